# Optimizing an MI355X kernel written in HIP

```python
import math
import jax, jax.numpy as jnp
from jax import lax
import numpy as np

D_MODEL = 1024
BATCH = 4
SEQ = 8192
DEPTH = 2

CONV_DIM = 512
CONV_WIDTH = 3
ATTN_HEADS = 8
ATTN_HEAD_DIM = 64
ATTN_DIM = ATTN_HEADS * ATTN_HEAD_DIM
MOBA_BLOCK = 256
MOBA_TOPK = 3
Q_CHUNK = 128
REL_BUCKETS = 32
REL_MAX_DISTANCE = 128
GLA_HEADS = 4
GLA_KEY_DIM = 64
GLA_VALUE_DIM = 128
GLA_QK_DIM = GLA_HEADS * GLA_KEY_DIM
GLA_V_DIM = GLA_HEADS * GLA_VALUE_DIM
GLA_GATE_RANK = 16
GLA_GATE_TEMP = 16.0
GLA_CHUNK = 64
N_BRANCHES = 3
BRANCH_DIM = 512
IN_SPLITS = (CONV_DIM, CONV_DIM, CONV_DIM, ATTN_DIM, ATTN_DIM, ATTN_DIM,
             GLA_QK_DIM, GLA_QK_DIM, GLA_V_DIM, GLA_V_DIM, GLA_GATE_RANK)
D_IN = 3 * CONV_DIM + 3 * ATTN_DIM + 2 * GLA_QK_DIM + 2 * GLA_V_DIM + GLA_GATE_RANK
N_GROUPS = 4
EXPERTS_PER_GROUP = 8
N_EXPERTS = N_GROUPS * EXPERTS_PER_GROUP
TOP_K = 2
EXPERT_FF = 512
EXPERT_BLOCK = 256
RMS_EPS = 1e-6

kernel_name = 'hybrid_conv_moba_gla_hmoe'


def rms_norm(x, g):
    xf = x.astype(jnp.float32)
    y = xf * lax.rsqrt(jnp.mean(xf * xf, axis=-1, keepdims=True) + RMS_EPS)
    return (y * g.astype(jnp.float32)).astype(x.dtype)


def short_conv(b_gate, c_gate, x_in, conv_w, conv_b):
    u = c_gate * x_in
    sn = u.shape[1]
    up = jnp.pad(u, ((0, 0), (CONV_WIDTH - 1, 0), (0, 0)))
    y = conv_b
    for j in range(CONV_WIDTH):
        y = y + conv_w[j] * up[:, j:j + sn]
    return b_gate * y


def t5_bucket(rel):
    n = jnp.maximum(rel, 0)
    max_exact = REL_BUCKETS // 2
    scaled = jnp.log(jnp.maximum(n, max_exact).astype(jnp.float32) / max_exact) / math.log(REL_MAX_DISTANCE / max_exact)
    large = jnp.minimum(max_exact + (scaled * (REL_BUCKETS - max_exact)).astype(jnp.int32), REL_BUCKETS - 1)
    return jnp.where(n < max_exact, n, large)


def moba_attention(q, k, v, rel_bias_table):
    bn, sn, nh, dh = q.shape
    f32 = jnp.float32
    n_blocks = max(-(-sn // MOBA_BLOCK), MOBA_TOPK)
    pad = n_blocks * MOBA_BLOCK - sn
    n_chunks = sn // Q_CHUNK
    scale = dh ** -0.5
    qh = q.transpose(0, 2, 1, 3)

    def to_blocks(t):
        t = jnp.pad(t.transpose(0, 2, 1, 3), ((0, 0), (0, 0), (0, pad), (0, 0)))
        return t.reshape(bn, nh, n_blocks, MOBA_BLOCK, dh)

    kblk, vblk = to_blocks(k), to_blocks(v)
    kmean = kblk.mean(axis=3)
    q_block = jnp.arange(sn) // MOBA_BLOCK
    past = jnp.arange(n_blocks)[None, :] < q_block[:, None]
    gate = jnp.einsum('bhsd,bhnd->bhsn', qh, kmean).astype(f32)
    gate = jnp.where(past, gate, -jnp.inf)
    _, sel = lax.top_k(gate, MOBA_TOPK)

    q_items = qh.reshape(bn, nh, n_chunks, Q_CHUNK, dh).transpose(0, 2, 1, 3, 4).reshape(bn * n_chunks, nh, Q_CHUNK, dh)
    sel_items = sel.reshape(bn, nh, n_chunks, Q_CHUNK, MOBA_TOPK).transpose(0, 2, 1, 3, 4).reshape(bn * n_chunks, nh, Q_CHUNK, MOBA_TOPK)
    table = rel_bias_table.astype(f32).T
    head3 = jnp.arange(nh)[:, None, None]
    head4 = jnp.arange(nh)[:, None, None, None]
    n_sel = MOBA_TOPK * MOBA_BLOCK

    def attend(args):
        qc, selc, item = args
        b = item // n_chunks
        c = item % n_chunks
        kb, vb = kblk[b], vblk[b]
        q_pos = c * Q_CHUNK + jnp.arange(Q_CHUNK)
        own = (c * Q_CHUNK) // MOBA_BLOCK
        k_sel = kb[head3, selc]
        v_sel = vb[head3, selc]
        kpos_sel = selc[..., None] * MOBA_BLOCK + jnp.arange(MOBA_BLOCK)
        s_sel = (jnp.einsum('hqd,hqktd->hqkt', qc, k_sel).astype(f32) * scale
                 + table[head4, t5_bucket(q_pos[None, :, None, None] - kpos_sel)])
        valid = jnp.arange(MOBA_TOPK) < own
        s_sel = jnp.where(valid[None, None, :, None], s_sel, -jnp.inf)
        k_own = lax.dynamic_index_in_dim(kb, own, axis=1, keepdims=False)
        v_own = lax.dynamic_index_in_dim(vb, own, axis=1, keepdims=False)
        rel_own = q_pos[:, None] - (own * MOBA_BLOCK + jnp.arange(MOBA_BLOCK))[None, :]
        s_own = jnp.einsum('hqd,htd->hqt', qc, k_own).astype(f32) * scale + table[:, t5_bucket(rel_own)]
        s_own = jnp.where(rel_own >= 0, s_own, -jnp.inf)
        logits = jnp.concatenate([s_sel.reshape(nh, Q_CHUNK, n_sel), s_own], axis=-1)
        p = jax.nn.softmax(logits, axis=-1).astype(qc.dtype)
        p_sel = p[..., :n_sel].reshape(nh, Q_CHUNK, MOBA_TOPK, MOBA_BLOCK)
        p_own = p[..., n_sel:]
        return (jnp.einsum('hqkt,hqktd->hqd', p_sel, v_sel)
                + jnp.einsum('hqt,htd->hqd', p_own, v_own))

    out = lax.map(attend, (q_items, sel_items, jnp.arange(bn * n_chunks)))
    return out.reshape(bn, n_chunks, nh, Q_CHUNK, dh).transpose(0, 1, 3, 2, 4).reshape(bn, sn, nh * dh)


def gla(q, k, v, r, z, w_alpha, b_alpha, out_norm):
    bn, sn, _ = q.shape
    f32 = jnp.float32
    nc = sn // GLA_CHUNK
    qf = q.astype(f32).reshape(bn, sn, GLA_HEADS, GLA_KEY_DIM) * GLA_KEY_DIM ** -0.5
    kf = k.astype(f32).reshape(bn, sn, GLA_HEADS, GLA_KEY_DIM)
    vf = v.astype(f32).reshape(bn, sn, GLA_HEADS, GLA_VALUE_DIM)
    log_a = jax.nn.log_sigmoid((z @ w_alpha + b_alpha).astype(f32)) / GLA_GATE_TEMP
    log_a = log_a.reshape(bn, sn, GLA_HEADS, GLA_KEY_DIM)

    def chunked(t):
        return t.reshape(bn, nc, GLA_CHUNK, GLA_HEADS, -1).transpose(0, 3, 1, 2, 4)

    qc, kc, vc, ac = chunked(qf), chunked(kf), chunked(vf), chunked(log_a)
    bcum = jnp.cumsum(ac, axis=3)
    btot = bcum[:, :, :, -1:, :]
    qe = qc * jnp.exp(bcum)
    ke = kc * jnp.exp(-bcum)
    kd = kc * jnp.exp(btot - bcum)
    causal = jnp.tril(jnp.ones((GLA_CHUNK, GLA_CHUNK), dtype=bool))
    att = jnp.where(causal, jnp.einsum('bhnid,bhnjd->bhnij', qe, ke), 0.0)
    o = jnp.einsum('bhnij,bhnjv->bhniv', att, vc)
    kv = jnp.einsum('bhnjd,bhnjv->bhndv', kd, vc)
    decay = jnp.exp(btot[:, :, :, 0, :])

    def step(state, inp):
        kv_n, dec_n = inp
        return dec_n[..., None] * state + kv_n, state

    s0 = jnp.zeros((bn, GLA_HEADS, GLA_KEY_DIM, GLA_VALUE_DIM), f32)
    _, s_prev = lax.scan(step, s0, (kv.transpose(2, 0, 1, 3, 4), decay.transpose(2, 0, 1, 3)))
    s_prev = s_prev.transpose(1, 2, 0, 3, 4)
    o = o + jnp.einsum('bhnid,bhndv->bhniv', qe, s_prev)
    o = o.transpose(0, 2, 3, 1, 4).reshape(bn, sn, GLA_HEADS, GLA_VALUE_DIM)
    o = rms_norm(o, out_norm).reshape(bn, sn, GLA_V_DIM)
    return (o * jax.nn.silu(r.astype(f32))).astype(r.dtype)


def hier_moe(h, w_rg, b_rg, w_re, b_re, w_g, w_u, w_d):
    bn, sn, d = h.shape
    f32 = jnp.float32
    t = bn * sn
    xt = h.reshape(t, d)
    p_group = jax.nn.softmax((xt @ w_rg + b_rg).astype(f32), axis=-1)
    group = jnp.argmax(p_group, axis=-1)
    p_group_top = jnp.take_along_axis(p_group, group[:, None], axis=-1)
    le = (xt @ w_re + b_re).astype(f32).reshape(t, N_GROUPS, EXPERTS_PER_GROUP)
    le_sel = jnp.take_along_axis(le, group[:, None, None], axis=1)[:, 0]
    top_p, top_i = lax.top_k(jax.nn.softmax(le_sel, axis=-1), TOP_K)
    weights = p_group_top * top_p / jnp.sum(top_p, axis=-1, keepdims=True)
    expert_id = group[:, None] * EXPERTS_PER_GROUP + top_i

    n_assign = t * TOP_K
    e_flat = expert_id.reshape(-1).astype(jnp.int32)
    w_flat = weights.reshape(-1).astype(h.dtype)
    tok_flat = jnp.repeat(jnp.arange(t, dtype=jnp.int32), TOP_K)
    counts = jnp.zeros((N_EXPERTS,), jnp.int32).at[e_flat].add(1)
    padded = ((counts + EXPERT_BLOCK - 1) // EXPERT_BLOCK) * EXPERT_BLOCK
    pad_end = jnp.cumsum(padded)
    pad_start = pad_end - padded
    start = jnp.cumsum(counts) - counts
    order = jnp.argsort(e_flat)
    e_sorted = e_flat[order]
    dest = pad_start[e_sorted] + (jnp.arange(n_assign, dtype=jnp.int32) - start[e_sorted])
    n_blocks = -(-n_assign // EXPERT_BLOCK) + N_EXPERTS
    n_rows = n_blocks * EXPERT_BLOCK
    row_tok = jnp.full((n_rows,), t, jnp.int32).at[dest].set(tok_flat[order])
    row_w = jnp.zeros((n_rows,), h.dtype).at[dest].set(w_flat[order])
    block_expert = jnp.minimum(
        jnp.searchsorted(pad_end, jnp.arange(n_blocks, dtype=jnp.int32) * EXPERT_BLOCK, side='right'),
        N_EXPERTS - 1)
    x_pad = jnp.concatenate([xt, jnp.zeros((1, d), xt.dtype)], axis=0)
    xs = x_pad[row_tok].reshape(n_blocks, EXPERT_BLOCK, d)

    def expert_block(args):
        xb, e = args
        return (jax.nn.silu(xb @ w_g[e]) * (xb @ w_u[e])) @ w_d[e]

    ys = lax.map(expert_block, (xs, block_expert)).reshape(n_rows, d)
    y = jax.ops.segment_sum(ys * row_w[:, None], row_tok, num_segments=t + 1)[:t]
    return y.reshape(bn, sn, d).astype(h.dtype)


def setup_inputs(seed: int = 0) -> dict:
    key = jax.random.key(seed)
    ks = jax.random.split(key, 22)
    f32 = jnp.float32

    def normal(k, shape, scale):
        return jax.random.normal(k, shape, f32) * scale

    def gain(k, shape):
        return 1.0 + 0.01 * jax.random.normal(k, shape, f32)

    return {
        'x': normal(ks[0], (BATCH, SEQ, D_MODEL), 1.0),
        'rel_bias_table': normal(ks[1], (REL_BUCKETS, ATTN_HEADS), 0.1),
        'norm_mix': gain(ks[2], (DEPTH, D_MODEL)),
        'w_in': normal(ks[3], (DEPTH, D_MODEL, D_IN), D_MODEL ** -0.5),
        'conv_w': normal(ks[4], (DEPTH, CONV_WIDTH, CONV_DIM), CONV_WIDTH ** -0.5),
        'conv_b': normal(ks[5], (DEPTH, CONV_DIM), 0.02),
        'q_norm': gain(ks[6], (DEPTH, ATTN_HEAD_DIM)),
        'k_norm': gain(ks[7], (DEPTH, ATTN_HEAD_DIM)),
        'w_gla_alpha': normal(ks[8], (DEPTH, GLA_GATE_RANK, GLA_QK_DIM), GLA_GATE_RANK ** -0.5),
        'b_gla_alpha': normal(ks[9], (DEPTH, GLA_QK_DIM), 0.1),
        'gla_out_norm': gain(ks[10], (DEPTH, GLA_VALUE_DIM)),
        'w_merge_gate': normal(ks[11], (DEPTH, N_BRANCHES, D_MODEL, D_MODEL), D_MODEL ** -0.5),
        'w_branch': normal(ks[12], (DEPTH, N_BRANCHES, BRANCH_DIM, D_MODEL), BRANCH_DIM ** -0.5),
        'w_out': normal(ks[13], (DEPTH, D_MODEL, D_MODEL), D_MODEL ** -0.5),
        'norm_ffn': gain(ks[14], (DEPTH, D_MODEL)),
        'w_router_group': normal(ks[15], (DEPTH, D_MODEL, N_GROUPS), D_MODEL ** -0.5),
        'b_router_group': normal(ks[16], (DEPTH, N_GROUPS), 0.01),
        'w_router_expert': normal(ks[17], (DEPTH, D_MODEL, N_EXPERTS), D_MODEL ** -0.5),
        'b_router_expert': normal(ks[18], (DEPTH, N_EXPERTS), 0.01),
        'w_expert_gate': normal(ks[19], (DEPTH, N_EXPERTS, D_MODEL, EXPERT_FF), D_MODEL ** -0.5),
        'w_expert_up': normal(ks[20], (DEPTH, N_EXPERTS, D_MODEL, EXPERT_FF), D_MODEL ** -0.5),
        'w_expert_down': normal(ks[21], (DEPTH, N_EXPERTS, EXPERT_FF, D_MODEL), EXPERT_FF ** -0.5),
    }


def reference(x, rel_bias_table, norm_mix, w_in, conv_w, conv_b, q_norm, k_norm,
              w_gla_alpha, b_gla_alpha, gla_out_norm, w_merge_gate, w_branch, w_out,
              norm_ffn, w_router_group, b_router_group, w_router_expert, b_router_expert,
              w_expert_gate, w_expert_up, w_expert_down):
    bn, sn, _ = x.shape
    split_points = np.cumsum(IN_SPLITS)[:-1].tolist()
    for l in range(DEPTH):
        h = rms_norm(x, norm_mix[l])
        (cb, cc, cx, aq, ak, av, gq, gk, gv, gr, gz) = jnp.split(h @ w_in[l], split_points, axis=-1)
        y_conv = short_conv(cb, cc, cx, conv_w[l], conv_b[l])
        q = rms_norm(aq.reshape(bn, sn, ATTN_HEADS, ATTN_HEAD_DIM), q_norm[l])
        k = rms_norm(ak.reshape(bn, sn, ATTN_HEADS, ATTN_HEAD_DIM), k_norm[l])
        v = av.reshape(bn, sn, ATTN_HEADS, ATTN_HEAD_DIM)
        y_attn = moba_attention(q, k, v, rel_bias_table)
        y_gla = gla(gq, gk, gv, gr, gz, w_gla_alpha[l], b_gla_alpha[l], gla_out_norm[l])
        merged = jnp.zeros_like(x)
        for n, y_b in enumerate((y_conv, y_attn, y_gla)):
            merged = merged + jax.nn.sigmoid(h @ w_merge_gate[l, n]) * (y_b @ w_branch[l, n])
        x = x + merged @ w_out[l]
        h2 = rms_norm(x, norm_ffn[l])
        x = x + hier_moe(h2, w_router_group[l], b_router_group[l], w_router_expert[l], b_router_expert[l],
                         w_expert_gate[l], w_expert_up[l], w_expert_down[l])
    return x
```

```cpp
#include <hip/hip_runtime.h>
#include <cstdio>
#include <cstdint>

#define LAS __attribute__((address_space(3)))
#ifndef PHASE_MASK
#define PHASE_MASK 0xffffffffu
#endif
#define PM(k) if ((PHASE_MASK >> (k)) & 1u)
#define GAS __attribute__((address_space(1)))
typedef unsigned short bf16;
typedef short bf16x8 __attribute__((ext_vector_type(8)));
typedef float f32x4 __attribute__((ext_vector_type(4)));
typedef float f32x2 __attribute__((ext_vector_type(2)));
typedef unsigned u32x4 __attribute__((ext_vector_type(4)));
typedef unsigned u32x2 __attribute__((ext_vector_type(2)));
typedef GAS unsigned gu32;

constexpr int T_ = 32768, SEQ = 8192, DM = 1024, DEPTH = 2;
constexpr int NPC = 1536, NPA = 1536, NPG = 1792, NIN = 4864;
constexpr int NYC = 1536;
constexpr int MAXROWS = 73728;
constexpr float RMS_EPS = 1e-6f;
constexpr float LOG2E = 1.4426950408889634f;
constexpr float QSCALE = 0.125f * LOG2E;

constexpr size_t MiB = 1u << 20;
constexpr size_t WS_CTL = 0, CTL_ZERO_BYTES = 1 * MiB;
constexpr size_t WS_MISC = 1 * MiB;
constexpr size_t WS_KMEAN = WS_MISC;
constexpr size_t WS_SEL = WS_MISC + 256 * 1024;
constexpr size_t WS_DEC = WS_SEL + 1 * MiB;
constexpr size_t WS_TOKE = WS_DEC + 512 * 1024;
constexpr size_t WS_TOKW = WS_TOKE + 256 * 1024;
constexpr size_t WS_TOKS = WS_TOKW + 256 * 1024;
constexpr size_t WS_ROWW = WS_TOKS + 256 * 1024;
constexpr size_t WS_BLKE = WS_ROWW + 288 * 1024;
constexpr size_t WS_WMIX = 8 * MiB;
constexpr size_t WMIX_LAYER = 22 * MiB;
constexpr size_t WO_WIN = 0, WO_WG = (size_t)NIN * 1024 * 2, WO_WB = WO_WG + (size_t)3072 * 1024 * 2, WO_WO = WO_WB + (size_t)3 * 1024 * 512 * 2;
constexpr size_t WS_H = 52 * MiB;
constexpr size_t WS_PC = 116 * MiB;
constexpr size_t WS_PA = 212 * MiB;
constexpr size_t WS_PG = 308 * MiB;
constexpr size_t WS_Y = 420 * MiB;
constexpr size_t WS_GLA = 516 * MiB;
constexpr size_t WS_END = 548 * MiB;
constexpr size_t WS_BB = WS_PC;
constexpr size_t WS_MRG = WS_PG;
constexpr size_t WS_W1T = WS_Y;
constexpr size_t WS_WDT = WS_Y + 64 * MiB;
constexpr size_t WS_XS = WS_PC;
constexpr size_t WS_ACT = WS_PG;
constexpr size_t WS_YS = WS_PC;
static_assert(WMIX_LAYER >= WO_WO + (size_t)1024 * 1024 * 2, "mixer weights fit");
static_assert(WS_WMIX + 2 * WMIX_LAYER <= WS_H && WS_BLKE + 2048 <= WS_WMIX, "map");
static_assert((size_t)MAXROWS * 1024 * 2 <= WS_PG - WS_PC && (size_t)MAXROWS * 512 * 2 <= WS_Y - WS_PG, "moe aliases fit");

constexpr int CW_BAR = 4096;
constexpr int CW_CNT = 16384;
constexpr int CW_CUR = 16384 + 256;

constexpr int RING_BYTES = 131072;
constexpr int LDSCTL_OFF = RING_BYTES;
constexpr int MISC_OFF = LDSCTL_OFF + 320;
constexpr int PTAB_OFF = LDSCTL_OFF + 512;
constexpr int LTAB_OFF = LDSCTL_OFF + 1024;
constexpr int LDS_BYTES = 147456;

#define RLX_AGENT __ATOMIC_RELAXED, __HIP_MEMORY_SCOPE_AGENT
__device__ __forceinline__ float bflo(unsigned w) { return __uint_as_float(w << 16); }
__device__ __forceinline__ float bfhi(unsigned w) { return __uint_as_float(w & 0xffff0000u); }
__device__ __forceinline__ float bf1(bf16 b) { return __uint_as_float((unsigned)b << 16); }
__device__ __forceinline__ unsigned f2bf(float f) { unsigned u = __float_as_uint(f); return (u + 0x7fffu + ((u >> 16) & 1u)) >> 16; }
__device__ __forceinline__ unsigned pk2(float lo, float hi) { return f2bf(lo) | (f2bf(hi) << 16); }
__device__ __forceinline__ void unpack8(const u32x4 w, float (&v)[8]) {
    v[0] = bflo(w.x); v[1] = bfhi(w.x); v[2] = bflo(w.y); v[3] = bfhi(w.y); v[4] = bflo(w.z); v[5] = bfhi(w.z); v[6] = bflo(w.w); v[7] = bfhi(w.w);
}
__device__ __forceinline__ u32x4 pack8(const float (&v)[8]) { u32x4 w; w.x = pk2(v[0], v[1]); w.y = pk2(v[2], v[3]); w.z = pk2(v[4], v[5]); w.w = pk2(v[6], v[7]); return w; }
__device__ __forceinline__ float wave_sum(float v) {
#pragma unroll
    for (int o = 1; o < 64; o <<= 1) v += __shfl_xor(v, o);
    return v;
}
__device__ __forceinline__ float wave_max(float v) {
#pragma unroll
    for (int o = 1; o < 64; o <<= 1) v = fmaxf(v, __shfl_xor(v, o));
    return v;
}
__device__ __forceinline__ float sigmoidf_(float x) { return __builtin_amdgcn_rcpf(1.0f + __builtin_amdgcn_exp2f(-x * LOG2E)); }

__device__ __forceinline__ int tid_now_() { int t = threadIdx.x; asm volatile("" : "+v"(t)); return t; }
namespace pg8 {
constexpr int BM = 256, BK = 64, HALF = 128, HTB = HALF * BK * 2, STAGE_BYTES = 8 * HTB;
__host__ __device__ __forceinline__ int lds_byte(int r, int c) { const int st = (r >> 4) * 2 + (c >> 5), rr = r & 15, cc = c & 31, ob = rr * 64 + cc * 2; return st * 1024 + (ob ^ (((ob >> 9) & 1) << 5)); }
__host__ __device__ __forceinline__ void stage_rc(int b, int& R, int& C) { const int st = b / 1024, sb = b % 1024, swz = sb ^ (((sb >> 9) & 1) << 5); R = (st >> 1) * 16 + swz / 64; C = (st & 1) * 32 + (swz % 64) / 2; }
__host__ __device__ __forceinline__ int perm32(int rho) { const int n = rho >> 4, i = rho & 15; return 8 * (i >> 2) + 4 * n + (i & 3); }
struct Unit { int pm, pn, z; };
__device__ __forceinline__ void tile_map(int w, int nM, int nN, int& pm, int& pn) {
    const int nwg = nM * nN, q = nwg / 8, r = nwg % 8, xcd = w % 8, off = w / 8;
    const int wg = (xcd < r ? xcd * (q + 1) : r * (q + 1) + (xcd - r) * q) + off;
    const int nig = 8 * nN, gid = wg / nig, fm = gid * 8, gsz = (nM - fm) < 8 ? (nM - fm) : 8;
    pm = fm + ((wg % nig) % gsz); pn = (wg % nig) / gsz;
}
__device__ __forceinline__ unsigned cvt_pk_bf16(float lo, float hi) { unsigned r; asm volatile("v_cvt_pk_bf16_f32 %0, %1, %2" : "=v"(r) : "v"(lo), "v"(hi)); return r; }

template <class Epi, class Sched>
__device__ __forceinline__ void gemm_phase(LAS unsigned char* lds, const int K, const int lda, const Sched& S, const Epi& E) {
    const int tid = tid_now_(), wid = __builtin_amdgcn_readfirstlane(tid >> 6), lane = tid & 63, wr = wid >> 2, wc = wid & 3, fr = lane & 15, fq = lane >> 4;
    const int nt = K / BK;
    unsigned voffA[2], voffB[2];
#pragma unroll
    for (int i = 0; i < 2; ++i) { int R, C; stage_rc(tid * 16 + i * 8192, R, C); const int Rb = Epi::PERM ? ((R & ~31) + perm32(R & 31)) : R;
        voffA[i] = (unsigned)(R * lda + C) * 2u; voffB[i] = (unsigned)(Rb * K + C) * 2u; }
    const size_t kstep = (size_t)(BK * 2);
    const size_t hstepA = (size_t)HALF * lda * 2, hstepB = (size_t)HALF * K * 2;
    const unsigned ldsw = (unsigned)wid * 1024u;
    const int aoff = lds_byte(wr * 64 + fr, fq * 8), boff = lds_byte(wc * 32 + fr, fq * 8);
#define PG8_SA(b, h) (((b) * 2 + (h)) * HTB)
#define PG8_SB(b, h) ((4 + (b) * 2 + (h)) * HTB)
#define PG8_STAGE(bufoff, gbase, voff) do { _Pragma("unroll") for (int _i = 0; _i < 2; ++_i) \
        __builtin_amdgcn_global_load_lds((const unsigned*)((const char*)(gbase) + (voff)[_i]), (LAS unsigned*)(lds + (bufoff) + ldsw + _i * 8192), 16, 0, 0); } while (0)
#define PG8_LDA(dst, b, h) do { _Pragma("unroll") for (int m = 0; m < 4; ++m) _Pragma("unroll") for (int k = 0; k < 2; ++k) dst[m][k] = *(const LAS bf16x8*)(lds + PG8_SA(b, h) + aoff + m * 2048 + k * 1024); } while (0)
#define PG8_LDB(dst, b, h) do { _Pragma("unroll") for (int n = 0; n < 2; ++n) _Pragma("unroll") for (int k = 0; k < 2; ++k) dst[n][k] = *(const LAS bf16x8*)(lds + PG8_SB(b, h) + boff + n * 2048 + k * 1024); } while (0)
#define PG8_MMA(ai, bj, At, Bt) do { __builtin_amdgcn_s_setprio(1); _Pragma("unroll") for (int m = 0; m < 4; ++m) _Pragma("unroll") for (int n = 0; n < 2; ++n) _Pragma("unroll") for (int k = 0; k < 2; ++k) \
        acc[ai][bj][m][n] = __builtin_amdgcn_mfma_f32_16x16x32_bf16(Bt[n][k], At[m][k], acc[ai][bj][m][n], 0, 0, 0); __builtin_amdgcn_s_setprio(0); } while (0)
#define PG8_WAIT_V(n) asm volatile("s_waitcnt vmcnt(" #n ")" ::: "memory")
#define PG8_WAIT_L(n) asm volatile("s_waitcnt lgkmcnt(" #n ")" ::: "memory")
#define PG8_BAR __builtin_amdgcn_s_barrier()
#define PG8_SCHED __builtin_amdgcn_sched_barrier(0)
    Unit cur, nxt; int ui = 0;
    if (!S.next(0, cur)) return;
    f32x4 acc[2][2][4][2];
#pragma unroll
    for (int a = 0; a < 2; ++a)
#pragma unroll
        for (int b = 0; b < 2; ++b)
#pragma unroll
            for (int m = 0; m < 4; ++m)
#pragma unroll
                for (int n = 0; n < 2; ++n) acc[a][b][m][n] = (f32x4){0.f, 0.f, 0.f, 0.f};
    bf16x8 At[4][2], B0[2][2], B1[2][2];
    const char* cA = S.a_ptr(cur); const char* cB = S.b_ptr(cur);
    PG8_STAGE(PG8_SB(0, 0), cB, voffB); PG8_STAGE(PG8_SB(0, 1), cB + hstepB, voffB); PG8_STAGE(PG8_SA(0, 0), cA, voffA); PG8_STAGE(PG8_SA(0, 1), cA + hstepA, voffA);
    if (wr == 1) PG8_BAR;
    PG8_WAIT_V(2); PG8_BAR;
    PG8_STAGE(PG8_SB(1, 0), cB + kstep, voffB); PG8_STAGE(PG8_SA(1, 0), cA + kstep, voffA); PG8_STAGE(PG8_SB(1, 1), cB + hstepB + kstep, voffB);
    PG8_WAIT_V(6); PG8_BAR;
    for (;;) {
        const bool has_next = S.next(ui + 1, nxt);
        const char* nA = has_next ? S.a_ptr(nxt) : cA; const char* nB = has_next ? S.b_ptr(nxt) : cB;
        for (int t = 0; t < nt; t += 2) {
            const bool last = (t == nt - 2);
            const char* a1 = cA + (size_t)(t + 1) * kstep;
            const char* a2 = last ? nA : cA + (size_t)(t + 2) * kstep; const char* b2 = last ? nB : cB + (size_t)(t + 2) * kstep;
            const char* a3 = a2 + kstep; const char* b3 = b2 + kstep;
            PG8_LDB(B0, 0, 0); PG8_LDB(B1, 0, 1); PG8_SCHED; PG8_LDA(At, 0, 0); PG8_STAGE(PG8_SA(1, 1), a1 + hstepA, voffA);
            PG8_WAIT_V(8); PG8_WAIT_L(0); PG8_BAR; PG8_MMA(0, 0, At, B0); PG8_MMA(0, 1, At, B1); PG8_BAR; PG8_SCHED;
            PG8_LDA(At, 0, 1); PG8_STAGE(PG8_SB(0, 0), b2, voffB); PG8_STAGE(PG8_SB(0, 1), b2 + hstepB, voffB); PG8_STAGE(PG8_SA(0, 0), a2, voffA);
            PG8_WAIT_V(8); PG8_WAIT_L(0); PG8_BAR; PG8_MMA(1, 0, At, B0); PG8_MMA(1, 1, At, B1); PG8_BAR; PG8_SCHED;
            PG8_LDB(B0, 1, 0); PG8_LDB(B1, 1, 1); PG8_SCHED; PG8_LDA(At, 1, 0); PG8_STAGE(PG8_SA(0, 1), a2 + hstepA, voffA);
            PG8_WAIT_V(8); PG8_WAIT_L(0); PG8_BAR; PG8_MMA(0, 0, At, B0); PG8_MMA(0, 1, At, B1); PG8_BAR; PG8_SCHED;
            PG8_LDA(At, 1, 1); PG8_STAGE(PG8_SB(1, 0), b3, voffB); PG8_STAGE(PG8_SB(1, 1), b3 + hstepB, voffB); PG8_STAGE(PG8_SA(1, 0), a3, voffA);
            PG8_WAIT_V(8); PG8_WAIT_L(0); PG8_BAR; PG8_MMA(1, 0, At, B0); PG8_MMA(1, 1, At, B1); PG8_BAR; PG8_SCHED;
        }
        if (wr == 0) PG8_BAR;
        E(acc, cur, wr, wc, fr, fq);
        if (!has_next) break;
#pragma unroll
        for (int a = 0; a < 2; ++a)
#pragma unroll
            for (int b = 0; b < 2; ++b)
#pragma unroll
                for (int m = 0; m < 4; ++m)
#pragma unroll
                    for (int n = 0; n < 2; ++n) acc[a][b][m][n] = (f32x4){0.f, 0.f, 0.f, 0.f};
        cur = nxt; cA = nA; cB = nB; ++ui;
        if (wr == 1) PG8_BAR;
    }
    PG8_WAIT_V(0);
    PG8_BAR;
#undef PG8_SA
#undef PG8_SB
#undef PG8_STAGE
#undef PG8_LDA
#undef PG8_LDB
#undef PG8_MMA
#undef PG8_WAIT_V
#undef PG8_WAIT_L
#undef PG8_BAR
#undef PG8_SCHED
}

struct SchedPlain {
    const char* A; const char* Bt; int nM, nN, G, c; size_t astep, bstep;
    __device__ __forceinline__ bool next(int i, Unit& u) const { const int L = i * G + c; if (L >= nM * nN) return false; tile_map(L, nM, nN, u.pm, u.pn); u.z = 0; return true; }
    __device__ __forceinline__ const char* a_ptr(const Unit& u) const { return A + (size_t)u.pm * astep; }
    __device__ __forceinline__ const char* b_ptr(const Unit& u) const { return Bt + (size_t)u.pn * bstep; }
};
struct SchedBranch {
    const char* Y; const char* Wb; int G, c;
    __device__ __forceinline__ bool next(int i, Unit& u) const { const int L = i * G + c; if (L >= 1536) return false; u.z = L / 512; tile_map(L % 512, 128, 4, u.pm, u.pn); return true; }
    __device__ __forceinline__ const char* a_ptr(const Unit& u) const { return Y + (size_t)u.pm * (256 * NYC * 2) + (size_t)u.z * 1024; }
    __device__ __forceinline__ const char* b_ptr(const Unit& u) const { return Wb + (size_t)u.z * (1024 * 512 * 2) + (size_t)u.pn * (256 * 512 * 2); }
};
struct SchedGate {
    const char* H; const char* Wg; int G, c;
    __device__ __forceinline__ bool next(int i, Unit& u) const { const int L = (i / 3) * G + c; if (L >= 512) return false; u.z = i % 3; tile_map(L, 128, 4, u.pm, u.pn); return true; }
    __device__ __forceinline__ const char* a_ptr(const Unit& u) const { return H + (size_t)u.pm * (256 * 1024 * 2); }
    __device__ __forceinline__ const char* b_ptr(const Unit& u) const { return Wg + (size_t)(u.z * 4 + u.pn) * (256 * 1024 * 2); }
};
struct SchedMoe {
    const char* A; const char* W; const LAS int* blk_e; int nU, G, c; size_t astep, estep, bstep;
    __device__ __forceinline__ bool next(int i, Unit& u) const { const int L = i * G + c; if (L >= nU) return false; u.pm = L >> 2; u.pn = L & 3; u.z = blk_e[u.pm]; return true; }
    __device__ __forceinline__ const char* a_ptr(const Unit& u) const { return A + (size_t)u.pm * astep; }
    __device__ __forceinline__ const char* b_ptr(const Unit& u) const { return W + (size_t)u.z * estep + (size_t)u.pn * bstep; }
};

#define EPI_ROWS_BEGIN _Pragma("unroll") for (int ai = 0; ai < 2; ++ai) _Pragma("unroll") for (int m = 0; m < 4; ++m)
struct EpiInProj {
    static constexpr bool PERM = true;
    bf16* Pc; bf16* Pa; bf16* Pg;
    __device__ __forceinline__ void operator()(const f32x4 (&acc)[2][2][4][2], const Unit& u, int wr, int wc, int fr, int fq) const {
        bf16* base; int ld, colt;
        if (u.pn < 6) { base = Pc; ld = NPC; colt = u.pn * 256; } else if (u.pn < 12) { base = Pa; ld = NPA; colt = (u.pn - 6) * 256; } else { base = Pg; ld = NPG; colt = (u.pn - 12) * 256; }
        const int row0 = u.pm * BM + wr * 64 + fr, col0 = colt + wc * 32 + 8 * fq;
        EPI_ROWS_BEGIN { bf16* rowp = base + (size_t)(row0 + ai * HALF + m * 16) * ld + col0;
#pragma unroll
            for (int bj = 0; bj < 2; ++bj) { const f32x4 v0 = acc[ai][bj][m][0], v1 = acc[ai][bj][m][1];
                u32x4 w; w.x = cvt_pk_bf16(v0[0], v0[1]); w.y = cvt_pk_bf16(v0[2], v0[3]); w.z = cvt_pk_bf16(v1[0], v1[1]); w.w = cvt_pk_bf16(v1[2], v1[3]);
                *(u32x4*)(rowp + bj * HALF) = w; } }
    }
};
struct EpiBranch {
    static constexpr bool PERM = true;
    bf16* Bb;
    __device__ __forceinline__ void operator()(const f32x4 (&acc)[2][2][4][2], const Unit& u, int wr, int wc, int fr, int fq) const {
        const int row0 = u.pm * BM + wr * 64 + fr, col0 = u.z * 1024 + u.pn * 256 + wc * 32 + 8 * fq;
        EPI_ROWS_BEGIN { bf16* rowp = Bb + (size_t)(row0 + ai * HALF + m * 16) * 3072 + col0;
#pragma unroll
            for (int bj = 0; bj < 2; ++bj) { const f32x4 v0 = acc[ai][bj][m][0], v1 = acc[ai][bj][m][1];
                u32x4 w; w.x = cvt_pk_bf16(v0[0], v0[1]); w.y = cvt_pk_bf16(v0[2], v0[3]); w.z = cvt_pk_bf16(v1[0], v1[1]); w.w = cvt_pk_bf16(v1[2], v1[3]);
                *(u32x4*)(rowp + bj * HALF) = w; } }
    }
};
struct EpiGateMerge {
    static constexpr bool PERM = true;
    const bf16* Bb; bf16* Mg;
    __device__ __forceinline__ void operator()(const f32x4 (&acc)[2][2][4][2], const Unit& u, int wr, int wc, int fr, int fq) const {
        const int row0 = u.pm * BM + wr * 64 + fr, col0 = u.pn * 256 + wc * 32 + 8 * fq;
        EPI_ROWS_BEGIN { const size_t r = (size_t)(row0 + ai * HALF + m * 16);
#pragma unroll
            for (int bj = 0; bj < 2; ++bj) {
                const u32x4 bw = *(const u32x4*)(Bb + r * 3072 + u.z * 1024 + col0 + bj * HALF);
                float b[8]; unpack8(bw, b);
                float o[8];
#pragma unroll
                for (int e = 0; e < 8; ++e) o[e] = sigmoidf_(acc[ai][bj][m][e >> 2][e & 3]) * b[e];
                bf16* mp = Mg + r * 1024 + col0 + bj * HALF;
                if (u.z != 0) { const u32x4 mw = *(const u32x4*)mp; float pm_[8]; unpack8(mw, pm_);
#pragma unroll
                    for (int e = 0; e < 8; ++e) o[e] += pm_[e]; }
                u32x4 w; w.x = cvt_pk_bf16(o[0], o[1]); w.y = cvt_pk_bf16(o[2], o[3]); w.z = cvt_pk_bf16(o[4], o[5]); w.w = cvt_pk_bf16(o[6], o[7]);
                *(u32x4*)mp = w; } }
    }
};
struct EpiOut {
    static constexpr bool PERM = false;
    const float* xin; float* out;
    __device__ __forceinline__ void operator()(const f32x4 (&acc)[2][2][4][2], const Unit& u, int wr, int wc, int fr, int fq) const {
        const int row0 = u.pm * BM + wr * 64 + fr, col0 = u.pn * BM + wc * 32 + 4 * fq;
        EPI_ROWS_BEGIN { const size_t off = (size_t)(row0 + ai * HALF + m * 16) * 1024 + col0;
#pragma unroll
            for (int bj = 0; bj < 2; ++bj)
#pragma unroll
                for (int n = 0; n < 2; ++n) { const f32x4 xv = *(const f32x4*)(xin + off + bj * HALF + n * 16); *(f32x4*)(out + off + bj * HALF + n * 16) = xv + acc[ai][bj][m][n]; } }
    }
};
struct EpiSwiGLU {
    static constexpr bool PERM = true;
    bf16* act;
    __device__ __forceinline__ void operator()(const f32x4 (&acc)[2][2][4][2], const Unit& u, int wr, int wc, int fr, int fq) const {
        const int row0 = u.pm * BM + wr * 64 + fr, col0 = u.pn * 128 + wc * 32 + 8 * fq;
        EPI_ROWS_BEGIN { bf16* rowp = act + (size_t)(row0 + ai * HALF + m * 16) * 512 + col0;
            float o[8];
#pragma unroll
            for (int e = 0; e < 8; ++e) { const float g = acc[ai][0][m][e >> 2][e & 3], up = acc[ai][1][m][e >> 2][e & 3]; o[e] = g * sigmoidf_(g) * up; }
            u32x4 w; w.x = cvt_pk_bf16(o[0], o[1]); w.y = cvt_pk_bf16(o[2], o[3]); w.z = cvt_pk_bf16(o[4], o[5]); w.w = cvt_pk_bf16(o[6], o[7]);
            *(u32x4*)rowp = w; }
    }
};
struct EpiMoeDown {
    static constexpr bool PERM = true;
    bf16* ys; const float* row_w;
    __device__ __forceinline__ void operator()(const f32x4 (&acc)[2][2][4][2], const Unit& u, int wr, int wc, int fr, int fq) const {
        const int row0 = u.pm * BM + wr * 64 + fr, col0 = u.pn * 256 + wc * 32 + 8 * fq;
        EPI_ROWS_BEGIN { const int r = row0 + ai * HALF + m * 16; const float rw = row_w[r]; bf16* rowp = ys + (size_t)r * 1024 + col0;
#pragma unroll
            for (int bj = 0; bj < 2; ++bj) { const f32x4 v0 = acc[ai][bj][m][0] * rw, v1 = acc[ai][bj][m][1] * rw;
                u32x4 w; w.x = cvt_pk_bf16(v0[0], v0[1]); w.y = cvt_pk_bf16(v0[2], v0[3]); w.z = cvt_pk_bf16(v1[0], v1[1]); w.w = cvt_pk_bf16(v1[2], v1[3]);
                *(u32x4*)(rowp + bj * HALF) = w; } }
    }
};
}

#define XB_TMO      128
#define XB_XCNT(j)  (256  + 64 * (j))
#define XB_XSUB(j)  (1280 + 64 * (j))
#define XB_XGEN(j)  (2304 + 64 * (j))
#define XB_TOP      3328
#define XB_TOPGEN   3392
#define XCD_BAR_WORDS 3456
#define XB_SPIN_CAP (1u << 18)
__device__ __forceinline__ unsigned xb_ld(unsigned* p)              { return __hip_atomic_load(p, __ATOMIC_RELAXED, __HIP_MEMORY_SCOPE_AGENT); }
__device__ __forceinline__ unsigned xb_add(unsigned* p, unsigned v) { return __hip_atomic_fetch_add(p, v, __ATOMIC_RELAXED, __HIP_MEMORY_SCOPE_AGENT); }
__device__ __forceinline__ unsigned xb_xcc_id() { return (unsigned)__builtin_amdgcn_s_getreg((3 << 11) | 20) & 0xFu; }
#define XB_SPIN(cond, bar) do { unsigned _sp = 0; while (cond) { __builtin_amdgcn_s_sleep(1); \
    if ((++_sp & 255u) == 0u) { if (xb_ld(&(bar)[XB_TMO])) break; if (_sp > XB_SPIN_CAP) { atomicAdd(&(bar)[XB_TMO], 1u); break; } } } } while (0)
struct XcdBarrier { unsigned* bar; unsigned x; volatile LAS unsigned* st; };
__device__ __forceinline__ XcdBarrier xcd_barrier_post(unsigned* bar, volatile LAS unsigned* st) {
    XcdBarrier b; b.bar = bar; b.x = xb_xcc_id(); b.st = st;
    if (threadIdx.x == 0) (void)xb_add(&bar[XB_XCNT(b.x)], 1u);
    return b;
}
__device__ __forceinline__ void xcd_barrier_complete(unsigned* bar, unsigned x, unsigned& nloc, unsigned& nx) {
    const unsigned G = gridDim.x * gridDim.y * gridDim.z;
    unsigned sum, cnt, mine, sp = 0u;
    for (;;) {
        sum = 0u; cnt = 0u; mine = 0u;
#pragma unroll
        for (unsigned j = 0; j < 16; ++j) { const unsigned c = xb_ld(&bar[XB_XCNT(j)]); sum += c; cnt += (c > 0u) ? 1u : 0u; mine = (j == x) ? c : mine; }
        if (sum == G) break;
        __builtin_amdgcn_s_sleep(1);
        if ((++sp & 255u) == 0u) { if (xb_ld(&bar[XB_TMO])) break; if (sp > XB_SPIN_CAP) { atomicAdd(&bar[XB_TMO], 1u); break; } }
    }
    nloc = mine > 0u ? mine : 1u; nx = cnt > 0u ? cnt : 1u;
}
__device__ __forceinline__ void xcd_barrier(const XcdBarrier& b) {
    asm volatile("s_waitcnt vmcnt(0)" ::: "memory");
    __syncthreads();
    if (threadIdx.x == 0) {
        unsigned* bar = b.bar;
        __builtin_amdgcn_s_waitcnt(0);
        unsigned nloc = b.st[0], nx = b.st[1];
        if (nloc == 0u) { xcd_barrier_complete(bar, b.x, nloc, nx); b.st[0] = nloc; b.st[1] = nx; }
        const unsigned old = xb_add(&bar[XB_XSUB(b.x)], 1u);
        const unsigned gen = old / nloc;
        if (old + 1u == (gen + 1u) * nloc) {
            __builtin_amdgcn_fence(__ATOMIC_RELEASE, "agent");
            asm volatile("s_waitcnt vmcnt(0)" ::: "memory");
            const unsigned og = xb_add(&bar[XB_TOP], 1u);
            const unsigned tg = og / nx;
            if (og + 1u == (tg + 1u) * nx) xb_add(&bar[XB_TOPGEN], 1u);
            else XB_SPIN(xb_ld(&bar[XB_TOPGEN]) == tg, bar);
            __builtin_amdgcn_fence(__ATOMIC_ACQUIRE, "agent");
            xb_add(&bar[XB_XGEN(b.x)], 1u);
            asm volatile("s_waitcnt vmcnt(0)" ::: "memory");
        } else {
            XB_SPIN(xb_ld(&bar[XB_XGEN(b.x)]) == gen, bar);
            __builtin_amdgcn_fence(__ATOMIC_ACQUIRE, "agent");
            asm volatile("s_waitcnt vmcnt(0)" ::: "memory");
        }
    }
    __syncthreads();
}

struct Frame {
    LAS unsigned char* lds;
    volatile LAS unsigned* MISC;
    unsigned* ctl;
    int tid, lane, wave, G;
    float* out;
    unsigned char* ws;
    __device__ __forceinline__ const float* inp(int k) const {
        const LAS unsigned* p = (const LAS unsigned*)(lds + PTAB_OFF) + 2 * k; const unsigned lo = __builtin_amdgcn_readfirstlane(p[0]), hi = __builtin_amdgcn_readfirstlane(p[1]);
        return (const float*)(const GAS float*)(((unsigned long long)hi << 32) | lo); }
};
__device__ __forceinline__ int tid_now() { int t = threadIdx.x; asm volatile("" : "+v"(t)); return t; }
__device__ __forceinline__ unsigned char* opaque(unsigned char* p) { unsigned z = 0u; asm volatile("" : "+s"(z)); return p + z; }
#define LDS_WAIT() asm volatile("s_waitcnt lgkmcnt(0)" ::: "memory")

__device__ __forceinline__ void transpose_item(const float* W, int ldw, int nvalid, bf16* WT, int Kd, int k0, int n0, int drow0, LAS float* scr, int lane) {
    const int cn = n0 + (lane & 31); const bool ok = cn < nvalid;
#pragma unroll 8
    for (int i = 0; i < 32; ++i) { const int kk = 2 * i + (lane >> 5); scr[kk * 33 + (lane & 31)] = ok ? W[(size_t)(k0 + kk) * ldw + cn] : 0.f; }
    LDS_WAIT(); asm volatile("" ::: "memory");
    const int c = lane & 7;
#pragma unroll
    for (int j = 0; j < 4; ++j) { const int n = (lane >> 3) + 8 * j; const LAS float* s = scr + (8 * c) * 33 + n;
        u32x4 o; o.x = pk2(s[0 * 33], s[1 * 33]); o.y = pk2(s[2 * 33], s[3 * 33]); o.z = pk2(s[4 * 33], s[5 * 33]); o.w = pk2(s[6 * 33], s[7 * 33]);
        *(u32x4*)(WT + (size_t)(drow0 + n) * Kd + k0 + 8 * c) = o; }
    LDS_WAIT(); asm volatile("" ::: "memory");
}

__device__ __forceinline__ void ph_convert_mixer(Frame& F) {
    const int tid = tid_now(), lane = tid & 63, wave = __builtin_amdgcn_readfirstlane(tid >> 6); (void)lane; (void)wave;
    unsigned char* const wsl = opaque(F.ws);
    LAS float* scr = (LAS float*)(F.lds + wave * 16384);
    const int gw = blockIdx.x * 8 + wave, NGW = F.G * 8;
    constexpr int I_IN = 16 * 152, I_G = 3 * 16 * 32, I_B = 3 * 8 * 32, I_O = 16 * 32, I_L = I_IN + I_G + I_B + I_O;
    for (int it = gw; it < 2 * I_L; it += NGW) {
        const int l = it / I_L; int r = it % I_L;
        unsigned char* wb = wsl + WS_WMIX + (size_t)l * WMIX_LAYER;
        if (r < I_IN) { const int kb = r / 152, nb = r % 152;
            transpose_item(F.inp(3) + (size_t)l * 1024 * 4624, 4624, 4624, (bf16*)(wb + WO_WIN), 1024, kb * 64, nb * 32, nb * 32, scr, lane); continue; }
        r -= I_IN;
        if (r < I_G) { const int z = r / 512, q = r % 512, kb = q / 32, nb = q % 32;
            transpose_item(F.inp(11) + ((size_t)l * 3 + z) * 1024 * 1024, 1024, 1024, (bf16*)(wb + WO_WG), 1024, kb * 64, nb * 32, z * 1024 + nb * 32, scr, lane); continue; }
        r -= I_G;
        if (r < I_B) { const int z = r / 256, q = r % 256, kb = q / 32, nb = q % 32;
            transpose_item(F.inp(12) + ((size_t)l * 3 + z) * 512 * 1024, 1024, 1024, (bf16*)(wb + WO_WB) + (size_t)z * 1024 * 512, 512, kb * 64, nb * 32, nb * 32, scr, lane); continue; }
        r -= I_B;
        { const int kb = r / 32, nb = r % 32;
            transpose_item(F.inp(13) + (size_t)l * 1024 * 1024, 1024, 1024, (bf16*)(wb + WO_WO), 1024, kb * 64, nb * 32, nb * 32, scr, lane); }
    }
}
__device__ __forceinline__ void ph_convert_experts(Frame& F, int l) {
    const int tid = tid_now(), lane = tid & 63, wave = __builtin_amdgcn_readfirstlane(tid >> 6); (void)lane; (void)wave;
    unsigned char* const wsl = opaque(F.ws);
    LAS float* scr = (LAS float*)(F.lds + wave * 16384);
    const int gw = blockIdx.x * 8 + wave, NGW = F.G * 8;
    constexpr int I_1 = 32 * 16 * 32, I_2 = 32 * 8 * 32;
    bf16* W1T = (bf16*)(wsl + WS_W1T); bf16* WdT = (bf16*)(wsl + WS_WDT);
    for (int it = gw; it < I_1 + I_2; it += NGW) {
        if (it < I_1) { const int e = it / 512, q = it % 512, kb = q / 32, j = q % 32, half = j >> 4, nb = j & 15;
            const float* src = (half ? F.inp(20) : F.inp(19)) + ((size_t)l * 32 + e) * 1024 * 512;
            const int t = nb >> 2, drow = t * 256 + half * 128 + (nb & 3) * 32;
            transpose_item(src, 512, 512, W1T + (size_t)e * 1024 * 1024, 1024, kb * 64, nb * 32, drow, scr, lane);
        } else { const int r = it - I_1, e = r / 256, q = r % 256, kb = q / 32, nb = q % 32;
            transpose_item(F.inp(21) + ((size_t)l * 32 + e) * 512 * 1024, 1024, 1024, WdT + (size_t)e * 1024 * 512, 512, kb * 64, nb * 32, nb * 32, scr, lane); }
    }
}
template <bool COMBINE, bool NORM>
__device__ __forceinline__ void ph_norm(Frame& F, const float* xin, const float* gain, bf16* H) {
    const int tid = tid_now(), lane = tid & 63, wave = __builtin_amdgcn_readfirstlane(tid >> 6); (void)lane; (void)wave;
    unsigned char* const wsl = opaque(F.ws);
    const int gw = blockIdx.x * 8 + wave, NGW = F.G * 8;
    const int* toks = (const int*)(wsl + WS_TOKS); const bf16* ys = (const bf16*)(wsl + WS_YS);
    f32x4 g[4];
#pragma unroll
    for (int j = 0; j < 4; ++j) g[j] = NORM ? *((const f32x4*)gain + 64 * j + lane) : (f32x4){0.f, 0.f, 0.f, 0.f};
    for (int m = gw; m < T_; m += NGW) {
        const f32x4* xr = (const f32x4*)(xin + (size_t)m * 1024) + lane;
        f32x4 v[4];
#pragma unroll
        for (int j = 0; j < 4; ++j) v[j] = xr[64 * j];
        if (COMBINE) {
            const int s0 = toks[2 * m], s1 = toks[2 * m + 1];
            const u32x2* y0 = (const u32x2*)(ys + (size_t)s0 * 1024) + lane; const u32x2* y1 = (const u32x2*)(ys + (size_t)s1 * 1024) + lane;
#pragma unroll
            for (int j = 0; j < 4; ++j) { const u32x2 a = y0[64 * j], b = y1[64 * j];
                v[j].x += bflo(a.x) + bflo(b.x); v[j].y += bfhi(a.x) + bfhi(b.x); v[j].z += bflo(a.y) + bflo(b.y); v[j].w += bfhi(a.y) + bfhi(b.y); }
            f32x4* xo = (f32x4*)(F.out + (size_t)m * 1024) + lane;
#pragma unroll
            for (int j = 0; j < 4; ++j) xo[64 * j] = v[j];
        }
        if (NORM) {
            float ss = 0.f;
#pragma unroll
            for (int j = 0; j < 4; ++j) ss += (v[j].x * v[j].x + v[j].y * v[j].y) + (v[j].z * v[j].z + v[j].w * v[j].w);
            const float rs = rsqrtf(wave_sum(ss) * (1.f / 1024.f) + RMS_EPS);
            u32x2* o8 = (u32x2*)(H + (size_t)m * 1024) + lane;
#pragma unroll
            for (int j = 0; j < 4; ++j) { u32x2 w; w.x = pk2(v[j].x * rs * g[j].x, v[j].y * rs * g[j].y); w.y = pk2(v[j].z * rs * g[j].z, v[j].w * rs * g[j].w); o8[64 * j] = w; }
        }
    }
}

__device__ __forceinline__ void ph_conv(Frame& F, int l) {
    const int tid = tid_now(), lane = tid & 63, wave = __builtin_amdgcn_readfirstlane(tid >> 6); (void)lane; (void)wave;
    unsigned char* const wsl = opaque(F.ws);
    const bf16* Pc = (const bf16*)(wsl + WS_PC); bf16* Y = (bf16*)(wsl + WS_Y);
    const float* cw = F.inp(4) + (size_t)l * 3 * 512; const float* cbias = F.inp(5) + (size_t)l * 512;
    const int gt = blockIdx.x * 512 + tid, NT = F.G * 512;
    for (int item = gt; item < T_ * 64; item += NT) {
        const int r = item >> 6, c8 = (item & 63) * 8, s = r & (SEQ - 1);
        const bf16* p = Pc + (size_t)r * NPC + c8;
        float cb[8], a[8], b[8], u0[8], u1[8], u2[8];
        unpack8(*(const u32x4*)p, cb);
        unpack8(*(const u32x4*)(p + 512), a); unpack8(*(const u32x4*)(p + 1024), b);
#pragma unroll
        for (int e = 0; e < 8; ++e) u2[e] = a[e] * b[e];
        if (s >= 1) { unpack8(*(const u32x4*)(p - NPC + 512), a); unpack8(*(const u32x4*)(p - NPC + 1024), b);
#pragma unroll
            for (int e = 0; e < 8; ++e) u1[e] = a[e] * b[e]; }
        else {
#pragma unroll
            for (int e = 0; e < 8; ++e) u1[e] = 0.f; }
        if (s >= 2) { unpack8(*(const u32x4*)(p - 2 * NPC + 512), a); unpack8(*(const u32x4*)(p - 2 * NPC + 1024), b);
#pragma unroll
            for (int e = 0; e < 8; ++e) u0[e] = a[e] * b[e]; }
        else {
#pragma unroll
            for (int e = 0; e < 8; ++e) u0[e] = 0.f; }
        float o[8];
#pragma unroll
        for (int e = 0; e < 8; ++e) o[e] = cb[e] * (cbias[c8 + e] + cw[c8 + e] * u0[e] + cw[512 + c8 + e] * u1[e] + cw[1024 + c8 + e] * u2[e]);
        *(u32x4*)(Y + (size_t)r * NYC + c8) = pack8(o);
    }
}
__device__ __forceinline__ void ph_qknorm(Frame& F, int l) {
    const int tid = tid_now(), lane = tid & 63, wave = __builtin_amdgcn_readfirstlane(tid >> 6); (void)lane; (void)wave;
    unsigned char* const wsl = opaque(F.ws);
    bf16* Pa = (bf16*)(wsl + WS_PA); float* kmean = (float*)(wsl + WS_KMEAN);
    LAS float* red = (LAS float*)F.lds;
    for (int unit = blockIdx.x; unit < 256; unit += F.G) {
        const int blk = unit >> 1, isk = unit & 1;
        const float* gn = (isk ? F.inp(7) : F.inp(6)) + l * 64 + (lane & 7) * 8;
        float g[8], ksum[8];
#pragma unroll
        for (int e = 0; e < 8; ++e) { g[e] = gn[e] * (isk ? 1.f : QSCALE); ksum[e] = 0.f; }
        for (int rr = 0; rr < 32; ++rr) {
            const int r = blk * 256 + wave * 32 + rr;
            bf16* p = Pa + (size_t)r * NPA + isk * 512 + lane * 8;
            float v[8]; unpack8(*(const u32x4*)p, v);
            float ss = 0.f;
#pragma unroll
            for (int e = 0; e < 8; ++e) ss += v[e] * v[e];
            ss += __shfl_xor(ss, 1); ss += __shfl_xor(ss, 2); ss += __shfl_xor(ss, 4);
            const float rs = rsqrtf(ss * (1.f / 64.f) + RMS_EPS);
#pragma unroll
            for (int e = 0; e < 8; ++e) { v[e] = v[e] * rs * g[e]; ksum[e] += v[e]; }
            *(u32x4*)p = pack8(v);
        }
        if (isk) {
#pragma unroll
            for (int e = 0; e < 8; ++e) red[wave * 512 + lane * 8 + e] = ksum[e];
            __syncthreads();
            { const int col = tid; float s = 0.f;
#pragma unroll
              for (int w = 0; w < 8; ++w) s += red[w * 512 + col];
              const int b = blk >> 5, n = blk & 31, h = col >> 6, d = col & 63;
              kmean[((size_t)((b * 8 + h) * 32 + n)) * 64 + d] = s * (1.f / 256.f); }
            __syncthreads();
        }
    }
}
__device__ __forceinline__ void gla_bcum(Frame& F, int l, int r0, int h, LAS float* zs, LAS float* wa, LAS float* ba, LAS float* bt, LAS float* la) {
    const int tid = tid_now(), lane = tid & 63, wave = __builtin_amdgcn_readfirstlane(tid >> 6); (void)lane; (void)wave;
    unsigned char* const wsl = opaque(F.ws);
    const bf16* Pg = (const bf16*)(wsl + WS_PG);
        for (int i = tid; i < 1024; i += 512) { const int j = i >> 4, rr = i & 15; zs[i] = bf1(Pg[(size_t)(r0 + j) * NPG + 1536 + rr]); }
    for (int i = tid; i < 1024; i += 512) { const int rr = i >> 6, d = i & 63; wa[i] = F.inp(8)[(size_t)l * 16 * 256 + rr * 256 + h * 64 + d]; }
    if (tid < 64) ba[tid] = F.inp(9)[l * 256 + h * 64 + tid];
    __syncthreads();
    { const int d = tid & 63, j0 = (tid >> 6) * 8;
#pragma unroll
      for (int jj = 0; jj < 8; ++jj) { const int j = j0 + jj; float x = ba[d];
#pragma unroll
          for (int rr = 0; rr < 16; ++rr) x += zs[j * 16 + rr] * wa[rr * 64 + d];
          const float ls = fminf(x, 0.f) - log1pf(__expf(-fabsf(x)));
          la[j * 65 + d] = ls * (1.f / 16.f); } }
    __syncthreads();
    if (tid < 64) { float a = 0.f; for (int j = 0; j < 64; ++j) { a += la[j * 65 + tid]; la[j * 65 + tid] = a; } bt[tid] = a; }
    __syncthreads();
}
__device__ __forceinline__ void ph_gla_kv(Frame& F, int l) {
    const int tid = tid_now(), lane = tid & 63, wave = __builtin_amdgcn_readfirstlane(tid >> 6); (void)lane; (void)wave;
    unsigned char* const wsl = opaque(F.ws);
    const bf16* Pg = (const bf16*)(wsl + WS_PG); bf16* GK = (bf16*)(wsl + WS_GLA); float* DEC = (float*)(wsl + WS_DEC);
    LAS float* zs = (LAS float*)F.lds; LAS float* wa = zs + 1024; LAS float* ba = wa + 1024; LAS float* bt = ba + 64; LAS float* la = bt + 64;
    LAS float* ks = la + 64 * 65; LAS float* vs = ks + 64 * 65;
        for (int unit = blockIdx.x; unit < 2048; unit += F.G) {
        const int h = unit & 3, cg = unit >> 2, b = cg >> 7, ch = cg & 127, r0 = b * SEQ + ch * 64;
        gla_bcum(F, l, r0, h, zs, wa, ba, bt, la);
        { const int d = tid & 63, j0 = (tid >> 6) * 8;
#pragma unroll
          for (int jj = 0; jj < 8; ++jj) { const int j = j0 + jj; ks[j * 65 + d] = bf1(Pg[(size_t)(r0 + j) * NPG + 256 + h * 64 + d]) * __expf(bt[d] - la[j * 65 + d]); } }
        for (int i = tid; i < 64 * 128; i += 512) { const int j = i >> 7, v = i & 127; vs[i] = bf1(Pg[(size_t)(r0 + j) * NPG + 512 + h * 128 + v]); }
        __syncthreads();
        { const int v = tid & 127, d0 = (tid >> 7) * 16; float acc[16];
#pragma unroll
          for (int dd = 0; dd < 16; ++dd) acc[dd] = 0.f;
#pragma unroll 2
          for (int j = 0; j < 64; ++j) { const float vv = vs[j * 128 + v];
#pragma unroll
              for (int dd = 0; dd < 16; ++dd) acc[dd] += ks[j * 65 + d0 + dd] * vv; }
          bf16* o = GK + ((size_t)((b * 4 + h) * 128 + ch)) * 8192;
#pragma unroll
          for (int dd = 0; dd < 16; ++dd) o[(d0 + dd) * 128 + v] = (bf16)f2bf(acc[dd]); }
        if (tid < 64) DEC[((size_t)((b * 4 + h) * 128 + ch)) * 64 + tid] = __expf(bt[tid]);
        __syncthreads();
    }
}
__device__ __forceinline__ void ph_moba_gate(Frame& F) {
    const int tid = tid_now(), lane = tid & 63, wave = __builtin_amdgcn_readfirstlane(tid >> 6); (void)lane; (void)wave;
    unsigned char* const wsl = opaque(F.ws);
    const bf16* Pa = (const bf16*)(wsl + WS_PA); const float* kmean = (const float*)(wsl + WS_KMEAN); unsigned* sel = (unsigned*)(wsl + WS_SEL);
    LAS float* km = (LAS float*)(F.lds + wave * 8192);
    const int gw = blockIdx.x * 8 + wave, NGW = F.G * 8;
    for (int it = gw; it < 512 * 8; it += NGW) {
        const int rb = it >> 3, h = it & 7, r = rb * 64 + lane, b = rb >> 7, qb = (rb & 127) >> 2;
        for (int i = lane; i < 2048; i += 64) km[i] = kmean[(size_t)(b * 8 + h) * 2048 + i];
        float q[64];
#pragma unroll
        for (int c = 0; c < 8; ++c) { float t8[8]; unpack8(*(const u32x4*)(Pa + (size_t)r * NPA + h * 64 + c * 8), t8);
#pragma unroll
            for (int e = 0; e < 8; ++e) q[c * 8 + e] = t8[e]; }
        LDS_WAIT(); asm volatile("" ::: "memory");
        float v0 = -INFINITY, v1 = -INFINITY, v2 = -INFINITY; int i0 = 0, i1 = 1, i2 = 2;
        for (int n = 0; n < qb; ++n) {
            float s = 0.f;
#pragma unroll
            for (int d = 0; d < 64; ++d) s += q[d] * km[n * 64 + d];
            if (s > v0) { v2 = v1; i2 = i1; v1 = v0; i1 = i0; v0 = s; i0 = n; }
            else if (s > v1) { v2 = v1; i2 = i1; v1 = s; i1 = n; }
            else if (s > v2) { v2 = s; i2 = n; }
        }
        const int nv = qb < 3 ? qb : 3;
        sel[(size_t)r * 8 + h] = (unsigned)i0 | ((unsigned)i1 << 8) | ((unsigned)i2 << 16) | ((unsigned)nv << 24);
        asm volatile("" ::: "memory");
    }
}
__device__ __forceinline__ void ph_gla_scan(Frame& F) {
    const int tid = tid_now(), lane = tid & 63, wave = __builtin_amdgcn_readfirstlane(tid >> 6); (void)lane; (void)wave;
    unsigned char* const wsl = opaque(F.ws);
    bf16* GK = (bf16*)(wsl + WS_GLA); const float* DEC = (const float*)(wsl + WS_DEC);
    const int gt = blockIdx.x * 512 + tid, NT = F.G * 512;
    for (int e = gt; e < 16 * 8192; e += NT) {
        const int bh = e >> 13, dv = e & 8191, d = dv >> 7;
        bf16* p = GK + (size_t)bh * 128 * 8192 + dv; const float* dc = DEC + (size_t)bh * 128 * 64 + d;
        float st = 0.f;
        for (int n0 = 0; n0 < 128; n0 += 16) {
            float kv[16], de[16];
#pragma unroll
            for (int i = 0; i < 16; ++i) { kv[i] = bf1(p[(size_t)(n0 + i) * 8192]); de[i] = dc[(n0 + i) * 64]; }
#pragma unroll
            for (int i = 0; i < 16; ++i) { p[(size_t)(n0 + i) * 8192] = (bf16)f2bf(st); st = de[i] * st + kv[i]; }
        }
    }
}
__device__ __forceinline__ void ph_moba_attn(Frame& F) {
    const int tid = tid_now(), lane = tid & 63, wave = __builtin_amdgcn_readfirstlane(tid >> 6); (void)lane; (void)wave;
    unsigned char* const wsl = opaque(F.ws);
    const bf16* Pa = (const bf16*)(wsl + WS_PA); const unsigned* sel = (const unsigned*)(wsl + WS_SEL); bf16* Y = (bf16*)(wsl + WS_Y);
    LAS float* pl = (LAS float*)(F.lds + wave * 8192);
    const LAS float* bias2 = (const LAS float*)(F.lds + LTAB_OFF);
    const LAS int* bucket = (const LAS int*)(F.lds + LTAB_OFF + 1024);
    const int gw = blockIdx.x * 8 + wave, NGW = F.G * 8;
    for (int it = gw; it < T_ * 8; it += NGW) {
        const int r = it >> 3, h = it & 7, b = r >> 13, s = r & (SEQ - 1), qb = s >> 8;
        const unsigned sw = sel[(size_t)r * 8 + h]; const int nv = (int)(sw >> 24);
        float q[64];
#pragma unroll
        for (int c = 0; c < 8; ++c) { float t8[8]; unpack8(*(const u32x4*)(Pa + (size_t)r * NPA + h * 64 + c * 8), t8);
#pragma unroll
            for (int e = 0; e < 8; ++e) q[c * 8 + e] = t8[e]; }
        float sc[4][4]; float mx = -INFINITY;
#pragma unroll
        for (int i = 0; i < 4; ++i) {
            const bool valid = (i < 3) ? (i < nv) : true;
            const int blk = (i < 3) ? (int)((sw >> (8 * i)) & 0xffu) : qb;
            if (valid) {
#pragma unroll
                for (int kk = 0; kk < 4; ++kk) {
                    const int kpos = blk * 256 + lane + 64 * kk;
                    const bf16* kp = Pa + (size_t)(b * SEQ + kpos) * NPA + 512 + h * 64;
                    float d = 0.f;
#pragma unroll
                    for (int c = 0; c < 8; ++c) { float t8[8]; unpack8(*(const u32x4*)(kp + c * 8), t8);
#pragma unroll
                        for (int e = 0; e < 8; ++e) d += q[c * 8 + e] * t8[e]; }
                    const int rel = s - kpos;
                    const float v = (rel < 0) ? -INFINITY : d + bias2[h * 32 + bucket[rel > 255 ? 255 : rel]];
                    sc[i][kk] = v; mx = fmaxf(mx, v);
                    asm volatile("" ::: "memory");
                }
            } else {
#pragma unroll
                for (int kk = 0; kk < 4; ++kk) sc[i][kk] = -INFINITY;
            }
        }
        mx = wave_max(mx);
        float ls = 0.f;
#pragma unroll
        for (int i = 0; i < 4; ++i)
#pragma unroll
            for (int kk = 0; kk < 4; ++kk) { const float p = __builtin_amdgcn_exp2f(sc[i][kk] - mx); ls += p; pl[i * 256 + lane + 64 * kk] = p; }
        ls = wave_sum(ls);
        LDS_WAIT(); asm volatile("" ::: "memory");
        float acc[8];
#pragma unroll
        for (int e = 0; e < 8; ++e) acc[e] = 0.f;
#pragma unroll
        for (int i = 0; i < 4; ++i) {
            const bool valid = (i < 3) ? (i < nv) : true;
            const int blk = (i < 3) ? (int)((sw >> (8 * i)) & 0xffu) : qb;
            if (valid) {
                const bf16* vp = Pa + (size_t)(b * SEQ + blk * 256 + (lane >> 3)) * NPA + 1024 + h * 64 + (lane & 7) * 8;
#pragma unroll 4
                for (int k0 = 0; k0 < 256; k0 += 8) {
                    const float p = pl[i * 256 + k0 + (lane >> 3)];
                    float t8[8]; unpack8(*(const u32x4*)(vp + (size_t)k0 * NPA), t8);
#pragma unroll
                    for (int e = 0; e < 8; ++e) acc[e] += p * t8[e];
                }
            }
        }
#pragma unroll
        for (int e = 0; e < 8; ++e) { acc[e] += __shfl_xor(acc[e], 8); acc[e] += __shfl_xor(acc[e], 16); acc[e] += __shfl_xor(acc[e], 32); }
        const float inv = 1.f / ls;
        if (lane < 8) { float o[8];
#pragma unroll
            for (int e = 0; e < 8; ++e) o[e] = acc[e] * inv;
            *(u32x4*)(Y + (size_t)r * NYC + 512 + h * 64 + lane * 8) = pack8(o); }
        asm volatile("" ::: "memory");
    }
}
__device__ __forceinline__ void ph_gla_out(Frame& F, int l) {
    const int tid = tid_now(), lane = tid & 63, wave = __builtin_amdgcn_readfirstlane(tid >> 6); (void)lane; (void)wave;
    unsigned char* const wsl = opaque(F.ws);
    const bf16* Pg = (const bf16*)(wsl + WS_PG); const bf16* GK = (const bf16*)(wsl + WS_GLA); bf16* Y = (bf16*)(wsl + WS_Y);
    LAS float* zs = (LAS float*)F.lds; LAS float* wa = zs + 1024; LAS float* ba = wa + 1024; LAS float* bt = ba + 64; LAS float* la = bt + 64;
    LAS float* qe = la + 64 * 65; LAS float* ke = qe + 64 * 65; LAS float* vs = ke + 64 * 65; LAS float* sp = vs + 64 * 128; LAS float* red = sp + 64 * 128;
        for (int unit = blockIdx.x; unit < 2048; unit += F.G) {
        const int h = unit & 3, cg = unit >> 2, b = cg >> 7, ch = cg & 127, r0 = b * SEQ + ch * 64;
        gla_bcum(F, l, r0, h, zs, wa, ba, bt, la);
        { const int d = tid & 63, j0 = (tid >> 6) * 8;
#pragma unroll
          for (int jj = 0; jj < 8; ++jj) { const int j = j0 + jj; const float bc = la[j * 65 + d];
              qe[j * 65 + d] = bf1(Pg[(size_t)(r0 + j) * NPG + h * 64 + d]) * 0.125f * __expf(bc);
              ke[j * 65 + d] = bf1(Pg[(size_t)(r0 + j) * NPG + 256 + h * 64 + d]) * __expf(-bc); } }
        for (int i = tid; i < 64 * 128; i += 512) { const int j = i >> 7, v = i & 127; vs[i] = bf1(Pg[(size_t)(r0 + j) * NPG + 512 + h * 128 + v]); }
        { const bf16* s = GK + ((size_t)((b * 4 + h) * 128 + ch)) * 8192; for (int i = tid; i < 8192; i += 512) sp[i] = bf1(s[i]); }
        __syncthreads();
        { const int j = tid & 63, i0 = (tid >> 6) * 8;
#pragma unroll
          for (int ii = 0; ii < 8; ++ii) { const int i = i0 + ii; float a = 0.f;
              if (j <= i) {
#pragma unroll 8
                  for (int d = 0; d < 64; ++d) a += qe[i * 65 + d] * ke[j * 65 + d]; }
              la[i * 65 + j] = a; } }
        __syncthreads();
        { const int v = tid & 127, i0 = (tid >> 7) * 16; float acc[16];
#pragma unroll
          for (int ii = 0; ii < 16; ++ii) acc[ii] = 0.f;
#pragma unroll 1
          for (int j = 0; j < 64; ++j) { const float vv = vs[j * 128 + v], sv = sp[j * 128 + v];
#pragma unroll
              for (int ii = 0; ii < 16; ++ii) acc[ii] += la[(i0 + ii) * 65 + j] * vv + qe[(i0 + ii) * 65 + j] * sv; }
#pragma unroll
          for (int ii = 0; ii < 16; ++ii) { const float s2 = wave_sum(acc[ii] * acc[ii]); if ((tid & 63) == 0) red[(i0 + ii) * 2 + ((tid >> 6) & 1)] = s2; }
          __syncthreads();
          const float gn = F.inp(10)[l * 128 + v];
#pragma unroll
          for (int ii = 0; ii < 16; ++ii) { const int i = i0 + ii; const float rs = rsqrtf((red[i * 2] + red[i * 2 + 1]) * (1.f / 128.f) + RMS_EPS);
              const float rr = bf1(Pg[(size_t)(r0 + i) * NPG + 1024 + h * 128 + v]);
              Y[(size_t)(r0 + i) * NYC + 1024 + h * 128 + v] = (bf16)f2bf(acc[ii] * rs * gn * (rr * sigmoidf_(rr))); } }
        __syncthreads();
    }
}
__device__ __forceinline__ void ph_norm_router(Frame& F, int l) {
    const int tid = tid_now(), lane = tid & 63, wave = __builtin_amdgcn_readfirstlane(tid >> 6); (void)lane; (void)wave;
    unsigned char* const wsl = opaque(F.ws);
    const int gw = blockIdx.x * 8 + wave, NGW = F.G * 8;
    const float* gain = F.inp(14) + (size_t)l * 1024; bf16* H = (bf16*)(wsl + WS_H);
    const float* wrg = F.inp(15) + (size_t)l * 1024 * 4; const float* brg = F.inp(16) + l * 4;
    const float* wre = F.inp(17) + (size_t)l * 1024 * 32; const float* bre = F.inp(18) + l * 32;
    int* toke = (int*)(wsl + WS_TOKE); float* tokw = (float*)(wsl + WS_TOKW);
    LAS unsigned* hist = (LAS unsigned*)(F.lds + LTAB_OFF);
    if (tid < 32) hist[tid] = 0u;
    __syncthreads();
    f32x4 g[4];
#pragma unroll
    for (int j = 0; j < 4; ++j) g[j] = *((const f32x4*)gain + 64 * j + lane);
    for (int m = gw; m < T_; m += NGW) {
        const f32x4* xr = (const f32x4*)(F.out + (size_t)m * 1024) + lane;
        f32x4 v[4]; float ss = 0.f;
#pragma unroll
        for (int j = 0; j < 4; ++j) { v[j] = xr[64 * j]; ss += (v[j].x * v[j].x + v[j].y * v[j].y) + (v[j].z * v[j].z + v[j].w * v[j].w); }
        const float rs = rsqrtf(wave_sum(ss) * (1.f / 1024.f) + RMS_EPS);
        u32x2* o8 = (u32x2*)(H + (size_t)m * 1024) + lane;
#pragma unroll
        for (int j = 0; j < 4; ++j) { v[j] = v[j] * rs * g[j]; u32x2 w; w.x = pk2(v[j].x, v[j].y); w.y = pk2(v[j].z, v[j].w); o8[64 * j] = w; }
        float lg[4] = {0.f, 0.f, 0.f, 0.f};
#pragma unroll
        for (int j = 0; j < 4; ++j)
#pragma unroll
            for (int e = 0; e < 4; ++e) { const int k = 4 * (64 * j + lane) + e; const f32x4 w = *(const f32x4*)(wrg + (size_t)k * 4); const float hv = v[j][e];
                lg[0] += hv * w.x; lg[1] += hv * w.y; lg[2] += hv * w.z; lg[3] += hv * w.w; }
#pragma unroll
        for (int i = 0; i < 4; ++i) lg[i] = wave_sum(lg[i]) + brg[i];
        int grp = 0; float gm = lg[0];
#pragma unroll
        for (int i = 1; i < 4; ++i) if (lg[i] > gm) { gm = lg[i]; grp = i; }
        float gs = 0.f;
#pragma unroll
        for (int i = 0; i < 4; ++i) gs += __expf(lg[i] - gm);
        const float pgt = 1.f / gs;
        float le[8];
#pragma unroll
        for (int i = 0; i < 8; ++i) le[i] = 0.f;
#pragma unroll
        for (int j = 0; j < 4; ++j)
#pragma unroll
            for (int e = 0; e < 4; ++e) { const int k = 4 * (64 * j + lane) + e; const float* wp = wre + (size_t)k * 32 + grp * 8; const f32x4 w0 = *(const f32x4*)wp, w1 = *(const f32x4*)(wp + 4); const float hv = v[j][e];
                le[0] += hv * w0.x; le[1] += hv * w0.y; le[2] += hv * w0.z; le[3] += hv * w0.w; le[4] += hv * w1.x; le[5] += hv * w1.y; le[6] += hv * w1.z; le[7] += hv * w1.w; }
#pragma unroll
        for (int i = 0; i < 8; ++i) le[i] = wave_sum(le[i]) + bre[grp * 8 + i];
        int e0 = 0; float m0 = le[0];
#pragma unroll
        for (int i = 1; i < 8; ++i) if (le[i] > m0) { m0 = le[i]; e0 = i; }
        int e1 = -1; float m1 = -INFINITY;
#pragma unroll
        for (int i = 0; i < 8; ++i) if (i != e0 && le[i] > m1) { m1 = le[i]; e1 = i; }
        const float t = __expf(m1 - m0), w0 = pgt / (1.f + t), w1 = pgt * t / (1.f + t);
        if (lane == 0) { toke[2 * m] = grp * 8 + e0; toke[2 * m + 1] = grp * 8 + e1; tokw[2 * m] = w0; tokw[2 * m + 1] = w1;
            (void)__hip_atomic_fetch_add(&hist[grp * 8 + e0], 1u, __ATOMIC_RELAXED, __HIP_MEMORY_SCOPE_WORKGROUP); (void)__hip_atomic_fetch_add(&hist[grp * 8 + e1], 1u, __ATOMIC_RELAXED, __HIP_MEMORY_SCOPE_WORKGROUP); }
    }
    __syncthreads();
    if (tid < 32 && hist[tid]) (void)__hip_atomic_fetch_add(F.ctl + CW_CNT + l * 64 + tid, hist[tid], RLX_AGENT);
    __syncthreads();
}
__device__ __forceinline__ void ph_dispatch(Frame& F, int l) {
    const int tid = tid_now(), lane = tid & 63, wave = __builtin_amdgcn_readfirstlane(tid >> 6); (void)lane; (void)wave;
    unsigned char* const wsl = opaque(F.ws);
    LAS int* pstart = (LAS int*)(F.lds + LTAB_OFF); LAS int* cnt = pstart + 32; LAS unsigned* lhist = (LAS unsigned*)(cnt + 32); LAS int* lbase = (LAS int*)(lhist + 32);
    LAS int* rowof = lbase + 32;
        const int* toke = (const int*)(wsl + WS_TOKE); const float* tokw = (const float*)(wsl + WS_TOKW);
    int* toks = (int*)(wsl + WS_TOKS); float* roww = (float*)(wsl + WS_ROWW); int* blke = (int*)(wsl + WS_BLKE);
    const bf16* H = (const bf16*)(wsl + WS_H); bf16* xs = (bf16*)(wsl + WS_XS);
    if (tid < 32) { cnt[tid] = (int)__hip_atomic_load(F.ctl + CW_CNT + l * 64 + tid, RLX_AGENT); lhist[tid] = 0u; }
    __syncthreads();
    if (tid == 0) { int a = 0; for (int e = 0; e < 32; ++e) { pstart[e] = a; a += ((cnt[e] + 255) >> 8) << 8; } pstart[32 + 32 + 32 + 32 + 256] = a; }
    __syncthreads();
    const int total = pstart[32 + 32 + 32 + 32 + 256];
    if (blockIdx.x == 0) {
        for (int rb = tid; rb < 288; rb += 512) { int e = 31; for (int k = 31; k >= 0; --k) if (rb * 256 < pstart[k] + (((cnt[k] + 255) >> 8) << 8)) e = k; blke[rb] = e; }
        if (tid == 0) blke[300] = total >> 8;
    }
    for (int e = blockIdx.x; e < 32; e += F.G) {
        const int p0 = pstart[e] + cnt[e], p1 = pstart[e] + (((cnt[e] + 255) >> 8) << 8);
        for (int i = tid; i < (p1 - p0) * 128; i += 512) { const int rr = p0 + (i >> 7); *((u32x4*)(xs + (size_t)rr * 1024) + (i & 127)) = (u32x4){0u, 0u, 0u, 0u}; }
        for (int rr = p0 + tid; rr < p1; rr += 512) roww[rr] = 0.f;
    }
    const int tpw = T_ / F.G, t0 = blockIdx.x * tpw;
    int myexp = -1, myrank = 0;
    if (tid < 2 * tpw) { myexp = toke[2 * t0 + tid]; myrank = (int)__hip_atomic_fetch_add(&lhist[myexp], 1u, __ATOMIC_RELAXED, __HIP_MEMORY_SCOPE_WORKGROUP); }
    __syncthreads();
    if (tid < 32) lbase[tid] = lhist[tid] ? (int)__hip_atomic_fetch_add(F.ctl + CW_CUR + l * 64 + tid, lhist[tid], RLX_AGENT) : 0;
    __syncthreads();
    if (tid < 2 * tpw) { const int row = pstart[myexp] + lbase[myexp] + myrank; rowof[tid] = row; toks[2 * t0 + tid] = row; roww[row] = tokw[2 * t0 + tid]; }
    __syncthreads();
    for (int a = wave; a < 2 * tpw; a += 8) { const int row = rowof[a], t = t0 + (a >> 1);
        const u32x4* src = (const u32x4*)(H + (size_t)t * 1024) + lane; u32x4* dst = (u32x4*)(xs + (size_t)row * 1024) + lane;
        dst[0] = src[0]; dst[64] = src[64]; }
    __syncthreads();
}

struct Args { const float* in[22]; float* out; unsigned char* ws; int ph_lo, ph_hi; };
constexpr int NPH = 12;

__global__ void __launch_bounds__(512, 2) fwd_kernel(Args args) {
    extern __shared__ __attribute__((aligned(16))) unsigned char lds_raw[];
    Frame F;
    F.lds = (LAS unsigned char*)lds_raw;
    F.MISC = (volatile LAS unsigned*)(F.lds + MISC_OFF);
    F.tid = threadIdx.x; F.lane = F.tid & 63; F.wave = __builtin_amdgcn_readfirstlane(F.tid >> 6); F.G = gridDim.x;
    F.out = args.out; F.ws = args.ws; F.ctl = (unsigned*)(args.ws + WS_CTL);
    for (int u = F.tid; u < (LDS_BYTES - LDSCTL_OFF) / 4; u += 512) ((LAS unsigned*)(F.lds + LDSCTL_OFF))[u] = 0u;
    __syncthreads();
    if (F.tid < 22) ((LAS unsigned long long*)(F.lds + PTAB_OFF))[F.tid] = (unsigned long long)args.in[F.tid];
    __syncthreads();
    const int lo = args.ph_lo, hi = args.ph_hi;
    const bool use_bar = (hi - lo) > 1;
    XcdBarrier bar; bar.bar = F.ctl + CW_BAR; bar.x = 0; bar.st = nullptr;
    if (use_bar) bar = xcd_barrier_post(F.ctl + CW_BAR, F.MISC + 8);
#define IN(k) (lo <= (k) && (k) < hi)
#define SEAM(k) do { if (IN(k) && IN((k) + 1)) xcd_barrier(bar); } while (0)
    for (int l = 0; l < DEPTH; ++l) {
        const int pb = l * NPH;
#define WSL unsigned char* const ws = opaque(F.ws); unsigned char* const wmix = ws + WS_WMIX + (size_t)l * WMIX_LAYER; (void)wmix
        if (IN(pb + 0)) { WSL;
            if (l == 0) { PM(0) ph_convert_mixer(F); __syncthreads(); PM(11) ph_norm<false, true>(F, F.inp(0), F.inp(2), (bf16*)(ws + WS_H)); }
            else PM(12) ph_norm<true, true>(F, F.out, F.inp(2) + 1024, (bf16*)(ws + WS_H));
        }
        SEAM(pb + 0);
        if (IN(pb + 1)) { WSL;
            pg8::SchedPlain S{(const char*)(ws + WS_H), (const char*)(wmix + WO_WIN), 128, 19, F.G, (int)blockIdx.x, (size_t)256 * 1024 * 2, (size_t)256 * 1024 * 2};
            pg8::EpiInProj E{(bf16*)(ws + WS_PC), (bf16*)(ws + WS_PA), (bf16*)(ws + WS_PG)};
            PM(16) pg8::gemm_phase(F.lds, 1024, 1024, S, E);
        }
        SEAM(pb + 1);
        if (IN(pb + 2)) { PM(1) ph_conv(F, l); PM(2) ph_qknorm(F, l); __syncthreads(); PM(3) ph_gla_kv(F, l); }
        SEAM(pb + 2);
        if (IN(pb + 3)) { PM(4) ph_moba_gate(F); PM(5) ph_gla_scan(F); }
        SEAM(pb + 3);
        if (IN(pb + 4)) {
            { LAS float* bias2 = (LAS float*)(F.lds + LTAB_OFF); LAS int* bucket = (LAS int*)(F.lds + LTAB_OFF + 1024);
              if (F.tid < 256) { const int bk = F.tid >> 3, hh = F.tid & 7; bias2[hh * 32 + bk] = F.inp(1)[bk * 8 + hh] * LOG2E;
                  const int n = F.tid; int bq; if (n < 16) bq = n; else { const float sc = logf((float)n / 16.0f) / 2.0794415416798357f; bq = 16 + (int)(sc * 16.0f); if (bq > 31) bq = 31; }
                  bucket[n] = bq; }
              __syncthreads(); }
            PM(6) ph_moba_attn(F); __syncthreads(); PM(7) ph_gla_out(F, l);
        }
        SEAM(pb + 4);
        if (IN(pb + 5)) { WSL;
            pg8::SchedBranch S{(const char*)(ws + WS_Y), (const char*)(wmix + WO_WB), F.G, (int)blockIdx.x};
            pg8::EpiBranch E{(bf16*)(ws + WS_BB)};
            PM(17) pg8::gemm_phase(F.lds, 512, NYC, S, E);
        }
        SEAM(pb + 5);
        if (IN(pb + 6)) { WSL;
            pg8::SchedGate S{(const char*)(ws + WS_H), (const char*)(wmix + WO_WG), F.G, (int)blockIdx.x};
            pg8::EpiGateMerge E{(const bf16*)(ws + WS_BB), (bf16*)(ws + WS_MRG)};
            PM(18) pg8::gemm_phase(F.lds, 1024, 1024, S, E);
        }
        SEAM(pb + 6);
        if (IN(pb + 7)) { WSL;
            pg8::SchedPlain S{(const char*)(ws + WS_MRG), (const char*)(wmix + WO_WO), 128, 4, F.G, (int)blockIdx.x, (size_t)256 * 1024 * 2, (size_t)256 * 1024 * 2};
            pg8::EpiOut E{l == 0 ? F.inp(0) : (const float*)F.out, F.out};
            PM(19) pg8::gemm_phase(F.lds, 1024, 1024, S, E);
        }
        SEAM(pb + 7);
        if (IN(pb + 8)) { PM(8) ph_norm_router(F, l); PM(9) ph_convert_experts(F, l); }
        SEAM(pb + 8);
        if (IN(pb + 9)) PM(10) ph_dispatch(F, l);
        SEAM(pb + 9);
        if (IN(pb + 10) || IN(pb + 11)) { WSL;
            LAS int* tab = (LAS int*)(F.lds + LTAB_OFF + 2048);
            const int* blke = (const int*)(ws + WS_BLKE);
            for (int i = F.tid; i < 304; i += 512) tab[i] = blke[i];
            __syncthreads();
            const int nblk = tab[300];
            if (IN(pb + 10)) {
                pg8::SchedMoe S{(const char*)(ws + WS_XS), (const char*)(ws + WS_W1T), tab, nblk * 4, F.G, (int)blockIdx.x, (size_t)256 * 1024 * 2, (size_t)1024 * 1024 * 2, (size_t)256 * 1024 * 2};
                pg8::EpiSwiGLU E{(bf16*)(ws + WS_ACT)};
                PM(20) pg8::gemm_phase(F.lds, 1024, 1024, S, E);
            }
            SEAM(pb + 10);
            if (IN(pb + 11)) {
                pg8::SchedMoe S{(const char*)(ws + WS_ACT), (const char*)(ws + WS_WDT), tab, nblk * 4, F.G, (int)blockIdx.x, (size_t)256 * 512 * 2, (size_t)1024 * 512 * 2, (size_t)256 * 512 * 2};
                pg8::EpiMoeDown E{(bf16*)(ws + WS_YS), (const float*)(ws + WS_ROWW)};
                PM(21) pg8::gemm_phase(F.lds, 512, 512, S, E);
            }
        }
        SEAM(pb + 11);
    }
    if (IN(2 * NPH)) PM(13) ph_norm<true, false>(F, F.out, nullptr, nullptr);
#undef IN
#undef SEAM
#undef WSL
}

extern "C" void kernel_launch(void* const* d_in, const int* in_sizes, int n_in, void* d_out, int out_size, void* d_ws, size_t ws_size, hipStream_t stream) {
    static int grid = 0;
    if (grid == 0) {
        if (n_in != 22 || out_size != T_ * DM || ws_size < WS_END) { fprintf(stderr, "kernel_launch: unexpected shapes (n_in %d out %d ws %zu)\n", n_in, out_size, ws_size); grid = -1; return; }
        if (hipFuncSetAttribute((const void*)fwd_kernel, hipFuncAttributeMaxDynamicSharedMemorySize, LDS_BYTES) != hipSuccess) { fprintf(stderr, "kernel_launch: hipFuncSetAttribute failed\n"); grid = -1; return; }
        int dev = 0, cus = 0, per_cu = 0;
        hipGetDevice(&dev); hipDeviceGetAttribute(&cus, hipDeviceAttributeMultiprocessorCount, dev);
        if (hipOccupancyMaxActiveBlocksPerMultiprocessor(&per_cu, (const void*)fwd_kernel, 512, LDS_BYTES) != hipSuccess || per_cu < 1) fprintf(stderr, "kernel_launch: occupancy query reports %d\n", per_cu);
        (void)hipGetLastError();
        grid = cus > 256 ? 256 : cus;
    }
    if (grid < 0) return;
    (void)hipMemsetAsync((char*)d_ws + WS_CTL, 0, CTL_ZERO_BYTES, stream);
    Args a{};
    for (int i = 0; i < 22; ++i) a.in[i] = (const float*)d_in[i];
    a.out = (float*)d_out; a.ws = (unsigned char*)d_ws; a.ph_lo = 0; a.ph_hi = 2 * NPH + 1;
    hipLaunchKernelGGL(fwd_kernel, dim3(grid), dim3(512), LDS_BYTES, stream, a);
}
```

```cpp
#include <hip/hip_runtime.h>
#include <cstdio>
#include <cstdint>

#define LAS __attribute__((address_space(3)))
#ifndef PHASE_MASK
#define PHASE_MASK 0xffffffffu
#endif
#define PM(k) if ((PHASE_MASK >> (k)) & 1u)
#define GAS __attribute__((address_space(1)))
typedef unsigned short bf16;
typedef short bf16x8 __attribute__((ext_vector_type(8)));
typedef float f32x4 __attribute__((ext_vector_type(4)));
typedef float f32x2 __attribute__((ext_vector_type(2)));
typedef unsigned u32x4 __attribute__((ext_vector_type(4)));
typedef unsigned u32x2 __attribute__((ext_vector_type(2)));
typedef GAS unsigned gu32;

constexpr int T_ = 32768, SEQ = 8192, DM = 1024, DEPTH = 2;
constexpr int NPC = 1536, NPA = 1536, NPG = 1792, NIN = 4864;
constexpr int NYC = 1536;
constexpr int MAXROWS = 73728;
constexpr float RMS_EPS = 1e-6f;
constexpr float LOG2E = 1.4426950408889634f;
constexpr float QSCALE = 0.125f * LOG2E;

constexpr size_t MiB = 1u << 20;
constexpr size_t WS_CTL = 0, CTL_ZERO_BYTES = 1 * MiB;
constexpr size_t WS_MISC = 1 * MiB;
constexpr size_t WS_KMEAN = WS_MISC;
constexpr size_t WS_SEL = WS_MISC + 256 * 1024;
constexpr size_t WS_DEC = WS_SEL + 1 * MiB;
constexpr size_t WS_TOKE = WS_DEC + 512 * 1024;
constexpr size_t WS_TOKW = WS_TOKE + 256 * 1024;
constexpr size_t WS_TOKS = WS_TOKW + 256 * 1024;
constexpr size_t WS_ROWW = WS_TOKS + 256 * 1024;
constexpr size_t WS_BLKE = WS_ROWW + 288 * 1024;
constexpr size_t WS_WMIX = 8 * MiB;
constexpr size_t WMIX_LAYER = 22 * MiB;
constexpr size_t WO_WIN = 0, WO_WG = (size_t)NIN * 1024 * 2, WO_WB = WO_WG + (size_t)3072 * 1024 * 2, WO_WO = WO_WB + (size_t)3 * 1024 * 512 * 2;
constexpr size_t WS_H = 52 * MiB;
constexpr size_t WS_PC = 116 * MiB;
constexpr size_t WS_PA = 212 * MiB;
constexpr size_t WS_PG = 308 * MiB;
constexpr size_t WS_Y = 420 * MiB;
constexpr size_t WS_GLA = 516 * MiB;
constexpr size_t WS_ML = 548 * MiB;
constexpr size_t WS_END = 556 * MiB;
constexpr size_t WS_OP = WS_PC;
constexpr size_t WS_BB = WS_PC;
constexpr size_t WS_MRG = WS_PG;
constexpr size_t WS_W1T = WS_Y;
constexpr size_t WS_WDT = WS_Y + 64 * MiB;
constexpr size_t WS_XS = WS_PC;
constexpr size_t WS_ACT = WS_PG;
constexpr size_t WS_YS = WS_PC;
static_assert(WMIX_LAYER >= WO_WO + (size_t)1024 * 1024 * 2, "mixer weights fit");
static_assert(WS_WMIX + 2 * WMIX_LAYER <= WS_H && WS_BLKE + 2048 <= WS_WMIX, "map");
static_assert((size_t)MAXROWS * 1024 * 2 <= WS_PG - WS_PC && (size_t)MAXROWS * 512 * 2 <= WS_Y - WS_PG, "moe aliases fit");

constexpr int CW_BAR = 4096;
constexpr int CW_CNT = 16384;
constexpr int CW_CUR = 16384 + 256;
constexpr int CW_Q = 16384 + 512;

constexpr int RING_BYTES = 131072;
constexpr int LDSCTL_OFF = RING_BYTES;
constexpr int MISC_OFF = LDSCTL_OFF + 320;
constexpr int PTAB_OFF = LDSCTL_OFF + 512;
constexpr int LTAB_OFF = LDSCTL_OFF + 1024;
constexpr int LDS_BYTES = 147456;

#define RLX_AGENT __ATOMIC_RELAXED, __HIP_MEMORY_SCOPE_AGENT
__device__ __forceinline__ float bflo(unsigned w) { return __uint_as_float(w << 16); }
__device__ __forceinline__ float bfhi(unsigned w) { return __uint_as_float(w & 0xffff0000u); }
__device__ __forceinline__ float bf1(bf16 b) { return __uint_as_float((unsigned)b << 16); }
__device__ __forceinline__ unsigned f2bf(float f) { unsigned u = __float_as_uint(f); return (u + 0x7fffu + ((u >> 16) & 1u)) >> 16; }
__device__ __forceinline__ unsigned pk2(float lo, float hi) { return f2bf(lo) | (f2bf(hi) << 16); }
__device__ __forceinline__ void unpack8(const u32x4 w, float (&v)[8]) {
    v[0] = bflo(w.x); v[1] = bfhi(w.x); v[2] = bflo(w.y); v[3] = bfhi(w.y); v[4] = bflo(w.z); v[5] = bfhi(w.z); v[6] = bflo(w.w); v[7] = bfhi(w.w);
}
__device__ __forceinline__ u32x4 pack8(const float (&v)[8]) { u32x4 w; w.x = pk2(v[0], v[1]); w.y = pk2(v[2], v[3]); w.z = pk2(v[4], v[5]); w.w = pk2(v[6], v[7]); return w; }
__device__ __forceinline__ float wave_sum(float v) {
#pragma unroll
    for (int o = 1; o < 64; o <<= 1) v += __shfl_xor(v, o);
    return v;
}
__device__ __forceinline__ float wave_max(float v) {
#pragma unroll
    for (int o = 1; o < 64; o <<= 1) v = fmaxf(v, __shfl_xor(v, o));
    return v;
}
__device__ __forceinline__ float sigmoidf_(float x) { return __builtin_amdgcn_rcpf(1.0f + __builtin_amdgcn_exp2f(-x * LOG2E)); }

__device__ __forceinline__ int tid_now_() { int t = threadIdx.x; asm volatile("" : "+v"(t)); return t; }
namespace pg8 {
constexpr int BM = 256, BK = 64, HALF = 128, HTB = HALF * BK * 2, STAGE_BYTES = 8 * HTB;
__host__ __device__ __forceinline__ int lds_byte(int r, int c) { const int st = (r >> 4) * 2 + (c >> 5), rr = r & 15, cc = c & 31, ob = rr * 64 + cc * 2; return st * 1024 + (ob ^ (((ob >> 9) & 1) << 5)); }
__host__ __device__ __forceinline__ void stage_rc(int b, int& R, int& C) { const int st = b / 1024, sb = b % 1024, swz = sb ^ (((sb >> 9) & 1) << 5); R = (st >> 1) * 16 + swz / 64; C = (st & 1) * 32 + (swz % 64) / 2; }
__host__ __device__ __forceinline__ int perm32(int rho) { const int n = rho >> 4, i = rho & 15; return 8 * (i >> 2) + 4 * n + (i & 3); }
struct Unit { int pm, pn, z; };
__device__ __forceinline__ void tile_map(int w, int nM, int nN, int& pm, int& pn) {
    const int nwg = nM * nN, q = nwg / 8, r = nwg % 8, xcd = w % 8, off = w / 8;
    const int wg = (xcd < r ? xcd * (q + 1) : r * (q + 1) + (xcd - r) * q) + off;
    const int nig = 8 * nN, gid = wg / nig, fm = gid * 8, gsz = (nM - fm) < 8 ? (nM - fm) : 8;
    pm = fm + ((wg % nig) % gsz); pn = (wg % nig) / gsz;
}
__device__ __forceinline__ unsigned cvt_pk_bf16(float lo, float hi) { unsigned r; asm volatile("v_cvt_pk_bf16_f32 %0, %1, %2" : "=v"(r) : "v"(lo), "v"(hi)); return r; }

template <class Epi, class Sched>
__device__ __forceinline__ void gemm_phase(LAS unsigned char* lds, const int K, const int lda, const Sched& S, const Epi& E) {
    const int tid = tid_now_(), wid = __builtin_amdgcn_readfirstlane(tid >> 6), lane = tid & 63, wr = wid >> 2, wc = wid & 3, fr = lane & 15, fq = lane >> 4;
    const int nt = K / BK;
    unsigned voffA[2], voffB[2];
#pragma unroll
    for (int i = 0; i < 2; ++i) { int R, C; stage_rc(tid * 16 + i * 8192, R, C); const int Rb = Epi::PERM ? ((R & ~31) + perm32(R & 31)) : R;
        voffA[i] = (unsigned)(R * lda + C) * 2u; voffB[i] = (unsigned)(Rb * K + C) * 2u; }
    const size_t kstep = (size_t)(BK * 2);
    const size_t hstepA = (size_t)HALF * lda * 2, hstepB = (size_t)HALF * K * 2;
    const unsigned ldsw = (unsigned)wid * 1024u;
    const int aoff = lds_byte(wr * 64 + fr, fq * 8), boff = lds_byte(wc * 32 + fr, fq * 8);
#define PG8_SA(b, h) (((b) * 2 + (h)) * HTB)
#define PG8_SB(b, h) ((4 + (b) * 2 + (h)) * HTB)
#define PG8_STAGE(bufoff, gbase, voff) do { _Pragma("unroll") for (int _i = 0; _i < 2; ++_i) \
        __builtin_amdgcn_global_load_lds((const unsigned*)((const char*)(gbase) + (voff)[_i]), (LAS unsigned*)(lds + (bufoff) + ldsw + _i * 8192), 16, 0, 0); } while (0)
#define PG8_LDA(dst, b, h) do { _Pragma("unroll") for (int m = 0; m < 4; ++m) _Pragma("unroll") for (int k = 0; k < 2; ++k) dst[m][k] = *(const LAS bf16x8*)(lds + PG8_SA(b, h) + aoff + m * 2048 + k * 1024); } while (0)
#define PG8_LDB(dst, b, h) do { _Pragma("unroll") for (int n = 0; n < 2; ++n) _Pragma("unroll") for (int k = 0; k < 2; ++k) dst[n][k] = *(const LAS bf16x8*)(lds + PG8_SB(b, h) + boff + n * 2048 + k * 1024); } while (0)
#define PG8_MMA(ai, bj, At, Bt) do { __builtin_amdgcn_s_setprio(1); _Pragma("unroll") for (int m = 0; m < 4; ++m) _Pragma("unroll") for (int n = 0; n < 2; ++n) _Pragma("unroll") for (int k = 0; k < 2; ++k) \
        acc[ai][bj][m][n] = __builtin_amdgcn_mfma_f32_16x16x32_bf16(Bt[n][k], At[m][k], acc[ai][bj][m][n], 0, 0, 0); __builtin_amdgcn_s_setprio(0); } while (0)
#define PG8_WAIT_V(n) asm volatile("s_waitcnt vmcnt(" #n ")" ::: "memory")
#define PG8_WAIT_L(n) asm volatile("s_waitcnt lgkmcnt(" #n ")" ::: "memory")
#define PG8_BAR __builtin_amdgcn_s_barrier()
#define PG8_SCHED __builtin_amdgcn_sched_barrier(0)
    Unit cur, nxt; int ui = 0;
    if (!S.next(0, cur)) return;
    f32x4 acc[2][2][4][2];
#pragma unroll
    for (int a = 0; a < 2; ++a)
#pragma unroll
        for (int b = 0; b < 2; ++b)
#pragma unroll
            for (int m = 0; m < 4; ++m)
#pragma unroll
                for (int n = 0; n < 2; ++n) acc[a][b][m][n] = (f32x4){0.f, 0.f, 0.f, 0.f};
    bf16x8 At[4][2], B0[2][2], B1[2][2];
    const char* cA = S.a_ptr(cur); const char* cB = S.b_ptr(cur);
    PG8_STAGE(PG8_SB(0, 0), cB, voffB); PG8_STAGE(PG8_SB(0, 1), cB + hstepB, voffB); PG8_STAGE(PG8_SA(0, 0), cA, voffA); PG8_STAGE(PG8_SA(0, 1), cA + hstepA, voffA);
    if (wr == 1) PG8_BAR;
    PG8_WAIT_V(2); PG8_BAR;
    PG8_STAGE(PG8_SB(1, 0), cB + kstep, voffB); PG8_STAGE(PG8_SA(1, 0), cA + kstep, voffA); PG8_STAGE(PG8_SB(1, 1), cB + hstepB + kstep, voffB);
    PG8_WAIT_V(6); PG8_BAR;
    for (;;) {
        const bool has_next = S.next(ui + 1, nxt);
        const char* nA = has_next ? S.a_ptr(nxt) : cA; const char* nB = has_next ? S.b_ptr(nxt) : cB;
        for (int t = 0; t < nt; t += 2) {
            const bool last = (t == nt - 2);
            const char* a1 = cA + (size_t)(t + 1) * kstep;
            const char* a2 = last ? nA : cA + (size_t)(t + 2) * kstep; const char* b2 = last ? nB : cB + (size_t)(t + 2) * kstep;
            const char* a3 = a2 + kstep; const char* b3 = b2 + kstep;
            PG8_LDB(B0, 0, 0); PG8_LDB(B1, 0, 1); PG8_SCHED; PG8_LDA(At, 0, 0); PG8_STAGE(PG8_SA(1, 1), a1 + hstepA, voffA);
            PG8_WAIT_V(8); PG8_WAIT_L(0); PG8_BAR; PG8_MMA(0, 0, At, B0); PG8_MMA(0, 1, At, B1); PG8_BAR; PG8_SCHED;
            PG8_LDA(At, 0, 1); PG8_STAGE(PG8_SB(0, 0), b2, voffB); PG8_STAGE(PG8_SB(0, 1), b2 + hstepB, voffB); PG8_STAGE(PG8_SA(0, 0), a2, voffA);
            PG8_WAIT_V(8); PG8_WAIT_L(0); PG8_BAR; PG8_MMA(1, 0, At, B0); PG8_MMA(1, 1, At, B1); PG8_BAR; PG8_SCHED;
            PG8_LDB(B0, 1, 0); PG8_LDB(B1, 1, 1); PG8_SCHED; PG8_LDA(At, 1, 0); PG8_STAGE(PG8_SA(0, 1), a2 + hstepA, voffA);
            PG8_WAIT_V(8); PG8_WAIT_L(0); PG8_BAR; PG8_MMA(0, 0, At, B0); PG8_MMA(0, 1, At, B1); PG8_BAR; PG8_SCHED;
            PG8_LDA(At, 1, 1); PG8_STAGE(PG8_SB(1, 0), b3, voffB); PG8_STAGE(PG8_SB(1, 1), b3 + hstepB, voffB); PG8_STAGE(PG8_SA(1, 0), a3, voffA);
            PG8_WAIT_V(8); PG8_WAIT_L(0); PG8_BAR; PG8_MMA(1, 0, At, B0); PG8_MMA(1, 1, At, B1); PG8_BAR; PG8_SCHED;
        }
        if (wr == 0) PG8_BAR;
        E(acc, cur, wr, wc, fr, fq);
        if (!has_next) break;
#pragma unroll
        for (int a = 0; a < 2; ++a)
#pragma unroll
            for (int b = 0; b < 2; ++b)
#pragma unroll
                for (int m = 0; m < 4; ++m)
#pragma unroll
                    for (int n = 0; n < 2; ++n) acc[a][b][m][n] = (f32x4){0.f, 0.f, 0.f, 0.f};
        cur = nxt; cA = nA; cB = nB; ++ui;
        if (wr == 1) PG8_BAR;
    }
    PG8_WAIT_V(0);
    PG8_BAR;
#undef PG8_SA
#undef PG8_SB
#undef PG8_STAGE
#undef PG8_LDA
#undef PG8_LDB
#undef PG8_MMA
#undef PG8_WAIT_V
#undef PG8_WAIT_L
#undef PG8_BAR
#undef PG8_SCHED
}

struct SchedPlain {
    const char* A; const char* Bt; int nM, nN, G, c; size_t astep, bstep;
    __device__ __forceinline__ bool next(int i, Unit& u) const { const int L = i * G + c; if (L >= nM * nN) return false; tile_map(L, nM, nN, u.pm, u.pn); u.z = 0; return true; }
    __device__ __forceinline__ const char* a_ptr(const Unit& u) const { return A + (size_t)u.pm * astep; }
    __device__ __forceinline__ const char* b_ptr(const Unit& u) const { return Bt + (size_t)u.pn * bstep; }
};
struct SchedBranch {
    const char* Y; const char* Wb; int G, c;
    __device__ __forceinline__ bool next(int i, Unit& u) const { const int L = i * G + c; if (L >= 1536) return false; u.z = L / 512; tile_map(L % 512, 128, 4, u.pm, u.pn); return true; }
    __device__ __forceinline__ const char* a_ptr(const Unit& u) const { return Y + (size_t)u.pm * (256 * NYC * 2) + (size_t)u.z * 1024; }
    __device__ __forceinline__ const char* b_ptr(const Unit& u) const { return Wb + (size_t)u.z * (1024 * 512 * 2) + (size_t)u.pn * (256 * 512 * 2); }
};
struct SchedGate {
    const char* H; const char* Wg; int G, c;
    __device__ __forceinline__ bool next(int i, Unit& u) const { const int L = (i / 3) * G + c; if (L >= 512) return false; u.z = i % 3; tile_map(L, 128, 4, u.pm, u.pn); return true; }
    __device__ __forceinline__ const char* a_ptr(const Unit& u) const { return H + (size_t)u.pm * (256 * 1024 * 2); }
    __device__ __forceinline__ const char* b_ptr(const Unit& u) const { return Wg + (size_t)(u.z * 4 + u.pn) * (256 * 1024 * 2); }
};
struct SchedMoe {
    const char* A; const char* W; const LAS int* blk_e; int nU, G, c; size_t astep, estep, bstep;
    __device__ __forceinline__ bool next(int i, Unit& u) const { const int L = i * G + c; if (L >= nU) return false; u.pm = L >> 2; u.pn = L & 3; u.z = blk_e[u.pm]; return true; }
    __device__ __forceinline__ const char* a_ptr(const Unit& u) const { return A + (size_t)u.pm * astep; }
    __device__ __forceinline__ const char* b_ptr(const Unit& u) const { return W + (size_t)u.z * estep + (size_t)u.pn * bstep; }
};

#define EPI_ROWS_BEGIN _Pragma("unroll") for (int ai = 0; ai < 2; ++ai) _Pragma("unroll") for (int m = 0; m < 4; ++m)
struct EpiInProj {
    static constexpr bool PERM = true;
    bf16* Pc; bf16* Pa; bf16* Pg;
    __device__ __forceinline__ void operator()(const f32x4 (&acc)[2][2][4][2], const Unit& u, int wr, int wc, int fr, int fq) const {
        bf16* base; int ld, colt;
        if (u.pn < 6) { base = Pc; ld = NPC; colt = u.pn * 256; } else if (u.pn < 12) { base = Pa; ld = NPA; colt = (u.pn - 6) * 256; } else { base = Pg; ld = NPG; colt = (u.pn - 12) * 256; }
        const int row0 = u.pm * BM + wr * 64 + fr, col0 = colt + wc * 32 + 8 * fq;
        EPI_ROWS_BEGIN { bf16* rowp = base + (size_t)(row0 + ai * HALF + m * 16) * ld + col0;
#pragma unroll
            for (int bj = 0; bj < 2; ++bj) { const f32x4 v0 = acc[ai][bj][m][0], v1 = acc[ai][bj][m][1];
                u32x4 w; w.x = cvt_pk_bf16(v0[0], v0[1]); w.y = cvt_pk_bf16(v0[2], v0[3]); w.z = cvt_pk_bf16(v1[0], v1[1]); w.w = cvt_pk_bf16(v1[2], v1[3]);
                *(u32x4*)(rowp + bj * HALF) = w; } }
    }
};
struct EpiBranch {
    static constexpr bool PERM = true;
    bf16* Bb;
    __device__ __forceinline__ void operator()(const f32x4 (&acc)[2][2][4][2], const Unit& u, int wr, int wc, int fr, int fq) const {
        const int row0 = u.pm * BM + wr * 64 + fr, col0 = u.z * 1024 + u.pn * 256 + wc * 32 + 8 * fq;
        EPI_ROWS_BEGIN { bf16* rowp = Bb + (size_t)(row0 + ai * HALF + m * 16) * 3072 + col0;
#pragma unroll
            for (int bj = 0; bj < 2; ++bj) { const f32x4 v0 = acc[ai][bj][m][0], v1 = acc[ai][bj][m][1];
                u32x4 w; w.x = cvt_pk_bf16(v0[0], v0[1]); w.y = cvt_pk_bf16(v0[2], v0[3]); w.z = cvt_pk_bf16(v1[0], v1[1]); w.w = cvt_pk_bf16(v1[2], v1[3]);
                *(u32x4*)(rowp + bj * HALF) = w; } }
    }
};
struct EpiGateMerge {
    static constexpr bool PERM = true;
    const bf16* Bb; bf16* Mg;
    __device__ __forceinline__ void operator()(const f32x4 (&acc)[2][2][4][2], const Unit& u, int wr, int wc, int fr, int fq) const {
        const int row0 = u.pm * BM + wr * 64 + fr, col0 = u.pn * 256 + wc * 32 + 8 * fq;
        EPI_ROWS_BEGIN { const size_t r = (size_t)(row0 + ai * HALF + m * 16);
#pragma unroll
            for (int bj = 0; bj < 2; ++bj) {
                const u32x4 bw = *(const u32x4*)(Bb + r * 3072 + u.z * 1024 + col0 + bj * HALF);
                float b[8]; unpack8(bw, b);
                float o[8];
#pragma unroll
                for (int e = 0; e < 8; ++e) o[e] = sigmoidf_(acc[ai][bj][m][e >> 2][e & 3]) * b[e];
                bf16* mp = Mg + r * 1024 + col0 + bj * HALF;
                if (u.z != 0) { const u32x4 mw = *(const u32x4*)mp; float pm_[8]; unpack8(mw, pm_);
#pragma unroll
                    for (int e = 0; e < 8; ++e) o[e] += pm_[e]; }
                u32x4 w; w.x = cvt_pk_bf16(o[0], o[1]); w.y = cvt_pk_bf16(o[2], o[3]); w.z = cvt_pk_bf16(o[4], o[5]); w.w = cvt_pk_bf16(o[6], o[7]);
                *(u32x4*)mp = w; } }
    }
};
struct EpiOut {
    static constexpr bool PERM = false;
    const float* xin; float* out;
    __device__ __forceinline__ void operator()(const f32x4 (&acc)[2][2][4][2], const Unit& u, int wr, int wc, int fr, int fq) const {
        const int row0 = u.pm * BM + wr * 64 + fr, col0 = u.pn * BM + wc * 32 + 4 * fq;
        EPI_ROWS_BEGIN { const size_t off = (size_t)(row0 + ai * HALF + m * 16) * 1024 + col0;
#pragma unroll
            for (int bj = 0; bj < 2; ++bj)
#pragma unroll
                for (int n = 0; n < 2; ++n) { const f32x4 xv = *(const f32x4*)(xin + off + bj * HALF + n * 16); *(f32x4*)(out + off + bj * HALF + n * 16) = xv + acc[ai][bj][m][n]; } }
    }
};
struct EpiSwiGLU {
    static constexpr bool PERM = true;
    bf16* act;
    __device__ __forceinline__ void operator()(const f32x4 (&acc)[2][2][4][2], const Unit& u, int wr, int wc, int fr, int fq) const {
        const int row0 = u.pm * BM + wr * 64 + fr, col0 = u.pn * 128 + wc * 32 + 8 * fq;
        EPI_ROWS_BEGIN { bf16* rowp = act + (size_t)(row0 + ai * HALF + m * 16) * 512 + col0;
            float o[8];
#pragma unroll
            for (int e = 0; e < 8; ++e) { const float g = acc[ai][0][m][e >> 2][e & 3], up = acc[ai][1][m][e >> 2][e & 3]; o[e] = g * sigmoidf_(g) * up; }
            u32x4 w; w.x = cvt_pk_bf16(o[0], o[1]); w.y = cvt_pk_bf16(o[2], o[3]); w.z = cvt_pk_bf16(o[4], o[5]); w.w = cvt_pk_bf16(o[6], o[7]);
            *(u32x4*)rowp = w; }
    }
};
struct EpiMoeDown {
    static constexpr bool PERM = true;
    bf16* ys; const float* row_w;
    __device__ __forceinline__ void operator()(const f32x4 (&acc)[2][2][4][2], const Unit& u, int wr, int wc, int fr, int fq) const {
        const int row0 = u.pm * BM + wr * 64 + fr, col0 = u.pn * 256 + wc * 32 + 8 * fq;
        EPI_ROWS_BEGIN { const int r = row0 + ai * HALF + m * 16; const float rw = row_w[r]; bf16* rowp = ys + (size_t)r * 1024 + col0;
#pragma unroll
            for (int bj = 0; bj < 2; ++bj) { const f32x4 v0 = acc[ai][bj][m][0] * rw, v1 = acc[ai][bj][m][1] * rw;
                u32x4 w; w.x = cvt_pk_bf16(v0[0], v0[1]); w.y = cvt_pk_bf16(v0[2], v0[3]); w.z = cvt_pk_bf16(v1[0], v1[1]); w.w = cvt_pk_bf16(v1[2], v1[3]);
                *(u32x4*)(rowp + bj * HALF) = w; } }
    }
};
}

#define XB_TMO      128
#define XB_XCNT(j)  (256  + 64 * (j))
#define XB_XSUB(j)  (1280 + 64 * (j))
#define XB_XGEN(j)  (2304 + 64 * (j))
#define XB_TOP      3328
#define XB_TOPGEN   3392
#define XCD_BAR_WORDS 3456
#define XB_SPIN_CAP (1u << 18)
__device__ __forceinline__ unsigned xb_ld(unsigned* p)              { return __hip_atomic_load(p, __ATOMIC_RELAXED, __HIP_MEMORY_SCOPE_AGENT); }
__device__ __forceinline__ unsigned xb_add(unsigned* p, unsigned v) { return __hip_atomic_fetch_add(p, v, __ATOMIC_RELAXED, __HIP_MEMORY_SCOPE_AGENT); }
__device__ __forceinline__ unsigned xb_xcc_id() { return (unsigned)__builtin_amdgcn_s_getreg((3 << 11) | 20) & 0xFu; }
#define XB_SPIN(cond, bar) do { unsigned _sp = 0; while (cond) { __builtin_amdgcn_s_sleep(1); \
    if ((++_sp & 255u) == 0u) { if (xb_ld(&(bar)[XB_TMO])) break; if (_sp > XB_SPIN_CAP) { atomicAdd(&(bar)[XB_TMO], 1u); break; } } } } while (0)
struct XcdBarrier { unsigned* bar; unsigned x; volatile LAS unsigned* st; };
__device__ __forceinline__ XcdBarrier xcd_barrier_post(unsigned* bar, volatile LAS unsigned* st) {
    XcdBarrier b; b.bar = bar; b.x = xb_xcc_id(); b.st = st;
    if (threadIdx.x == 0) (void)xb_add(&bar[XB_XCNT(b.x)], 1u);
    return b;
}
__device__ __forceinline__ void xcd_barrier_complete(unsigned* bar, unsigned x, unsigned& nloc, unsigned& nx) {
    const unsigned G = gridDim.x * gridDim.y * gridDim.z;
    unsigned sum, cnt, mine, sp = 0u;
    for (;;) {
        sum = 0u; cnt = 0u; mine = 0u;
#pragma unroll
        for (unsigned j = 0; j < 16; ++j) { const unsigned c = xb_ld(&bar[XB_XCNT(j)]); sum += c; cnt += (c > 0u) ? 1u : 0u; mine = (j == x) ? c : mine; }
        if (sum == G) break;
        __builtin_amdgcn_s_sleep(1);
        if ((++sp & 255u) == 0u) { if (xb_ld(&bar[XB_TMO])) break; if (sp > XB_SPIN_CAP) { atomicAdd(&bar[XB_TMO], 1u); break; } }
    }
    nloc = mine > 0u ? mine : 1u; nx = cnt > 0u ? cnt : 1u;
}
__device__ __forceinline__ void xcd_barrier(const XcdBarrier& b) {
    asm volatile("s_waitcnt vmcnt(0)" ::: "memory");
    __syncthreads();
    if (threadIdx.x == 0) {
        unsigned* bar = b.bar;
        __builtin_amdgcn_s_waitcnt(0);
        unsigned nloc = b.st[0], nx = b.st[1];
        if (nloc == 0u) { xcd_barrier_complete(bar, b.x, nloc, nx); b.st[0] = nloc; b.st[1] = nx; }
        const unsigned old = xb_add(&bar[XB_XSUB(b.x)], 1u);
        const unsigned gen = old / nloc;
        if (old + 1u == (gen + 1u) * nloc) {
            __builtin_amdgcn_fence(__ATOMIC_RELEASE, "agent");
            asm volatile("s_waitcnt vmcnt(0)" ::: "memory");
            const unsigned og = xb_add(&bar[XB_TOP], 1u);
            const unsigned tg = og / nx;
            if (og + 1u == (tg + 1u) * nx) xb_add(&bar[XB_TOPGEN], 1u);
            else XB_SPIN(xb_ld(&bar[XB_TOPGEN]) == tg, bar);
            __builtin_amdgcn_fence(__ATOMIC_ACQUIRE, "agent");
            xb_add(&bar[XB_XGEN(b.x)], 1u);
            asm volatile("s_waitcnt vmcnt(0)" ::: "memory");
        } else {
            XB_SPIN(xb_ld(&bar[XB_XGEN(b.x)]) == gen, bar);
            __builtin_amdgcn_fence(__ATOMIC_ACQUIRE, "agent");
            asm volatile("s_waitcnt vmcnt(0)" ::: "memory");
        }
    }
    __syncthreads();
}

struct Frame {
    LAS unsigned char* lds;
    volatile LAS unsigned* MISC;
    unsigned* ctl;
    int tid, lane, wave, G;
    float* out;
    unsigned char* ws;
    __device__ __forceinline__ const float* inp(int k) const {
        const LAS unsigned* p = (const LAS unsigned*)(lds + PTAB_OFF) + 2 * k; const unsigned lo = __builtin_amdgcn_readfirstlane(p[0]), hi = __builtin_amdgcn_readfirstlane(p[1]);
        return (const float*)(const GAS float*)(((unsigned long long)hi << 32) | lo); }
};
__device__ __forceinline__ int tid_now() { int t = threadIdx.x; asm volatile("" : "+v"(t)); return t; }
__device__ __forceinline__ unsigned char* opaque(unsigned char* p) { unsigned z = 0u; asm volatile("" : "+s"(z)); return p + z; }
#define LDS_WAIT() asm volatile("s_waitcnt lgkmcnt(0)" ::: "memory")

__device__ __forceinline__ void transpose_item(const float* W, int ldw, int nvalid, bf16* WT, int Kd, int k0, int n0, int drow0, LAS float* scr, int lane) {
    const int cn = n0 + (lane & 31); const bool ok = cn < nvalid;
#pragma unroll 8
    for (int i = 0; i < 32; ++i) { const int kk = 2 * i + (lane >> 5); scr[kk * 33 + (lane & 31)] = ok ? W[(size_t)(k0 + kk) * ldw + cn] : 0.f; }
    LDS_WAIT(); asm volatile("" ::: "memory");
    const int c = lane & 7;
#pragma unroll
    for (int j = 0; j < 4; ++j) { const int n = (lane >> 3) + 8 * j; const LAS float* s = scr + (8 * c) * 33 + n;
        u32x4 o; o.x = pk2(s[0 * 33], s[1 * 33]); o.y = pk2(s[2 * 33], s[3 * 33]); o.z = pk2(s[4 * 33], s[5 * 33]); o.w = pk2(s[6 * 33], s[7 * 33]);
        *(u32x4*)(WT + (size_t)(drow0 + n) * Kd + k0 + 8 * c) = o; }
    LDS_WAIT(); asm volatile("" ::: "memory");
}

__device__ __forceinline__ void ph_convert_mixer(Frame& F) {
    const int tid = tid_now(), lane = tid & 63, wave = __builtin_amdgcn_readfirstlane(tid >> 6); (void)lane; (void)wave;
    unsigned char* const wsl = opaque(F.ws);
    LAS float* scr = (LAS float*)(F.lds + wave * 16384);
    const int gw = blockIdx.x * 8 + wave, NGW = F.G * 8;
    constexpr int I_IN = 16 * 152, I_G = 3 * 16 * 32, I_B = 3 * 8 * 32, I_O = 16 * 32, I_L = I_IN + I_G + I_B + I_O;
    for (int it = gw; it < 2 * I_L; it += NGW) {
        const int l = it / I_L; int r = it % I_L;
        unsigned char* wb = wsl + WS_WMIX + (size_t)l * WMIX_LAYER;
        if (r < I_IN) { const int kb = r / 152, nb = r % 152;
            transpose_item(F.inp(3) + (size_t)l * 1024 * 4624, 4624, 4624, (bf16*)(wb + WO_WIN), 1024, kb * 64, nb * 32, nb * 32, scr, lane); continue; }
        r -= I_IN;
        if (r < I_G) { const int z = r / 512, q = r % 512, kb = q / 32, nb = q % 32;
            transpose_item(F.inp(11) + ((size_t)l * 3 + z) * 1024 * 1024, 1024, 1024, (bf16*)(wb + WO_WG), 1024, kb * 64, nb * 32, z * 1024 + nb * 32, scr, lane); continue; }
        r -= I_G;
        if (r < I_B) { const int z = r / 256, q = r % 256, kb = q / 32, nb = q % 32;
            transpose_item(F.inp(12) + ((size_t)l * 3 + z) * 512 * 1024, 1024, 1024, (bf16*)(wb + WO_WB) + (size_t)z * 1024 * 512, 512, kb * 64, nb * 32, nb * 32, scr, lane); continue; }
        r -= I_B;
        { const int kb = r / 32, nb = r % 32;
            transpose_item(F.inp(13) + (size_t)l * 1024 * 1024, 1024, 1024, (bf16*)(wb + WO_WO), 1024, kb * 64, nb * 32, nb * 32, scr, lane); }
    }
}
__device__ __forceinline__ void ph_convert_experts(Frame& F, int l) {
    const int tid = tid_now(), lane = tid & 63, wave = __builtin_amdgcn_readfirstlane(tid >> 6); (void)lane; (void)wave;
    unsigned char* const wsl = opaque(F.ws);
    LAS float* scr = (LAS float*)(F.lds + wave * 16384);
    const int gw = blockIdx.x * 8 + wave, NGW = F.G * 8;
    constexpr int I_1 = 32 * 16 * 32, I_2 = 32 * 8 * 32;
    bf16* W1T = (bf16*)(wsl + WS_W1T); bf16* WdT = (bf16*)(wsl + WS_WDT);
    for (int it = gw; it < I_1 + I_2; it += NGW) {
        if (it < I_1) { const int e = it / 512, q = it % 512, kb = q / 32, j = q % 32, half = j >> 4, nb = j & 15;
            const float* src = (half ? F.inp(20) : F.inp(19)) + ((size_t)l * 32 + e) * 1024 * 512;
            const int t = nb >> 2, drow = t * 256 + half * 128 + (nb & 3) * 32;
            transpose_item(src, 512, 512, W1T + (size_t)e * 1024 * 1024, 1024, kb * 64, nb * 32, drow, scr, lane);
        } else { const int r = it - I_1, e = r / 256, q = r % 256, kb = q / 32, nb = q % 32;
            transpose_item(F.inp(21) + ((size_t)l * 32 + e) * 512 * 1024, 1024, 1024, WdT + (size_t)e * 1024 * 512, 512, kb * 64, nb * 32, nb * 32, scr, lane); }
    }
}
template <bool COMBINE, bool NORM>
__device__ __forceinline__ void ph_norm(Frame& F, const float* xin, const float* gain, bf16* H) {
    const int tid = tid_now(), lane = tid & 63, wave = __builtin_amdgcn_readfirstlane(tid >> 6); (void)lane; (void)wave;
    unsigned char* const wsl = opaque(F.ws);
    const int gw = blockIdx.x * 8 + wave, NGW = F.G * 8;
    const int* toks = (const int*)(wsl + WS_TOKS); const bf16* ys = (const bf16*)(wsl + WS_YS);
    f32x4 g[4];
#pragma unroll
    for (int j = 0; j < 4; ++j) g[j] = NORM ? *((const f32x4*)gain + 64 * j + lane) : (f32x4){0.f, 0.f, 0.f, 0.f};
    for (int m = gw; m < T_; m += NGW) {
        const f32x4* xr = (const f32x4*)(xin + (size_t)m * 1024) + lane;
        f32x4 v[4];
#pragma unroll
        for (int j = 0; j < 4; ++j) v[j] = xr[64 * j];
        if (COMBINE) {
            const int s0 = toks[2 * m], s1 = toks[2 * m + 1];
            const u32x2* y0 = (const u32x2*)(ys + (size_t)s0 * 1024) + lane; const u32x2* y1 = (const u32x2*)(ys + (size_t)s1 * 1024) + lane;
#pragma unroll
            for (int j = 0; j < 4; ++j) { const u32x2 a = y0[64 * j], b = y1[64 * j];
                v[j].x += bflo(a.x) + bflo(b.x); v[j].y += bfhi(a.x) + bfhi(b.x); v[j].z += bflo(a.y) + bflo(b.y); v[j].w += bfhi(a.y) + bfhi(b.y); }
            f32x4* xo = (f32x4*)(F.out + (size_t)m * 1024) + lane;
#pragma unroll
            for (int j = 0; j < 4; ++j) xo[64 * j] = v[j];
        }
        if (NORM) {
            float ss = 0.f;
#pragma unroll
            for (int j = 0; j < 4; ++j) ss += (v[j].x * v[j].x + v[j].y * v[j].y) + (v[j].z * v[j].z + v[j].w * v[j].w);
            const float rs = rsqrtf(wave_sum(ss) * (1.f / 1024.f) + RMS_EPS);
            u32x2* o8 = (u32x2*)(H + (size_t)m * 1024) + lane;
#pragma unroll
            for (int j = 0; j < 4; ++j) { u32x2 w; w.x = pk2(v[j].x * rs * g[j].x, v[j].y * rs * g[j].y); w.y = pk2(v[j].z * rs * g[j].z, v[j].w * rs * g[j].w); o8[64 * j] = w; }
        }
    }
}

__device__ __forceinline__ void ph_conv(Frame& F, int l) {
    const int tid = tid_now(), lane = tid & 63, wave = __builtin_amdgcn_readfirstlane(tid >> 6); (void)lane; (void)wave;
    unsigned char* const wsl = opaque(F.ws);
    const bf16* Pc = (const bf16*)(wsl + WS_PC); bf16* Y = (bf16*)(wsl + WS_Y);
    const float* cw = F.inp(4) + (size_t)l * 3 * 512; const float* cbias = F.inp(5) + (size_t)l * 512;
    const int gt = blockIdx.x * 512 + tid, NT = F.G * 512;
    for (int item = gt; item < T_ * 64; item += NT) {
        const int r = item >> 6, c8 = (item & 63) * 8, s = r & (SEQ - 1);
        const bf16* p = Pc + (size_t)r * NPC + c8;
        float cb[8], a[8], b[8], u0[8], u1[8], u2[8];
        unpack8(*(const u32x4*)p, cb);
        unpack8(*(const u32x4*)(p + 512), a); unpack8(*(const u32x4*)(p + 1024), b);
#pragma unroll
        for (int e = 0; e < 8; ++e) u2[e] = a[e] * b[e];
        if (s >= 1) { unpack8(*(const u32x4*)(p - NPC + 512), a); unpack8(*(const u32x4*)(p - NPC + 1024), b);
#pragma unroll
            for (int e = 0; e < 8; ++e) u1[e] = a[e] * b[e]; }
        else {
#pragma unroll
            for (int e = 0; e < 8; ++e) u1[e] = 0.f; }
        if (s >= 2) { unpack8(*(const u32x4*)(p - 2 * NPC + 512), a); unpack8(*(const u32x4*)(p - 2 * NPC + 1024), b);
#pragma unroll
            for (int e = 0; e < 8; ++e) u0[e] = a[e] * b[e]; }
        else {
#pragma unroll
            for (int e = 0; e < 8; ++e) u0[e] = 0.f; }
        float o[8];
#pragma unroll
        for (int e = 0; e < 8; ++e) o[e] = cb[e] * (cbias[c8 + e] + cw[c8 + e] * u0[e] + cw[512 + c8 + e] * u1[e] + cw[1024 + c8 + e] * u2[e]);
        *(u32x4*)(Y + (size_t)r * NYC + c8) = pack8(o);
    }
}
__device__ __forceinline__ void ph_qknorm(Frame& F, int l) {
    const int tid = tid_now(), lane = tid & 63, wave = __builtin_amdgcn_readfirstlane(tid >> 6); (void)lane; (void)wave;
    unsigned char* const wsl = opaque(F.ws);
    bf16* Pa = (bf16*)(wsl + WS_PA); float* kmean = (float*)(wsl + WS_KMEAN);
    LAS float* red = (LAS float*)F.lds;
    for (int unit = blockIdx.x; unit < 256; unit += F.G) {
        const int blk = unit >> 1, isk = unit & 1;
        const float* gn = (isk ? F.inp(7) : F.inp(6)) + l * 64 + (lane & 7) * 8;
        float g[8], ksum[8];
#pragma unroll
        for (int e = 0; e < 8; ++e) { g[e] = gn[e] * (isk ? 1.f : QSCALE); ksum[e] = 0.f; }
        for (int rr = 0; rr < 32; ++rr) {
            const int r = blk * 256 + wave * 32 + rr;
            bf16* p = Pa + (size_t)r * NPA + isk * 512 + lane * 8;
            float v[8]; unpack8(*(const u32x4*)p, v);
            float ss = 0.f;
#pragma unroll
            for (int e = 0; e < 8; ++e) ss += v[e] * v[e];
            ss += __shfl_xor(ss, 1); ss += __shfl_xor(ss, 2); ss += __shfl_xor(ss, 4);
            const float rs = rsqrtf(ss * (1.f / 64.f) + RMS_EPS);
#pragma unroll
            for (int e = 0; e < 8; ++e) { v[e] = v[e] * rs * g[e]; ksum[e] += v[e]; }
            *(u32x4*)p = pack8(v);
        }
        if (isk) {
#pragma unroll
            for (int e = 0; e < 8; ++e) red[wave * 512 + lane * 8 + e] = ksum[e];
            __syncthreads();
            { const int col = tid; float s = 0.f;
#pragma unroll
              for (int w = 0; w < 8; ++w) s += red[w * 512 + col];
              const int b = blk >> 5, n = blk & 31, h = col >> 6, d = col & 63;
              kmean[((size_t)((b * 8 + h) * 32 + n)) * 64 + d] = s * (1.f / 256.f); }
            __syncthreads();
        }
    }
}
__device__ __forceinline__ void gla_bcum(Frame& F, int l, int r0, int h, LAS float* zs, LAS float* wa, LAS float* ba, LAS float* bt, LAS float* la) {
    const int tid = tid_now(), lane = tid & 63, wave = __builtin_amdgcn_readfirstlane(tid >> 6); (void)lane; (void)wave;
    unsigned char* const wsl = opaque(F.ws);
    const bf16* Pg = (const bf16*)(wsl + WS_PG);
        for (int i = tid; i < 1024; i += 512) { const int j = i >> 4, rr = i & 15; zs[i] = bf1(Pg[(size_t)(r0 + j) * NPG + 1536 + rr]); }
    for (int i = tid; i < 1024; i += 512) { const int rr = i >> 6, d = i & 63; wa[i] = F.inp(8)[(size_t)l * 16 * 256 + rr * 256 + h * 64 + d]; }
    if (tid < 64) ba[tid] = F.inp(9)[l * 256 + h * 64 + tid];
    __syncthreads();
    { const int d = tid & 63, j0 = (tid >> 6) * 8;
#pragma unroll
      for (int jj = 0; jj < 8; ++jj) { const int j = j0 + jj; float x = ba[d];
#pragma unroll
          for (int rr = 0; rr < 16; ++rr) x += zs[j * 16 + rr] * wa[rr * 64 + d];
          const float ls = fminf(x, 0.f) - log1pf(__expf(-fabsf(x)));
          la[j * 65 + d] = ls * (1.f / 16.f); } }
    __syncthreads();
    if (tid < 64) { float a = 0.f; for (int j = 0; j < 64; ++j) { a += la[j * 65 + tid]; la[j * 65 + tid] = a; } bt[tid] = a; }
    __syncthreads();
}
__device__ __forceinline__ void ph_gla_kv(Frame& F, int l) {
    const int tid = tid_now(), lane = tid & 63, wave = __builtin_amdgcn_readfirstlane(tid >> 6); (void)lane; (void)wave;
    unsigned char* const wsl = opaque(F.ws);
    const bf16* Pg = (const bf16*)(wsl + WS_PG); bf16* GK = (bf16*)(wsl + WS_GLA); float* DEC = (float*)(wsl + WS_DEC);
    LAS float* zs = (LAS float*)F.lds; LAS float* wa = zs + 1024; LAS float* ba = wa + 1024; LAS float* bt = ba + 64; LAS float* la = bt + 64;
    LAS float* ks = la + 64 * 65; LAS float* vs = ks + 64 * 65;
        for (int unit = blockIdx.x; unit < 2048; unit += F.G) {
        const int h = unit & 3, cg = unit >> 2, b = cg >> 7, ch = cg & 127, r0 = b * SEQ + ch * 64;
        gla_bcum(F, l, r0, h, zs, wa, ba, bt, la);
        { const int d = tid & 63, j0 = (tid >> 6) * 8;
#pragma unroll
          for (int jj = 0; jj < 8; ++jj) { const int j = j0 + jj; ks[j * 65 + d] = bf1(Pg[(size_t)(r0 + j) * NPG + 256 + h * 64 + d]) * __expf(bt[d] - la[j * 65 + d]); } }
        for (int i = tid; i < 64 * 128; i += 512) { const int j = i >> 7, v = i & 127; vs[i] = bf1(Pg[(size_t)(r0 + j) * NPG + 512 + h * 128 + v]); }
        __syncthreads();
        { const int v = tid & 127, d0 = (tid >> 7) * 16; float acc[16];
#pragma unroll
          for (int dd = 0; dd < 16; ++dd) acc[dd] = 0.f;
#pragma unroll 2
          for (int j = 0; j < 64; ++j) { const float vv = vs[j * 128 + v];
#pragma unroll
              for (int dd = 0; dd < 16; ++dd) acc[dd] += ks[j * 65 + d0 + dd] * vv; }
          bf16* o = GK + ((size_t)((b * 4 + h) * 128 + ch)) * 8192;
#pragma unroll
          for (int dd = 0; dd < 16; ++dd) o[(d0 + dd) * 128 + v] = (bf16)f2bf(acc[dd]); }
        if (tid < 64) DEC[((size_t)((b * 4 + h) * 128 + ch)) * 64 + tid] = __expf(bt[tid]);
        __syncthreads();
    }
}
__device__ __forceinline__ void ph_moba_gate(Frame& F) {
    const int tid = tid_now(), lane = tid & 63, wave = __builtin_amdgcn_readfirstlane(tid >> 6); (void)lane; (void)wave;
    unsigned char* const wsl = opaque(F.ws);
    const bf16* Pa = (const bf16*)(wsl + WS_PA); const float* kmean = (const float*)(wsl + WS_KMEAN); unsigned* sel = (unsigned*)(wsl + WS_SEL);
    LAS float* km = (LAS float*)(F.lds + wave * 8192);
    const int gw = blockIdx.x * 8 + wave, NGW = F.G * 8;
    for (int it = gw; it < 512 * 8; it += NGW) {
        const int rb = it >> 3, h = it & 7, r = rb * 64 + lane, b = rb >> 7, qb = (rb & 127) >> 2;
        for (int i = lane; i < 2048; i += 64) km[i] = kmean[(size_t)(b * 8 + h) * 2048 + i];
        float q[64];
#pragma unroll
        for (int c = 0; c < 8; ++c) { float t8[8]; unpack8(*(const u32x4*)(Pa + (size_t)r * NPA + h * 64 + c * 8), t8);
#pragma unroll
            for (int e = 0; e < 8; ++e) q[c * 8 + e] = t8[e]; }
        LDS_WAIT(); asm volatile("" ::: "memory");
        float v0 = -INFINITY, v1 = -INFINITY, v2 = -INFINITY; int i0 = 0, i1 = 1, i2 = 2;
        for (int n = 0; n < qb; ++n) {
            float s = 0.f;
#pragma unroll
            for (int d = 0; d < 64; ++d) s += q[d] * km[n * 64 + d];
            if (s > v0) { v2 = v1; i2 = i1; v1 = v0; i1 = i0; v0 = s; i0 = n; }
            else if (s > v1) { v2 = v1; i2 = i1; v1 = s; i1 = n; }
            else if (s > v2) { v2 = s; i2 = n; }
        }
        const int nv = qb < 3 ? qb : 3;
        sel[(size_t)(b * 8 + h) * SEQ + (r & (SEQ - 1))] = (unsigned)i0 | ((unsigned)i1 << 8) | ((unsigned)i2 << 16) | ((unsigned)nv << 24);
        asm volatile("" ::: "memory");
    }
}
__device__ __forceinline__ void ph_gla_scan(Frame& F) {
    const int tid = tid_now(), lane = tid & 63, wave = __builtin_amdgcn_readfirstlane(tid >> 6); (void)lane; (void)wave;
    unsigned char* const wsl = opaque(F.ws);
    bf16* GK = (bf16*)(wsl + WS_GLA); const float* DEC = (const float*)(wsl + WS_DEC);
    const int gt = blockIdx.x * 512 + tid, NT = F.G * 512;
    for (int e = gt; e < 16 * 8192; e += NT) {
        const int bh = e >> 13, dv = e & 8191, d = dv >> 7;
        bf16* p = GK + (size_t)bh * 128 * 8192 + dv; const float* dc = DEC + (size_t)bh * 128 * 64 + d;
        float st = 0.f;
        for (int n0 = 0; n0 < 128; n0 += 16) {
            float kv[16], de[16];
#pragma unroll
            for (int i = 0; i < 16; ++i) { kv[i] = bf1(p[(size_t)(n0 + i) * 8192]); de[i] = dc[(n0 + i) * 64]; }
#pragma unroll
            for (int i = 0; i < 16; ++i) { p[(size_t)(n0 + i) * 8192] = (bf16)f2bf(st); st = de[i] * st + kv[i]; }
        }
    }
}
__device__ __forceinline__ void ph_moba_attn(Frame& F) {
    const int tid = tid_now(), lane = tid & 63, wave = __builtin_amdgcn_readfirstlane(tid >> 6); (void)lane; (void)wave;
    unsigned char* const wsl = opaque(F.ws);
    const bf16* Pa = (const bf16*)(wsl + WS_PA); const unsigned* sel = (const unsigned*)(wsl + WS_SEL); bf16* Y = (bf16*)(wsl + WS_Y);
    LAS float* pl = (LAS float*)(F.lds + wave * 8192);
    const LAS float* bias2 = (const LAS float*)(F.lds + LTAB_OFF);
    const LAS int* bucket = (const LAS int*)(F.lds + LTAB_OFF + 1024);
    const int gw = blockIdx.x * 8 + wave, NGW = F.G * 8;
    for (int it = gw; it < T_ * 8; it += NGW) {
        const int r = it >> 3, h = it & 7, b = r >> 13, s = r & (SEQ - 1), qb = s >> 8;
        const unsigned sw = sel[(size_t)(b * 8 + h) * SEQ + s]; const int nv = (int)(sw >> 24);
        float q[64];
#pragma unroll
        for (int c = 0; c < 8; ++c) { float t8[8]; unpack8(*(const u32x4*)(Pa + (size_t)r * NPA + h * 64 + c * 8), t8);
#pragma unroll
            for (int e = 0; e < 8; ++e) q[c * 8 + e] = t8[e]; }
        float sc[4][4]; float mx = -INFINITY;
#pragma unroll
        for (int i = 0; i < 4; ++i) {
            const bool valid = (i < 3) ? (i < nv) : true;
            const int blk = (i < 3) ? (int)((sw >> (8 * i)) & 0xffu) : qb;
            if (valid) {
#pragma unroll
                for (int kk = 0; kk < 4; ++kk) {
                    const int kpos = blk * 256 + lane + 64 * kk;
                    const bf16* kp = Pa + (size_t)(b * SEQ + kpos) * NPA + 512 + h * 64;
                    float d = 0.f;
#pragma unroll
                    for (int c = 0; c < 8; ++c) { float t8[8]; unpack8(*(const u32x4*)(kp + c * 8), t8);
#pragma unroll
                        for (int e = 0; e < 8; ++e) d += q[c * 8 + e] * t8[e]; }
                    const int rel = s - kpos;
                    const float v = (rel < 0) ? -INFINITY : d + bias2[h * 32 + bucket[rel > 255 ? 255 : rel]];
                    sc[i][kk] = v; mx = fmaxf(mx, v);
                    asm volatile("" ::: "memory");
                }
            } else {
#pragma unroll
                for (int kk = 0; kk < 4; ++kk) sc[i][kk] = -INFINITY;
            }
        }
        mx = wave_max(mx);
        float ls = 0.f;
#pragma unroll
        for (int i = 0; i < 4; ++i)
#pragma unroll
            for (int kk = 0; kk < 4; ++kk) { const float p = __builtin_amdgcn_exp2f(sc[i][kk] - mx); ls += p; pl[i * 256 + lane + 64 * kk] = p; }
        ls = wave_sum(ls);
        LDS_WAIT(); asm volatile("" ::: "memory");
        float acc[8];
#pragma unroll
        for (int e = 0; e < 8; ++e) acc[e] = 0.f;
#pragma unroll
        for (int i = 0; i < 4; ++i) {
            const bool valid = (i < 3) ? (i < nv) : true;
            const int blk = (i < 3) ? (int)((sw >> (8 * i)) & 0xffu) : qb;
            if (valid) {
                const bf16* vp = Pa + (size_t)(b * SEQ + blk * 256 + (lane >> 3)) * NPA + 1024 + h * 64 + (lane & 7) * 8;
#pragma unroll 4
                for (int k0 = 0; k0 < 256; k0 += 8) {
                    const float p = pl[i * 256 + k0 + (lane >> 3)];
                    float t8[8]; unpack8(*(const u32x4*)(vp + (size_t)k0 * NPA), t8);
#pragma unroll
                    for (int e = 0; e < 8; ++e) acc[e] += p * t8[e];
                }
            }
        }
#pragma unroll
        for (int e = 0; e < 8; ++e) { acc[e] += __shfl_xor(acc[e], 8); acc[e] += __shfl_xor(acc[e], 16); acc[e] += __shfl_xor(acc[e], 32); }
        const float inv = 1.f / ls;
        if (lane < 8) { float o[8];
#pragma unroll
            for (int e = 0; e < 8; ++e) o[e] = acc[e] * inv;
            *(u32x4*)(Y + (size_t)r * NYC + 512 + h * 64 + lane * 8) = pack8(o); }
        asm volatile("" ::: "memory");
    }
}

namespace moba {
typedef float f32x16 __attribute__((ext_vector_type(16)));
constexpr int KPB = 144;
constexpr int VPB = 520;
constexpr int L_K = 0, L_V = 36864, L_TB = 70144, L_LIST = 72192, L_OST = 88576, L_WS = 125440, L_CNT = 129536;
constexpr int OSP = 72;
constexpr int OFP = 68;
__device__ __forceinline__ int crow(int r, int hi) { return (r & 3) + 8 * (r >> 2) + 4 * hi; }
__device__ __forceinline__ unsigned cvtpk(float lo, float hi) { unsigned r; asm volatile("v_cvt_pk_bf16_f32 %0, %1, %2" : "=v"(r) : "v"(lo), "v"(hi)); return r; }

__device__ __forceinline__ void stage_kv(LAS unsigned char* lds, const bf16* Pa, int krow0, int h, const float* relb, int tid) {
#pragma unroll
    for (int i = 0; i < 4; ++i) { const int id = tid + 512 * i, kv = id >> 3, dc = id & 7;
        const bf16* src = Pa + (size_t)(krow0 + kv) * NPA + h * 64 + dc * 8;
        const u32x4 kw = *(const u32x4*)(src + 512), vw = *(const u32x4*)(src + 1024);
        *(LAS u32x4*)(lds + L_K + kv * KPB + dc * 16) = kw;
        LAS bf16* vt = (LAS bf16*)(lds + L_V) + (dc * 8) * (VPB / 2) + kv;
        vt[0 * (VPB / 2)] = (bf16)(vw.x & 0xffffu); vt[1 * (VPB / 2)] = (bf16)(vw.x >> 16); vt[2 * (VPB / 2)] = (bf16)(vw.y & 0xffffu); vt[3 * (VPB / 2)] = (bf16)(vw.y >> 16);
        vt[4 * (VPB / 2)] = (bf16)(vw.z & 0xffffu); vt[5 * (VPB / 2)] = (bf16)(vw.z >> 16); vt[6 * (VPB / 2)] = (bf16)(vw.w & 0xffffu); vt[7 * (VPB / 2)] = (bf16)(vw.w >> 16); }
    if (tid < 256) { const int n = tid; int bq; if (n < 16) bq = n; else { const float sc = logf((float)n / 16.0f) / 2.0794415416798357f; bq = 16 + (int)(sc * 16.0f); if (bq > 31) bq = 31; }
        ((LAS float*)(lds + L_TB))[256 + n] = relb[bq * 8 + h] * LOG2E; ((LAS float*)(lds + L_TB))[n] = -INFINITY; }
}

__device__ __forceinline__ void half_scores(const LAS unsigned char* lds, const bf16x8 (&qf)[4], int c, int hi, int half, f32x16 (&p)[4]) {
#pragma unroll
    for (int t2 = 0; t2 < 4; ++t2) {
        f32x16 acc = {0.f, 0.f, 0.f, 0.f, 0.f, 0.f, 0.f, 0.f, 0.f, 0.f, 0.f, 0.f, 0.f, 0.f, 0.f, 0.f};
#pragma unroll
        for (int st = 0; st < 4; ++st) { const bf16x8 kf = *(const LAS bf16x8*)(lds + L_K + (128 * half + 32 * t2 + c) * KPB + st * 32 + hi * 16); acc = __builtin_amdgcn_mfma_f32_32x32x16_bf16(kf, qf[st], acc, 0, 0, 0); }
        p[t2] = acc;
        __builtin_amdgcn_sched_barrier(0);
    }
}
__device__ __forceinline__ void half_bias(const LAS unsigned char* lds, int hi, int half, int relbase, f32x16 (&p)[4]) {
    const LAS float* tb = (const LAS float*)(lds + L_TB);
#pragma unroll
    for (int t2 = 0; t2 < 4; ++t2) {
#pragma unroll
        for (int r = 0; r < 16; ++r) { int idx = relbase - (128 * half + 32 * t2 + crow(r, hi)) + 256; idx = idx > 511 ? 511 : idx; p[t2][r] += tb[idx]; }
        __builtin_amdgcn_sched_barrier(0); }
}
__device__ __forceinline__ float half_max(const f32x16 (&p)[4]) {
    float m = -INFINITY;
#pragma unroll
    for (int t2 = 0; t2 < 4; ++t2)
#pragma unroll
        for (int r = 0; r < 16; ++r) m = fmaxf(m, p[t2][r]);
    return fmaxf(m, __shfl_xor(m, 32));
}
__device__ __forceinline__ float half_pv(const LAS unsigned char* lds, int c, int hi, int half, float m, f32x16 (&p)[4], f32x16 (&o)[2]) {
    float l = 0.f;
#pragma unroll
    for (int t2 = 0; t2 < 4; ++t2)
#pragma unroll
        for (int r = 0; r < 16; ++r) { const float e = __builtin_amdgcn_exp2f(p[t2][r] - m); l += e; p[t2][r] = e; }
    l += __shfl_xor(l, 32);
    __builtin_amdgcn_sched_barrier(0);
#pragma unroll
    for (int t2 = 0; t2 < 4; ++t2) {
#pragma unroll
        for (int s2 = 0; s2 < 2; ++s2) {
            u32x4 aw; aw.x = cvtpk(p[t2][8 * s2 + 0], p[t2][8 * s2 + 1]); aw.y = cvtpk(p[t2][8 * s2 + 2], p[t2][8 * s2 + 3]); aw.z = cvtpk(p[t2][8 * s2 + 4], p[t2][8 * s2 + 5]); aw.w = cvtpk(p[t2][8 * s2 + 6], p[t2][8 * s2 + 7]);
            const bf16x8 af = __builtin_bit_cast(bf16x8, aw);
#pragma unroll
            for (int dc = 0; dc < 2; ++dc) {
                const LAS unsigned char* vp = lds + L_V + (32 * dc + c) * VPB + (128 * half + 32 * t2 + 16 * s2 + 4 * hi) * 2;
                const u32x2 b0 = *(const LAS u32x2*)vp, b1 = *(const LAS u32x2*)(vp + 16);
                u32x4 bw; bw.x = b0.x; bw.y = b0.y; bw.z = b1.x; bw.w = b1.y;
                o[dc] = __builtin_amdgcn_mfma_f32_32x32x16_bf16(af, __builtin_bit_cast(bf16x8, bw), o[dc], 0, 0, 0);
            }
            __builtin_amdgcn_sched_barrier(0);
        }
    }
    return l;
}
template <bool OWN>
__device__ __forceinline__ void tile_attn(const LAS unsigned char* lds, LAS float* scr, const bf16x8 (&qf)[4], int c, int hi, int w, int relbase, bool nearb, float& m_out, float& l_out, f32x16 (&o)[2]) {
    f32x16 p[4];
#pragma unroll
    for (int dc = 0; dc < 2; ++dc)
#pragma unroll
        for (int r = 0; r < 16; ++r) o[dc][r] = 0.f;
    half_scores(lds, qf, c, hi, 0, p);
    if (OWN) half_bias(lds, hi, 0, relbase, p); else if (__any(nearb)) { if (nearb) half_bias(lds, hi, 0, relbase, p); }
    float m = half_max(p);
    float l = half_pv(lds, c, hi, 0, m, p, o);
    if (!OWN || w >= 4) {
        half_scores(lds, qf, c, hi, 1, p);
        if (OWN) half_bias(lds, hi, 1, relbase, p); else if (__any(nearb)) { if (nearb) half_bias(lds, hi, 1, relbase, p); }
        const float mn = fmaxf(m, half_max(p));
        const float sc = __builtin_amdgcn_exp2f(m - mn);
        if (hi == 0) scr[c] = sc;
        asm volatile("s_waitcnt lgkmcnt(0)" ::: "memory");
#pragma unroll
        for (int g = 0; g < 4; ++g) { const f32x4 f = *(const LAS f32x4*)(scr + 8 * g + 4 * hi);
#pragma unroll
            for (int dc = 0; dc < 2; ++dc) { o[dc][4 * g + 0] *= f.x; o[dc][4 * g + 1] *= f.y; o[dc][4 * g + 2] *= f.z; o[dc][4 * g + 3] *= f.w; } }
        asm volatile("s_waitcnt lgkmcnt(0)" ::: "memory");
        l = l * sc + half_pv(lds, c, hi, 1, mn, p, o);
        m = mn;
    }
    m_out = m; l_out = l;
}
}

__device__ __forceinline__ void ph_moba_routed(Frame& F, int l) {
    const int tid = tid_now(), lane = tid & 63, wave = __builtin_amdgcn_readfirstlane(tid >> 6); (void)lane; (void)wave;
    unsigned char* const wsl = opaque(F.ws);
    using namespace moba;
    const bf16* Pa = (const bf16*)(wsl + WS_PA); const unsigned* sel = (const unsigned*)(wsl + WS_SEL);
    bf16* OP = (bf16*)(wsl + WS_OP); float* ML = (float*)(wsl + WS_ML);
    const float* relb = F.inp(1);
    LAS unsigned char* lds = F.lds;
    LAS unsigned short* list = (LAS unsigned short*)(lds + L_LIST);
    LAS unsigned* cnt = (LAS unsigned*)(lds + L_CNT);
    const int c = lane & 31, hi = lane >> 5;
    for (;;) {
        __syncthreads();
        if (tid == 0) { cnt[0] = 0u; cnt[1] = __hip_atomic_fetch_add(F.ctl + CW_Q + l, 1u, RLX_AGENT); }
        __syncthreads();
        const int u = (int)cnt[1];
        if (u >= 31 * 32) break;
        const int n = u >> 5, bh = u & 31, b = bh >> 3, h = bh & 7;
        stage_kv(lds, Pa, b * SEQ + n * 256, h, relb, tid);
        const unsigned* sp = sel + (size_t)bh * SEQ;
        for (int s0 = (n + 1) * 256; s0 < SEQ; s0 += 512) {
            const int s = s0 + tid; int slot = -1;
            if (s < SEQ) { const unsigned wv = sp[s]; const int nv = (int)(wv >> 24);
                if (nv > 0 && (int)(wv & 0xffu) == n) slot = 0; else if (nv > 1 && (int)((wv >> 8) & 0xffu) == n) slot = 1; else if (nv > 2 && (int)((wv >> 16) & 0xffu) == n) slot = 2; }
            const unsigned long long bal = __ballot(slot >= 0);
            unsigned base = 0u;
            if (lane == 0 && bal) base = __hip_atomic_fetch_add(&cnt[0], (unsigned)__popcll(bal), __ATOMIC_RELAXED, __HIP_MEMORY_SCOPE_WORKGROUP);
            base = __shfl(base, 0);
            if (slot >= 0) list[base + __popcll(bal & ((1ull << lane) - 1ull))] = (unsigned short)((s << 2) | slot);
        }
        __syncthreads();
        const int L = (int)cnt[0];
        const float c31 = ((const LAS float*)(lds + L_TB))[511];
        LAS bf16* ost = (LAS bf16*)(lds + L_OST + wave * 4608);
        for (int tile = wave; tile * 32 < L; tile += 8) {
            int qi = tile * 32 + c; const bool valid = qi < L; qi = valid ? qi : L - 1;
            const unsigned ent = list[qi]; const int s = (int)(ent >> 2), slot = (int)(ent & 3u);
            const bf16* qp = Pa + (size_t)(b * SEQ + s) * NPA + h * 64 + hi * 8;
            bf16x8 qf[4];
#pragma unroll
            for (int st = 0; st < 4; ++st) qf[st] = *(const bf16x8*)(qp + st * 16);
            const bool nearb = (s >> 8) == n + 1;
            float m, ls; f32x16 o[2];
            tile_attn<false>(lds, (LAS float*)(lds + L_WS + wave * 512), qf, c, hi, 0, s - n * 256, nearb, m, ls, o);
            if (!nearb) m += c31;
            if (valid && hi == 0) { float* mp = ML + ((size_t)((b * SEQ + s) * 8 + h) * 3 + slot) * 2; mp[0] = m; mp[1] = ls; }
#pragma unroll
            for (int dc = 0; dc < 2; ++dc)
#pragma unroll
                for (int r = 0; r < 16; ++r) ost[crow(r, hi) * OSP + 32 * dc + c] = (bf16)f2bf(o[dc][r]);
            asm volatile("s_waitcnt lgkmcnt(0)" ::: "memory");
            { const int q = lane >> 1, half = lane & 1; int qj = tile * 32 + q; const bool vq = qj < L; qj = vq ? qj : L - 1;
              const unsigned e2 = list[qj]; const int s2 = (int)(e2 >> 2), sl2 = (int)(e2 & 3u);
              bf16* dst = OP + ((size_t)((b * SEQ + s2) * 8 + h) * 3 + sl2) * 64 + half * 32;
              if (vq) {
#pragma unroll
                  for (int i = 0; i < 4; ++i) *(u32x4*)(dst + i * 8) = *(const LAS u32x4*)(ost + q * OSP + half * 32 + i * 8); } }
            asm volatile("s_waitcnt lgkmcnt(0)" ::: "memory");
        }
    }
}
__device__ __forceinline__ void ph_moba_own(Frame& F) {
    const int tid = tid_now(), lane = tid & 63, wave = __builtin_amdgcn_readfirstlane(tid >> 6); (void)lane; (void)wave;
    unsigned char* const wsl = opaque(F.ws);
    using namespace moba;
    const bf16* Pa = (const bf16*)(wsl + WS_PA); const unsigned* sel = (const unsigned*)(wsl + WS_SEL);
    const bf16* OP = (const bf16*)(wsl + WS_OP); const float* ML = (const float*)(wsl + WS_ML); bf16* Y = (bf16*)(wsl + WS_Y);
    const float* relb = F.inp(1);
    LAS unsigned char* lds = F.lds;
    const int c = lane & 31, hi = lane >> 5;
    for (int u = blockIdx.x; u < 1024; u += F.G) {
        const int bh = u >> 5, qb = u & 31, b = bh >> 3, h = bh & 7;
        __syncthreads();
        stage_kv(lds, Pa, b * SEQ + qb * 256, h, relb, tid);
        __syncthreads();
        const int s = qb * 256 + wave * 32 + c;
        const bf16* qp = Pa + (size_t)(b * SEQ + s) * NPA + h * 64 + hi * 8;
        bf16x8 qf[4];
#pragma unroll
        for (int st = 0; st < 4; ++st) qf[st] = *(const bf16x8*)(qp + st * 16);
        float m, ls; f32x16 o[2];
        int relb_own = wave * 32 + c; asm volatile("" : "+v"(relb_own));
        tile_attn<true>(lds, (LAS float*)(lds + L_WS + wave * 512), qf, c, hi, wave, relb_own, true, m, ls, o);
        asm volatile("" ::: "memory");
        const unsigned wv = sel[(size_t)bh * SEQ + s]; const int nv = (int)(wv >> 24);
        float ms[3], lsv[3]; float M = m;
#pragma unroll
        for (int j = 0; j < 3; ++j) { if (j < nv) { const float* mp = ML + ((size_t)((b * SEQ + s) * 8 + h) * 3 + j) * 2; ms[j] = mp[0]; lsv[j] = mp[1]; M = fmaxf(M, ms[j]); } else { ms[j] = -INFINITY; lsv[j] = 0.f; } }
        const float a_own = __builtin_amdgcn_exp2f(m - M); float a[3]; float Ls = a_own * ls;
#pragma unroll
        for (int j = 0; j < 3; ++j) { a[j] = (j < nv) ? __builtin_amdgcn_exp2f(ms[j] - M) : 0.f; Ls += a[j] * lsv[j]; }
        const float inv = 1.f / Ls;
        __syncthreads();
        LAS float* fsc = (LAS float*)(lds + L_WS + wave * 512);
        if (hi == 0) { *(LAS f32x4*)(fsc + c * 4) = (f32x4){a_own * inv, a[0] * inv, a[1] * inv, a[2] * inv}; }
        LAS float* of = (LAS float*)(lds + wave * (32 * OFP * 4));
#pragma unroll
        for (int dc = 0; dc < 2; ++dc)
#pragma unroll
            for (int r = 0; r < 16; ++r) of[crow(r, hi) * OFP + 32 * dc + c] = o[dc][r];
        asm volatile("s_waitcnt lgkmcnt(0)" ::: "memory");
#pragma unroll
        for (int it = 0; it < 4; ++it) {
            const int q = it * 8 + (lane >> 3), ch = lane & 7, sq = qb * 256 + wave * 32 + q;
            const f32x4 f = *(const LAS f32x4*)(fsc + q * 4);
            const f32x4 o0 = *(const LAS f32x4*)(of + q * OFP + ch * 8), o1 = *(const LAS f32x4*)(of + q * OFP + ch * 8 + 4);
            float v[8] = {o0.x * f.x, o0.y * f.x, o0.z * f.x, o0.w * f.x, o1.x * f.x, o1.y * f.x, o1.z * f.x, o1.w * f.x};
            const bf16* pp = OP + ((size_t)((b * SEQ + sq) * 8 + h) * 3) * 64 + ch * 8;
#pragma unroll
            for (int j = 0; j < 3; ++j) { const float fj = f[1 + j]; if (fj != 0.f) { float t8[8]; unpack8(*(const u32x4*)(pp + j * 64), t8);
#pragma unroll
                for (int e = 0; e < 8; ++e) v[e] += fj * t8[e]; } }
            *(u32x4*)(Y + (size_t)(b * SEQ + sq) * NYC + 512 + h * 64 + ch * 8) = pack8(v);
        }
    }
}
__device__ __forceinline__ void ph_gla_out(Frame& F, int l) {
    const int tid = tid_now(), lane = tid & 63, wave = __builtin_amdgcn_readfirstlane(tid >> 6); (void)lane; (void)wave;
    unsigned char* const wsl = opaque(F.ws);
    const bf16* Pg = (const bf16*)(wsl + WS_PG); const bf16* GK = (const bf16*)(wsl + WS_GLA); bf16* Y = (bf16*)(wsl + WS_Y);
    LAS float* zs = (LAS float*)F.lds; LAS float* wa = zs + 1024; LAS float* ba = wa + 1024; LAS float* bt = ba + 64; LAS float* la = bt + 64;
    LAS float* qe = la + 64 * 65; LAS float* ke = qe + 64 * 65; LAS float* vs = ke + 64 * 65; LAS float* sp = vs + 64 * 128; LAS float* red = sp + 64 * 128;
        for (int unit = blockIdx.x; unit < 2048; unit += F.G) {
        const int h = unit & 3, cg = unit >> 2, b = cg >> 7, ch = cg & 127, r0 = b * SEQ + ch * 64;
        gla_bcum(F, l, r0, h, zs, wa, ba, bt, la);
        { const int d = tid & 63, j0 = (tid >> 6) * 8;
#pragma unroll
          for (int jj = 0; jj < 8; ++jj) { const int j = j0 + jj; const float bc = la[j * 65 + d];
              qe[j * 65 + d] = bf1(Pg[(size_t)(r0 + j) * NPG + h * 64 + d]) * 0.125f * __expf(bc);
              ke[j * 65 + d] = bf1(Pg[(size_t)(r0 + j) * NPG + 256 + h * 64 + d]) * __expf(-bc); } }
        for (int i = tid; i < 64 * 128; i += 512) { const int j = i >> 7, v = i & 127; vs[i] = bf1(Pg[(size_t)(r0 + j) * NPG + 512 + h * 128 + v]); }
        { const bf16* s = GK + ((size_t)((b * 4 + h) * 128 + ch)) * 8192; for (int i = tid; i < 8192; i += 512) sp[i] = bf1(s[i]); }
        __syncthreads();
        { const int j = tid & 63, i0 = (tid >> 6) * 8;
#pragma unroll
          for (int ii = 0; ii < 8; ++ii) { const int i = i0 + ii; float a = 0.f;
              if (j <= i) {
#pragma unroll 8
                  for (int d = 0; d < 64; ++d) a += qe[i * 65 + d] * ke[j * 65 + d]; }
              la[i * 65 + j] = a; } }
        __syncthreads();
        { const int v = tid & 127, i0 = (tid >> 7) * 16; float acc[16];
#pragma unroll
          for (int ii = 0; ii < 16; ++ii) acc[ii] = 0.f;
#pragma unroll 1
          for (int j = 0; j < 64; ++j) { const float vv = vs[j * 128 + v], sv = sp[j * 128 + v];
#pragma unroll
              for (int ii = 0; ii < 16; ++ii) acc[ii] += la[(i0 + ii) * 65 + j] * vv + qe[(i0 + ii) * 65 + j] * sv; }
#pragma unroll
          for (int ii = 0; ii < 16; ++ii) { const float s2 = wave_sum(acc[ii] * acc[ii]); if ((tid & 63) == 0) red[(i0 + ii) * 2 + ((tid >> 6) & 1)] = s2; }
          __syncthreads();
          const float gn = F.inp(10)[l * 128 + v];
#pragma unroll
          for (int ii = 0; ii < 16; ++ii) { const int i = i0 + ii; const float rs = rsqrtf((red[i * 2] + red[i * 2 + 1]) * (1.f / 128.f) + RMS_EPS);
              const float rr = bf1(Pg[(size_t)(r0 + i) * NPG + 1024 + h * 128 + v]);
              Y[(size_t)(r0 + i) * NYC + 1024 + h * 128 + v] = (bf16)f2bf(acc[ii] * rs * gn * (rr * sigmoidf_(rr))); } }
        __syncthreads();
    }
}
__device__ __forceinline__ void ph_norm_router(Frame& F, int l) {
    const int tid = tid_now(), lane = tid & 63, wave = __builtin_amdgcn_readfirstlane(tid >> 6); (void)lane; (void)wave;
    unsigned char* const wsl = opaque(F.ws);
    const int gw = blockIdx.x * 8 + wave, NGW = F.G * 8;
    const float* gain = F.inp(14) + (size_t)l * 1024; bf16* H = (bf16*)(wsl + WS_H);
    const float* wrg = F.inp(15) + (size_t)l * 1024 * 4; const float* brg = F.inp(16) + l * 4;
    const float* wre = F.inp(17) + (size_t)l * 1024 * 32; const float* bre = F.inp(18) + l * 32;
    int* toke = (int*)(wsl + WS_TOKE); float* tokw = (float*)(wsl + WS_TOKW);
    LAS unsigned* hist = (LAS unsigned*)(F.lds + LTAB_OFF);
    if (tid < 32) hist[tid] = 0u;
    __syncthreads();
    f32x4 g[4];
#pragma unroll
    for (int j = 0; j < 4; ++j) g[j] = *((const f32x4*)gain + 64 * j + lane);
    for (int m = gw; m < T_; m += NGW) {
        const f32x4* xr = (const f32x4*)(F.out + (size_t)m * 1024) + lane;
        f32x4 v[4]; float ss = 0.f;
#pragma unroll
        for (int j = 0; j < 4; ++j) { v[j] = xr[64 * j]; ss += (v[j].x * v[j].x + v[j].y * v[j].y) + (v[j].z * v[j].z + v[j].w * v[j].w); }
        const float rs = rsqrtf(wave_sum(ss) * (1.f / 1024.f) + RMS_EPS);
        u32x2* o8 = (u32x2*)(H + (size_t)m * 1024) + lane;
#pragma unroll
        for (int j = 0; j < 4; ++j) { v[j] = v[j] * rs * g[j]; u32x2 w; w.x = pk2(v[j].x, v[j].y); w.y = pk2(v[j].z, v[j].w); o8[64 * j] = w; }
        float lg[4] = {0.f, 0.f, 0.f, 0.f};
#pragma unroll
        for (int j = 0; j < 4; ++j)
#pragma unroll
            for (int e = 0; e < 4; ++e) { const int k = 4 * (64 * j + lane) + e; const f32x4 w = *(const f32x4*)(wrg + (size_t)k * 4); const float hv = v[j][e];
                lg[0] += hv * w.x; lg[1] += hv * w.y; lg[2] += hv * w.z; lg[3] += hv * w.w; }
#pragma unroll
        for (int i = 0; i < 4; ++i) lg[i] = wave_sum(lg[i]) + brg[i];
        int grp = 0; float gm = lg[0];
#pragma unroll
        for (int i = 1; i < 4; ++i) if (lg[i] > gm) { gm = lg[i]; grp = i; }
        float gs = 0.f;
#pragma unroll
        for (int i = 0; i < 4; ++i) gs += __expf(lg[i] - gm);
        const float pgt = 1.f / gs;
        float le[8];
#pragma unroll
        for (int i = 0; i < 8; ++i) le[i] = 0.f;
#pragma unroll
        for (int j = 0; j < 4; ++j)
#pragma unroll
            for (int e = 0; e < 4; ++e) { const int k = 4 * (64 * j + lane) + e; const float* wp = wre + (size_t)k * 32 + grp * 8; const f32x4 w0 = *(const f32x4*)wp, w1 = *(const f32x4*)(wp + 4); const float hv = v[j][e];
                le[0] += hv * w0.x; le[1] += hv * w0.y; le[2] += hv * w0.z; le[3] += hv * w0.w; le[4] += hv * w1.x; le[5] += hv * w1.y; le[6] += hv * w1.z; le[7] += hv * w1.w; }
#pragma unroll
        for (int i = 0; i < 8; ++i) le[i] = wave_sum(le[i]) + bre[grp * 8 + i];
        int e0 = 0; float m0 = le[0];
#pragma unroll
        for (int i = 1; i < 8; ++i) if (le[i] > m0) { m0 = le[i]; e0 = i; }
        int e1 = -1; float m1 = -INFINITY;
#pragma unroll
        for (int i = 0; i < 8; ++i) if (i != e0 && le[i] > m1) { m1 = le[i]; e1 = i; }
        const float t = __expf(m1 - m0), w0 = pgt / (1.f + t), w1 = pgt * t / (1.f + t);
        if (lane == 0) { toke[2 * m] = grp * 8 + e0; toke[2 * m + 1] = grp * 8 + e1; tokw[2 * m] = w0; tokw[2 * m + 1] = w1;
            (void)__hip_atomic_fetch_add(&hist[grp * 8 + e0], 1u, __ATOMIC_RELAXED, __HIP_MEMORY_SCOPE_WORKGROUP); (void)__hip_atomic_fetch_add(&hist[grp * 8 + e1], 1u, __ATOMIC_RELAXED, __HIP_MEMORY_SCOPE_WORKGROUP); }
    }
    __syncthreads();
    if (tid < 32 && hist[tid]) (void)__hip_atomic_fetch_add(F.ctl + CW_CNT + l * 64 + tid, hist[tid], RLX_AGENT);
    __syncthreads();
}
__device__ __forceinline__ void ph_dispatch(Frame& F, int l) {
    const int tid = tid_now(), lane = tid & 63, wave = __builtin_amdgcn_readfirstlane(tid >> 6); (void)lane; (void)wave;
    unsigned char* const wsl = opaque(F.ws);
    LAS int* pstart = (LAS int*)(F.lds + LTAB_OFF); LAS int* cnt = pstart + 32; LAS unsigned* lhist = (LAS unsigned*)(cnt + 32); LAS int* lbase = (LAS int*)(lhist + 32);
    LAS int* rowof = lbase + 32;
        const int* toke = (const int*)(wsl + WS_TOKE); const float* tokw = (const float*)(wsl + WS_TOKW);
    int* toks = (int*)(wsl + WS_TOKS); float* roww = (float*)(wsl + WS_ROWW); int* blke = (int*)(wsl + WS_BLKE);
    const bf16* H = (const bf16*)(wsl + WS_H); bf16* xs = (bf16*)(wsl + WS_XS);
    if (tid < 32) { cnt[tid] = (int)__hip_atomic_load(F.ctl + CW_CNT + l * 64 + tid, RLX_AGENT); lhist[tid] = 0u; }
    __syncthreads();
    if (tid == 0) { int a = 0; for (int e = 0; e < 32; ++e) { pstart[e] = a; a += ((cnt[e] + 255) >> 8) << 8; } pstart[32 + 32 + 32 + 32 + 256] = a; }
    __syncthreads();
    const int total = pstart[32 + 32 + 32 + 32 + 256];
    if (blockIdx.x == 0) {
        for (int rb = tid; rb < 288; rb += 512) { int e = 31; for (int k = 31; k >= 0; --k) if (rb * 256 < pstart[k] + (((cnt[k] + 255) >> 8) << 8)) e = k; blke[rb] = e; }
        if (tid == 0) blke[300] = total >> 8;
    }
    for (int e = blockIdx.x; e < 32; e += F.G) {
        const int p0 = pstart[e] + cnt[e], p1 = pstart[e] + (((cnt[e] + 255) >> 8) << 8);
        for (int i = tid; i < (p1 - p0) * 128; i += 512) { const int rr = p0 + (i >> 7); *((u32x4*)(xs + (size_t)rr * 1024) + (i & 127)) = (u32x4){0u, 0u, 0u, 0u}; }
        for (int rr = p0 + tid; rr < p1; rr += 512) roww[rr] = 0.f;
    }
    const int tpw = T_ / F.G, t0 = blockIdx.x * tpw;
    int myexp = -1, myrank = 0;
    if (tid < 2 * tpw) { myexp = toke[2 * t0 + tid]; myrank = (int)__hip_atomic_fetch_add(&lhist[myexp], 1u, __ATOMIC_RELAXED, __HIP_MEMORY_SCOPE_WORKGROUP); }
    __syncthreads();
    if (tid < 32) lbase[tid] = lhist[tid] ? (int)__hip_atomic_fetch_add(F.ctl + CW_CUR + l * 64 + tid, lhist[tid], RLX_AGENT) : 0;
    __syncthreads();
    if (tid < 2 * tpw) { const int row = pstart[myexp] + lbase[myexp] + myrank; rowof[tid] = row; toks[2 * t0 + tid] = row; roww[row] = tokw[2 * t0 + tid]; }
    __syncthreads();
    for (int a = wave; a < 2 * tpw; a += 8) { const int row = rowof[a], t = t0 + (a >> 1);
        const u32x4* src = (const u32x4*)(H + (size_t)t * 1024) + lane; u32x4* dst = (u32x4*)(xs + (size_t)row * 1024) + lane;
        dst[0] = src[0]; dst[64] = src[64]; }
    __syncthreads();
}

struct Args { const float* in[22]; float* out; unsigned char* ws; int ph_lo, ph_hi; };
constexpr int NPH = 13;

__global__ void __launch_bounds__(512, 2) fwd_kernel(Args args) {
    extern __shared__ __attribute__((aligned(16))) unsigned char lds_raw[];
    Frame F;
    F.lds = (LAS unsigned char*)lds_raw;
    F.MISC = (volatile LAS unsigned*)(F.lds + MISC_OFF);
    F.tid = threadIdx.x; F.lane = F.tid & 63; F.wave = __builtin_amdgcn_readfirstlane(F.tid >> 6); F.G = gridDim.x;
    F.out = args.out; F.ws = args.ws; F.ctl = (unsigned*)(args.ws + WS_CTL);
    for (int u = F.tid; u < (LDS_BYTES - LDSCTL_OFF) / 4; u += 512) ((LAS unsigned*)(F.lds + LDSCTL_OFF))[u] = 0u;
    __syncthreads();
    if (F.tid < 22) ((LAS unsigned long long*)(F.lds + PTAB_OFF))[F.tid] = (unsigned long long)args.in[F.tid];
    __syncthreads();
    const int lo = args.ph_lo, hi = args.ph_hi;
    const bool use_bar = (hi - lo) > 1;
    XcdBarrier bar; bar.bar = F.ctl + CW_BAR; bar.x = 0; bar.st = nullptr;
    if (use_bar) bar = xcd_barrier_post(F.ctl + CW_BAR, F.MISC + 8);
#define IN(k) (lo <= (k) && (k) < hi)
#define SEAM(k) do { if (IN(k) && IN((k) + 1)) xcd_barrier(bar); } while (0)
    for (int l = 0; l < DEPTH; ++l) {
        const int pb = l * NPH;
#define WSL unsigned char* const ws = opaque(F.ws); unsigned char* const wmix = ws + WS_WMIX + (size_t)l * WMIX_LAYER; (void)wmix
        if (IN(pb + 0)) { WSL;
            if (l == 0) { PM(0) ph_convert_mixer(F); __syncthreads(); PM(11) ph_norm<false, true>(F, F.inp(0), F.inp(2), (bf16*)(ws + WS_H)); }
            else PM(12) ph_norm<true, true>(F, F.out, F.inp(2) + 1024, (bf16*)(ws + WS_H));
        }
        SEAM(pb + 0);
        if (IN(pb + 1)) { WSL;
            pg8::SchedPlain S{(const char*)(ws + WS_H), (const char*)(wmix + WO_WIN), 128, 19, F.G, (int)blockIdx.x, (size_t)256 * 1024 * 2, (size_t)256 * 1024 * 2};
            pg8::EpiInProj E{(bf16*)(ws + WS_PC), (bf16*)(ws + WS_PA), (bf16*)(ws + WS_PG)};
            PM(16) pg8::gemm_phase(F.lds, 1024, 1024, S, E);
        }
        SEAM(pb + 1);
        if (IN(pb + 2)) { PM(1) ph_conv(F, l); PM(2) ph_qknorm(F, l); __syncthreads(); PM(3) ph_gla_kv(F, l); }
        SEAM(pb + 2);
        if (IN(pb + 3)) { PM(4) ph_moba_gate(F); PM(5) ph_gla_scan(F); }
        SEAM(pb + 3);
        if (IN(pb + 4)) {
#if defined(MOBA_NAIVE)
            { LAS float* bias2 = (LAS float*)(F.lds + LTAB_OFF); LAS int* bucket = (LAS int*)(F.lds + LTAB_OFF + 1024);
              if (F.tid < 256) { const int bk = F.tid >> 3, hh = F.tid & 7; bias2[hh * 32 + bk] = F.inp(1)[bk * 8 + hh] * LOG2E;
                  const int n = F.tid; int bq; if (n < 16) bq = n; else { const float sc = logf((float)n / 16.0f) / 2.0794415416798357f; bq = 16 + (int)(sc * 16.0f); if (bq > 31) bq = 31; }
                  bucket[n] = bq; }
              __syncthreads(); }
            PM(6) ph_moba_attn(F); __syncthreads(); PM(7) ph_gla_out(F, l);
#else
            PM(7) ph_gla_out(F, l); __syncthreads(); PM(6) ph_moba_routed(F, l);
#endif
        }
        SEAM(pb + 4);
        if (IN(pb + 12)) {
#if !defined(MOBA_NAIVE)
            PM(14) ph_moba_own(F);
#endif
        }
        SEAM(pb + 12);
        if (IN(pb + 5)) { WSL;
            pg8::SchedBranch S{(const char*)(ws + WS_Y), (const char*)(wmix + WO_WB), F.G, (int)blockIdx.x};
            pg8::EpiBranch E{(bf16*)(ws + WS_BB)};
            PM(17) pg8::gemm_phase(F.lds, 512, NYC, S, E);
        }
        SEAM(pb + 5);
        if (IN(pb + 6)) { WSL;
            pg8::SchedGate S{(const char*)(ws + WS_H), (const char*)(wmix + WO_WG), F.G, (int)blockIdx.x};
            pg8::EpiGateMerge E{(const bf16*)(ws + WS_BB), (bf16*)(ws + WS_MRG)};
            PM(18) pg8::gemm_phase(F.lds, 1024, 1024, S, E);
        }
        SEAM(pb + 6);
        if (IN(pb + 7)) { WSL;
            pg8::SchedPlain S{(const char*)(ws + WS_MRG), (const char*)(wmix + WO_WO), 128, 4, F.G, (int)blockIdx.x, (size_t)256 * 1024 * 2, (size_t)256 * 1024 * 2};
            pg8::EpiOut E{l == 0 ? F.inp(0) : (const float*)F.out, F.out};
            PM(19) pg8::gemm_phase(F.lds, 1024, 1024, S, E);
        }
        SEAM(pb + 7);
        if (IN(pb + 8)) { PM(8) ph_norm_router(F, l); PM(9) ph_convert_experts(F, l); }
        SEAM(pb + 8);
        if (IN(pb + 9)) PM(10) ph_dispatch(F, l);
        SEAM(pb + 9);
        if (IN(pb + 10) || IN(pb + 11)) { WSL;
            LAS int* tab = (LAS int*)(F.lds + LTAB_OFF + 2048);
            const int* blke = (const int*)(ws + WS_BLKE);
            for (int i = F.tid; i < 304; i += 512) tab[i] = blke[i];
            __syncthreads();
            const int nblk = tab[300];
            if (IN(pb + 10)) {
                pg8::SchedMoe S{(const char*)(ws + WS_XS), (const char*)(ws + WS_W1T), tab, nblk * 4, F.G, (int)blockIdx.x, (size_t)256 * 1024 * 2, (size_t)1024 * 1024 * 2, (size_t)256 * 1024 * 2};
                pg8::EpiSwiGLU E{(bf16*)(ws + WS_ACT)};
                PM(20) pg8::gemm_phase(F.lds, 1024, 1024, S, E);
            }
            SEAM(pb + 10);
            if (IN(pb + 11)) {
                pg8::SchedMoe S{(const char*)(ws + WS_ACT), (const char*)(ws + WS_WDT), tab, nblk * 4, F.G, (int)blockIdx.x, (size_t)256 * 512 * 2, (size_t)1024 * 512 * 2, (size_t)256 * 512 * 2};
                pg8::EpiMoeDown E{(bf16*)(ws + WS_YS), (const float*)(ws + WS_ROWW)};
                PM(21) pg8::gemm_phase(F.lds, 512, 512, S, E);
            }
        }
        SEAM(pb + 11);
    }
    if (IN(2 * NPH)) PM(13) ph_norm<true, false>(F, F.out, nullptr, nullptr);
#undef IN
#undef SEAM
#undef WSL
}

extern "C" void kernel_launch(void* const* d_in, const int* in_sizes, int n_in, void* d_out, int out_size, void* d_ws, size_t ws_size, hipStream_t stream) {
    static int grid = 0;
    if (grid == 0) {
        if (n_in != 22 || out_size != T_ * DM || ws_size < WS_END) { fprintf(stderr, "kernel_launch: unexpected shapes (n_in %d out %d ws %zu)\n", n_in, out_size, ws_size); grid = -1; return; }
        if (hipFuncSetAttribute((const void*)fwd_kernel, hipFuncAttributeMaxDynamicSharedMemorySize, LDS_BYTES) != hipSuccess) { fprintf(stderr, "kernel_launch: hipFuncSetAttribute failed\n"); grid = -1; return; }
        int dev = 0, cus = 0, per_cu = 0;
        hipGetDevice(&dev); hipDeviceGetAttribute(&cus, hipDeviceAttributeMultiprocessorCount, dev);
        if (hipOccupancyMaxActiveBlocksPerMultiprocessor(&per_cu, (const void*)fwd_kernel, 512, LDS_BYTES) != hipSuccess || per_cu < 1) fprintf(stderr, "kernel_launch: occupancy query reports %d\n", per_cu);
        (void)hipGetLastError();
        grid = cus > 256 ? 256 : cus;
    }
    if (grid < 0) return;
    (void)hipMemsetAsync((char*)d_ws + WS_CTL, 0, CTL_ZERO_BYTES, stream);
    Args a{};
    for (int i = 0; i < 22; ++i) a.in[i] = (const float*)d_in[i];
    a.out = (float*)d_out; a.ws = (unsigned char*)d_ws; a.ph_lo = 0; a.ph_hi = 2 * NPH + 1;
    hipLaunchKernelGGL(fwd_kernel, dim3(grid), dim3(512), LDS_BYTES, stream, a);
}
```

```cpp
#include <hip/hip_runtime.h>
#include <cstdio>
#include <cstdint>

#define LAS __attribute__((address_space(3)))
#ifndef PHASE_MASK
#define PHASE_MASK 0xffffffffu
#endif
#define PM(k) if ((PHASE_MASK >> (k)) & 1u)
#define GAS __attribute__((address_space(1)))
typedef unsigned short bf16;
typedef short bf16x8 __attribute__((ext_vector_type(8)));
typedef float f32x4 __attribute__((ext_vector_type(4)));
typedef float f32x2 __attribute__((ext_vector_type(2)));
typedef unsigned u32x4 __attribute__((ext_vector_type(4)));
typedef unsigned u32x2 __attribute__((ext_vector_type(2)));
typedef GAS unsigned gu32;

constexpr int T_ = 32768, SEQ = 8192, DM = 1024, DEPTH = 2;
constexpr int NPC = 1536, NPA = 1536, NPG = 1792, NIN = 4864;
constexpr int NYC = 1536;
constexpr int MAXROWS = 73728;
constexpr float RMS_EPS = 1e-6f;
constexpr float LOG2E = 1.4426950408889634f;
constexpr float QSCALE = 0.125f * LOG2E;

constexpr size_t MiB = 1u << 20;
constexpr size_t WS_CTL = 0, CTL_ZERO_BYTES = 1 * MiB;
constexpr size_t WS_MISC = 1 * MiB;
constexpr size_t WS_KMEAN = WS_MISC;
constexpr size_t WS_SEL = WS_MISC + 256 * 1024;
constexpr size_t WS_DEC = WS_SEL + 1 * MiB;
constexpr size_t WS_TOKE = WS_DEC + 512 * 1024;
constexpr size_t WS_TOKW = WS_TOKE + 256 * 1024;
constexpr size_t WS_TOKS = WS_TOKW + 256 * 1024;
constexpr size_t WS_ROWW = WS_TOKS + 256 * 1024;
constexpr size_t WS_BLKE = WS_ROWW + 288 * 1024;
constexpr size_t WS_WMIX = 8 * MiB;
constexpr size_t WMIX_LAYER = 22 * MiB;
constexpr size_t WO_WIN = 0, WO_WG = (size_t)NIN * 1024 * 2, WO_WB = WO_WG + (size_t)3072 * 1024 * 2, WO_WO = WO_WB + (size_t)3 * 1024 * 512 * 2;
constexpr size_t WS_H = 52 * MiB;
constexpr size_t WS_PC = 116 * MiB;
constexpr size_t WS_PA = 212 * MiB;
constexpr size_t WS_PG = 308 * MiB;
constexpr size_t WS_Y = 420 * MiB;
constexpr size_t WS_GLA = 516 * MiB;
constexpr size_t WS_ML = 548 * MiB;
constexpr size_t WS_END = 556 * MiB;
constexpr size_t WS_OP = WS_PC;
constexpr size_t WS_BB = WS_PC;
constexpr size_t WS_MRG = WS_PG;
constexpr size_t WS_W1T = WS_Y;
constexpr size_t WS_WDT = WS_Y + 64 * MiB;
constexpr size_t WS_XS = WS_PC;
constexpr size_t WS_ACT = WS_PG;
constexpr size_t WS_YS = WS_PC;
static_assert(WMIX_LAYER >= WO_WO + (size_t)1024 * 1024 * 2, "mixer weights fit");
static_assert(WS_WMIX + 2 * WMIX_LAYER <= WS_H && WS_BLKE + 2048 <= WS_WMIX, "map");
static_assert((size_t)MAXROWS * 1024 * 2 <= WS_PG - WS_PC && (size_t)MAXROWS * 512 * 2 <= WS_Y - WS_PG, "moe aliases fit");

constexpr int CW_BAR = 4096;
constexpr int CW_CNT = 16384;
constexpr int CW_CUR = 16384 + 256;
constexpr int CW_Q = 16384 + 512;

constexpr int RING_BYTES = 131072;
constexpr int LDSCTL_OFF = RING_BYTES;
constexpr int MISC_OFF = LDSCTL_OFF + 320;
constexpr int PTAB_OFF = LDSCTL_OFF + 512;
constexpr int LTAB_OFF = LDSCTL_OFF + 1024;
constexpr int LDS_BYTES = 147456;

#define RLX_AGENT __ATOMIC_RELAXED, __HIP_MEMORY_SCOPE_AGENT
__device__ __forceinline__ float bflo(unsigned w) { return __uint_as_float(w << 16); }
__device__ __forceinline__ float bfhi(unsigned w) { return __uint_as_float(w & 0xffff0000u); }
__device__ __forceinline__ float bf1(bf16 b) { return __uint_as_float((unsigned)b << 16); }
__device__ __forceinline__ unsigned f2bf(float f) { unsigned u = __float_as_uint(f); return (u + 0x7fffu + ((u >> 16) & 1u)) >> 16; }
__device__ __forceinline__ unsigned pk2(float lo, float hi) { return f2bf(lo) | (f2bf(hi) << 16); }
__device__ __forceinline__ void unpack8(const u32x4 w, float (&v)[8]) {
    v[0] = bflo(w.x); v[1] = bfhi(w.x); v[2] = bflo(w.y); v[3] = bfhi(w.y); v[4] = bflo(w.z); v[5] = bfhi(w.z); v[6] = bflo(w.w); v[7] = bfhi(w.w);
}
__device__ __forceinline__ u32x4 pack8(const float (&v)[8]) { u32x4 w; w.x = pk2(v[0], v[1]); w.y = pk2(v[2], v[3]); w.z = pk2(v[4], v[5]); w.w = pk2(v[6], v[7]); return w; }
__device__ __forceinline__ float wave_sum(float v) {
#pragma unroll
    for (int o = 1; o < 64; o <<= 1) v += __shfl_xor(v, o);
    return v;
}
__device__ __forceinline__ float wave_max(float v) {
#pragma unroll
    for (int o = 1; o < 64; o <<= 1) v = fmaxf(v, __shfl_xor(v, o));
    return v;
}
__device__ __forceinline__ float sigmoidf_(float x) { return __builtin_amdgcn_rcpf(1.0f + __builtin_amdgcn_exp2f(-x * LOG2E)); }

__device__ __forceinline__ int tid_now_() { int t = threadIdx.x; asm volatile("" : "+v"(t)); return t; }
namespace pg8 {
constexpr int BM = 256, BK = 64, HALF = 128, HTB = HALF * BK * 2, STAGE_BYTES = 8 * HTB;
__host__ __device__ __forceinline__ int lds_byte(int r, int c) { const int st = (r >> 4) * 2 + (c >> 5), rr = r & 15, cc = c & 31, ob = rr * 64 + cc * 2; return st * 1024 + (ob ^ (((ob >> 9) & 1) << 5)); }
__host__ __device__ __forceinline__ void stage_rc(int b, int& R, int& C) { const int st = b / 1024, sb = b % 1024, swz = sb ^ (((sb >> 9) & 1) << 5); R = (st >> 1) * 16 + swz / 64; C = (st & 1) * 32 + (swz % 64) / 2; }
__host__ __device__ __forceinline__ int perm32(int rho) { const int n = rho >> 4, i = rho & 15; return 8 * (i >> 2) + 4 * n + (i & 3); }
struct Unit { int pm, pn, z; };
__device__ __forceinline__ void tile_map(int w, int nM, int nN, int& pm, int& pn) {
    const int nwg = nM * nN, q = nwg / 8, r = nwg % 8, xcd = w % 8, off = w / 8;
    const int wg = (xcd < r ? xcd * (q + 1) : r * (q + 1) + (xcd - r) * q) + off;
    const int nig = 8 * nN, gid = wg / nig, fm = gid * 8, gsz = (nM - fm) < 8 ? (nM - fm) : 8;
    pm = fm + ((wg % nig) % gsz); pn = (wg % nig) / gsz;
}
__device__ __forceinline__ unsigned cvt_pk_bf16(float lo, float hi) { unsigned r; asm volatile("v_cvt_pk_bf16_f32 %0, %1, %2" : "=v"(r) : "v"(lo), "v"(hi)); return r; }

template <class Epi, class Sched>
__device__ __forceinline__ void gemm_phase(LAS unsigned char* lds, const int K, const int lda, const Sched& S, const Epi& E) {
    const int tid = tid_now_(), wid = __builtin_amdgcn_readfirstlane(tid >> 6), lane = tid & 63, wr = wid >> 2, wc = wid & 3, fr = lane & 15, fq = lane >> 4;
    const int nt = K / BK;
    unsigned voffA[2], voffB[2];
#pragma unroll
    for (int i = 0; i < 2; ++i) { int R, C; stage_rc(tid * 16 + i * 8192, R, C); const int Rb = Epi::PERM ? ((R & ~31) + perm32(R & 31)) : R;
        voffA[i] = (unsigned)(R * lda + C) * 2u; voffB[i] = (unsigned)(Rb * K + C) * 2u; }
    const size_t kstep = (size_t)(BK * 2);
    const size_t hstepA = (size_t)HALF * lda * 2, hstepB = (size_t)HALF * K * 2;
    const unsigned ldsw = (unsigned)wid * 1024u;
    const int aoff = lds_byte(wr * 64 + fr, fq * 8), boff = lds_byte(wc * 32 + fr, fq * 8);
#define PG8_SA(b, h) (((b) * 2 + (h)) * HTB)
#define PG8_SB(b, h) ((4 + (b) * 2 + (h)) * HTB)
#define PG8_STAGE(bufoff, gbase, voff) do { _Pragma("unroll") for (int _i = 0; _i < 2; ++_i) \
        __builtin_amdgcn_global_load_lds((const unsigned*)((const char*)(gbase) + (voff)[_i]), (LAS unsigned*)(lds + (bufoff) + ldsw + _i * 8192), 16, 0, 0); } while (0)
#define PG8_LDA(dst, b, h) do { _Pragma("unroll") for (int m = 0; m < 4; ++m) _Pragma("unroll") for (int k = 0; k < 2; ++k) dst[m][k] = *(const LAS bf16x8*)(lds + PG8_SA(b, h) + aoff + m * 2048 + k * 1024); } while (0)
#define PG8_LDB(dst, b, h) do { _Pragma("unroll") for (int n = 0; n < 2; ++n) _Pragma("unroll") for (int k = 0; k < 2; ++k) dst[n][k] = *(const LAS bf16x8*)(lds + PG8_SB(b, h) + boff + n * 2048 + k * 1024); } while (0)
#define PG8_MMA(ai, bj, At, Bt) do { __builtin_amdgcn_s_setprio(1); _Pragma("unroll") for (int m = 0; m < 4; ++m) _Pragma("unroll") for (int n = 0; n < 2; ++n) _Pragma("unroll") for (int k = 0; k < 2; ++k) \
        acc[ai][bj][m][n] = __builtin_amdgcn_mfma_f32_16x16x32_bf16(Bt[n][k], At[m][k], acc[ai][bj][m][n], 0, 0, 0); __builtin_amdgcn_s_setprio(0); } while (0)
#define PG8_WAIT_V(n) asm volatile("s_waitcnt vmcnt(" #n ")" ::: "memory")
#define PG8_WAIT_L(n) asm volatile("s_waitcnt lgkmcnt(" #n ")" ::: "memory")
#define PG8_BAR __builtin_amdgcn_s_barrier()
#define PG8_SCHED __builtin_amdgcn_sched_barrier(0)
    Unit cur, nxt; int ui = 0;
    if (!S.next(0, cur)) return;
    f32x4 acc[2][2][4][2];
#pragma unroll
    for (int a = 0; a < 2; ++a)
#pragma unroll
        for (int b = 0; b < 2; ++b)
#pragma unroll
            for (int m = 0; m < 4; ++m)
#pragma unroll
                for (int n = 0; n < 2; ++n) acc[a][b][m][n] = (f32x4){0.f, 0.f, 0.f, 0.f};
    bf16x8 At[4][2], B0[2][2], B1[2][2];
    const char* cA = S.a_ptr(cur); const char* cB = S.b_ptr(cur);
    PG8_STAGE(PG8_SB(0, 0), cB, voffB); PG8_STAGE(PG8_SB(0, 1), cB + hstepB, voffB); PG8_STAGE(PG8_SA(0, 0), cA, voffA); PG8_STAGE(PG8_SA(0, 1), cA + hstepA, voffA);
    if (wr == 1) PG8_BAR;
    PG8_WAIT_V(2); PG8_BAR;
    PG8_STAGE(PG8_SB(1, 0), cB + kstep, voffB); PG8_STAGE(PG8_SA(1, 0), cA + kstep, voffA); PG8_STAGE(PG8_SB(1, 1), cB + hstepB + kstep, voffB);
    PG8_WAIT_V(6); PG8_BAR;
    for (;;) {
        const bool has_next = S.next(ui + 1, nxt);
        const char* nA = has_next ? S.a_ptr(nxt) : cA; const char* nB = has_next ? S.b_ptr(nxt) : cB;
        for (int t = 0; t < nt; t += 2) {
            const bool last = (t == nt - 2);
            const char* a1 = cA + (size_t)(t + 1) * kstep;
            const char* a2 = last ? nA : cA + (size_t)(t + 2) * kstep; const char* b2 = last ? nB : cB + (size_t)(t + 2) * kstep;
            const char* a3 = a2 + kstep; const char* b3 = b2 + kstep;
            PG8_LDB(B0, 0, 0); PG8_LDB(B1, 0, 1); PG8_SCHED; PG8_LDA(At, 0, 0); PG8_STAGE(PG8_SA(1, 1), a1 + hstepA, voffA);
            PG8_WAIT_V(8); PG8_WAIT_L(0); PG8_BAR; PG8_MMA(0, 0, At, B0); PG8_MMA(0, 1, At, B1); PG8_BAR; PG8_SCHED;
            PG8_LDA(At, 0, 1); PG8_STAGE(PG8_SB(0, 0), b2, voffB); PG8_STAGE(PG8_SB(0, 1), b2 + hstepB, voffB); PG8_STAGE(PG8_SA(0, 0), a2, voffA);
            PG8_WAIT_V(8); PG8_WAIT_L(0); PG8_BAR; PG8_MMA(1, 0, At, B0); PG8_MMA(1, 1, At, B1); PG8_BAR; PG8_SCHED;
            PG8_LDB(B0, 1, 0); PG8_LDB(B1, 1, 1); PG8_SCHED; PG8_LDA(At, 1, 0); PG8_STAGE(PG8_SA(0, 1), a2 + hstepA, voffA);
            PG8_WAIT_V(8); PG8_WAIT_L(0); PG8_BAR; PG8_MMA(0, 0, At, B0); PG8_MMA(0, 1, At, B1); PG8_BAR; PG8_SCHED;
            PG8_LDA(At, 1, 1); PG8_STAGE(PG8_SB(1, 0), b3, voffB); PG8_STAGE(PG8_SB(1, 1), b3 + hstepB, voffB); PG8_STAGE(PG8_SA(1, 0), a3, voffA);
            PG8_WAIT_V(8); PG8_WAIT_L(0); PG8_BAR; PG8_MMA(1, 0, At, B0); PG8_MMA(1, 1, At, B1); PG8_BAR; PG8_SCHED;
        }
        if (wr == 0) PG8_BAR;
        E(acc, cur, wr, wc, fr, fq);
        if (!has_next) break;
#pragma unroll
        for (int a = 0; a < 2; ++a)
#pragma unroll
            for (int b = 0; b < 2; ++b)
#pragma unroll
                for (int m = 0; m < 4; ++m)
#pragma unroll
                    for (int n = 0; n < 2; ++n) acc[a][b][m][n] = (f32x4){0.f, 0.f, 0.f, 0.f};
        cur = nxt; cA = nA; cB = nB; ++ui;
        if (wr == 1) PG8_BAR;
    }
    PG8_WAIT_V(0);
    PG8_BAR;
#undef PG8_SA
#undef PG8_SB
#undef PG8_STAGE
#undef PG8_LDA
#undef PG8_LDB
#undef PG8_MMA
#undef PG8_WAIT_V
#undef PG8_WAIT_L
#undef PG8_BAR
#undef PG8_SCHED
}

struct SchedPlain {
    const char* A; const char* Bt; int nM, nN, G, c; size_t astep, bstep;
    __device__ __forceinline__ bool next(int i, Unit& u) const { const int L = i * G + c; if (L >= nM * nN) return false; tile_map(L, nM, nN, u.pm, u.pn); u.z = 0; return true; }
    __device__ __forceinline__ const char* a_ptr(const Unit& u) const { return A + (size_t)u.pm * astep; }
    __device__ __forceinline__ const char* b_ptr(const Unit& u) const { return Bt + (size_t)u.pn * bstep; }
};
struct SchedBranch {
    const char* Y; const char* Wb; int G, c;
    __device__ __forceinline__ bool next(int i, Unit& u) const { const int L = i * G + c; if (L >= 1536) return false; u.z = L / 512; tile_map(L % 512, 128, 4, u.pm, u.pn); return true; }
    __device__ __forceinline__ const char* a_ptr(const Unit& u) const { return Y + (size_t)u.pm * (256 * NYC * 2) + (size_t)u.z * 1024; }
    __device__ __forceinline__ const char* b_ptr(const Unit& u) const { return Wb + (size_t)u.z * (1024 * 512 * 2) + (size_t)u.pn * (256 * 512 * 2); }
};
struct SchedGate {
    const char* H; const char* Wg; int G, c;
    __device__ __forceinline__ bool next(int i, Unit& u) const { const int L = (i / 3) * G + c; if (L >= 512) return false; u.z = i % 3; tile_map(L, 128, 4, u.pm, u.pn); return true; }
    __device__ __forceinline__ const char* a_ptr(const Unit& u) const { return H + (size_t)u.pm * (256 * 1024 * 2); }
    __device__ __forceinline__ const char* b_ptr(const Unit& u) const { return Wg + (size_t)(u.z * 4 + u.pn) * (256 * 1024 * 2); }
};
struct SchedMoe {
    const char* A; const char* W; const LAS int* blk_e; int nU, G, c; size_t astep, estep, bstep;
    __device__ __forceinline__ bool next(int i, Unit& u) const { const int L = i * G + c; if (L >= nU) return false; u.pm = L >> 2; u.pn = L & 3; u.z = blk_e[u.pm]; return true; }
    __device__ __forceinline__ const char* a_ptr(const Unit& u) const { return A + (size_t)u.pm * astep; }
    __device__ __forceinline__ const char* b_ptr(const Unit& u) const { return W + (size_t)u.z * estep + (size_t)u.pn * bstep; }
};

#define EPI_ROWS_BEGIN _Pragma("unroll") for (int ai = 0; ai < 2; ++ai) _Pragma("unroll") for (int m = 0; m < 4; ++m)
struct EpiInProj {
    static constexpr bool PERM = true;
    bf16* Pc; bf16* Pa; bf16* Pg;
    __device__ __forceinline__ void operator()(const f32x4 (&acc)[2][2][4][2], const Unit& u, int wr, int wc, int fr, int fq) const {
        bf16* base; int ld, colt;
        if (u.pn < 6) { base = Pc; ld = NPC; colt = u.pn * 256; } else if (u.pn < 12) { base = Pa; ld = NPA; colt = (u.pn - 6) * 256; } else { base = Pg; ld = NPG; colt = (u.pn - 12) * 256; }
        const int row0 = u.pm * BM + wr * 64 + fr, col0 = colt + wc * 32 + 8 * fq;
        EPI_ROWS_BEGIN { bf16* rowp = base + (size_t)(row0 + ai * HALF + m * 16) * ld + col0;
#pragma unroll
            for (int bj = 0; bj < 2; ++bj) { const f32x4 v0 = acc[ai][bj][m][0], v1 = acc[ai][bj][m][1];
                u32x4 w; w.x = cvt_pk_bf16(v0[0], v0[1]); w.y = cvt_pk_bf16(v0[2], v0[3]); w.z = cvt_pk_bf16(v1[0], v1[1]); w.w = cvt_pk_bf16(v1[2], v1[3]);
                *(u32x4*)(rowp + bj * HALF) = w; } }
    }
};
struct EpiBranch {
    static constexpr bool PERM = true;
    bf16* Bb;
    __device__ __forceinline__ void operator()(const f32x4 (&acc)[2][2][4][2], const Unit& u, int wr, int wc, int fr, int fq) const {
        const int row0 = u.pm * BM + wr * 64 + fr, col0 = u.z * 1024 + u.pn * 256 + wc * 32 + 8 * fq;
        EPI_ROWS_BEGIN { bf16* rowp = Bb + (size_t)(row0 + ai * HALF + m * 16) * 3072 + col0;
#pragma unroll
            for (int bj = 0; bj < 2; ++bj) { const f32x4 v0 = acc[ai][bj][m][0], v1 = acc[ai][bj][m][1];
                u32x4 w; w.x = cvt_pk_bf16(v0[0], v0[1]); w.y = cvt_pk_bf16(v0[2], v0[3]); w.z = cvt_pk_bf16(v1[0], v1[1]); w.w = cvt_pk_bf16(v1[2], v1[3]);
                *(u32x4*)(rowp + bj * HALF) = w; } }
    }
};
struct EpiGateMerge {
    static constexpr bool PERM = true;
    const bf16* Bb; bf16* Mg;
    __device__ __forceinline__ void operator()(const f32x4 (&acc)[2][2][4][2], const Unit& u, int wr, int wc, int fr, int fq) const {
        const int row0 = u.pm * BM + wr * 64 + fr, col0 = u.pn * 256 + wc * 32 + 8 * fq;
        EPI_ROWS_BEGIN { const size_t r = (size_t)(row0 + ai * HALF + m * 16);
#pragma unroll
            for (int bj = 0; bj < 2; ++bj) {
                const u32x4 bw = *(const u32x4*)(Bb + r * 3072 + u.z * 1024 + col0 + bj * HALF);
                float b[8]; unpack8(bw, b);
                float o[8];
#pragma unroll
                for (int e = 0; e < 8; ++e) o[e] = sigmoidf_(acc[ai][bj][m][e >> 2][e & 3]) * b[e];
                bf16* mp = Mg + r * 1024 + col0 + bj * HALF;
                if (u.z != 0) { const u32x4 mw = *(const u32x4*)mp; float pm_[8]; unpack8(mw, pm_);
#pragma unroll
                    for (int e = 0; e < 8; ++e) o[e] += pm_[e]; }
                u32x4 w; w.x = cvt_pk_bf16(o[0], o[1]); w.y = cvt_pk_bf16(o[2], o[3]); w.z = cvt_pk_bf16(o[4], o[5]); w.w = cvt_pk_bf16(o[6], o[7]);
                *(u32x4*)mp = w; } }
    }
};
struct EpiOut {
    static constexpr bool PERM = false;
    const float* xin; float* out;
    __device__ __forceinline__ void operator()(const f32x4 (&acc)[2][2][4][2], const Unit& u, int wr, int wc, int fr, int fq) const {
        const int row0 = u.pm * BM + wr * 64 + fr, col0 = u.pn * BM + wc * 32 + 4 * fq;
        EPI_ROWS_BEGIN { const size_t off = (size_t)(row0 + ai * HALF + m * 16) * 1024 + col0;
#pragma unroll
            for (int bj = 0; bj < 2; ++bj)
#pragma unroll
                for (int n = 0; n < 2; ++n) { const f32x4 xv = *(const f32x4*)(xin + off + bj * HALF + n * 16); *(f32x4*)(out + off + bj * HALF + n * 16) = xv + acc[ai][bj][m][n]; } }
    }
};
struct EpiSwiGLU {
    static constexpr bool PERM = true;
    bf16* act;
    __device__ __forceinline__ void operator()(const f32x4 (&acc)[2][2][4][2], const Unit& u, int wr, int wc, int fr, int fq) const {
        const int row0 = u.pm * BM + wr * 64 + fr, col0 = u.pn * 128 + wc * 32 + 8 * fq;
        EPI_ROWS_BEGIN { bf16* rowp = act + (size_t)(row0 + ai * HALF + m * 16) * 512 + col0;
            float o[8];
#pragma unroll
            for (int e = 0; e < 8; ++e) { const float g = acc[ai][0][m][e >> 2][e & 3], up = acc[ai][1][m][e >> 2][e & 3]; o[e] = g * sigmoidf_(g) * up; }
            u32x4 w; w.x = cvt_pk_bf16(o[0], o[1]); w.y = cvt_pk_bf16(o[2], o[3]); w.z = cvt_pk_bf16(o[4], o[5]); w.w = cvt_pk_bf16(o[6], o[7]);
            *(u32x4*)rowp = w; }
    }
};
struct EpiMoeDown {
    static constexpr bool PERM = true;
    bf16* ys; const float* row_w;
    __device__ __forceinline__ void operator()(const f32x4 (&acc)[2][2][4][2], const Unit& u, int wr, int wc, int fr, int fq) const {
        const int row0 = u.pm * BM + wr * 64 + fr, col0 = u.pn * 256 + wc * 32 + 8 * fq;
        EPI_ROWS_BEGIN { const int r = row0 + ai * HALF + m * 16; const float rw = row_w[r]; bf16* rowp = ys + (size_t)r * 1024 + col0;
#pragma unroll
            for (int bj = 0; bj < 2; ++bj) { const f32x4 v0 = acc[ai][bj][m][0] * rw, v1 = acc[ai][bj][m][1] * rw;
                u32x4 w; w.x = cvt_pk_bf16(v0[0], v0[1]); w.y = cvt_pk_bf16(v0[2], v0[3]); w.z = cvt_pk_bf16(v1[0], v1[1]); w.w = cvt_pk_bf16(v1[2], v1[3]);
                *(u32x4*)(rowp + bj * HALF) = w; } }
    }
};
}

#define XB_TMO      128
#define XB_XCNT(j)  (256  + 64 * (j))
#define XB_XSUB(j)  (1280 + 64 * (j))
#define XB_XGEN(j)  (2304 + 64 * (j))
#define XB_TOP      3328
#define XB_TOPGEN   3392
#define XCD_BAR_WORDS 3456
#define XB_SPIN_CAP (1u << 18)
__device__ __forceinline__ unsigned xb_ld(unsigned* p)              { return __hip_atomic_load(p, __ATOMIC_RELAXED, __HIP_MEMORY_SCOPE_AGENT); }
__device__ __forceinline__ unsigned xb_add(unsigned* p, unsigned v) { return __hip_atomic_fetch_add(p, v, __ATOMIC_RELAXED, __HIP_MEMORY_SCOPE_AGENT); }
__device__ __forceinline__ unsigned xb_xcc_id() { return (unsigned)__builtin_amdgcn_s_getreg((3 << 11) | 20) & 0xFu; }
#define XB_SPIN(cond, bar) do { unsigned _sp = 0; while (cond) { __builtin_amdgcn_s_sleep(1); \
    if ((++_sp & 255u) == 0u) { if (xb_ld(&(bar)[XB_TMO])) break; if (_sp > XB_SPIN_CAP) { atomicAdd(&(bar)[XB_TMO], 1u); break; } } } } while (0)
struct XcdBarrier { unsigned* bar; unsigned x; volatile LAS unsigned* st; };
__device__ __forceinline__ XcdBarrier xcd_barrier_post(unsigned* bar, volatile LAS unsigned* st) {
    XcdBarrier b; b.bar = bar; b.x = xb_xcc_id(); b.st = st;
    if (threadIdx.x == 0) (void)xb_add(&bar[XB_XCNT(b.x)], 1u);
    return b;
}
__device__ __forceinline__ void xcd_barrier_complete(unsigned* bar, unsigned x, unsigned& nloc, unsigned& nx) {
    const unsigned G = gridDim.x * gridDim.y * gridDim.z;
    unsigned sum, cnt, mine, sp = 0u;
    for (;;) {
        sum = 0u; cnt = 0u; mine = 0u;
#pragma unroll
        for (unsigned j = 0; j < 16; ++j) { const unsigned c = xb_ld(&bar[XB_XCNT(j)]); sum += c; cnt += (c > 0u) ? 1u : 0u; mine = (j == x) ? c : mine; }
        if (sum == G) break;
        __builtin_amdgcn_s_sleep(1);
        if ((++sp & 255u) == 0u) { if (xb_ld(&bar[XB_TMO])) break; if (sp > XB_SPIN_CAP) { atomicAdd(&bar[XB_TMO], 1u); break; } }
    }
    nloc = mine > 0u ? mine : 1u; nx = cnt > 0u ? cnt : 1u;
}
__device__ __forceinline__ void xcd_barrier(const XcdBarrier& b) {
    asm volatile("s_waitcnt vmcnt(0)" ::: "memory");
    __syncthreads();
    if (threadIdx.x == 0) {
        unsigned* bar = b.bar;
        __builtin_amdgcn_s_waitcnt(0);
        unsigned nloc = b.st[0], nx = b.st[1];
        if (nloc == 0u) { xcd_barrier_complete(bar, b.x, nloc, nx); b.st[0] = nloc; b.st[1] = nx; }
        const unsigned old = xb_add(&bar[XB_XSUB(b.x)], 1u);
        const unsigned gen = old / nloc;
        if (old + 1u == (gen + 1u) * nloc) {
            __builtin_amdgcn_fence(__ATOMIC_RELEASE, "agent");
            asm volatile("s_waitcnt vmcnt(0)" ::: "memory");
            const unsigned og = xb_add(&bar[XB_TOP], 1u);
            const unsigned tg = og / nx;
            if (og + 1u == (tg + 1u) * nx) xb_add(&bar[XB_TOPGEN], 1u);
            else XB_SPIN(xb_ld(&bar[XB_TOPGEN]) == tg, bar);
            __builtin_amdgcn_fence(__ATOMIC_ACQUIRE, "agent");
            xb_add(&bar[XB_XGEN(b.x)], 1u);
            asm volatile("s_waitcnt vmcnt(0)" ::: "memory");
        } else {
            XB_SPIN(xb_ld(&bar[XB_XGEN(b.x)]) == gen, bar);
            __builtin_amdgcn_fence(__ATOMIC_ACQUIRE, "agent");
            asm volatile("s_waitcnt vmcnt(0)" ::: "memory");
        }
    }
    __syncthreads();
}

struct Frame {
    LAS unsigned char* lds;
    volatile LAS unsigned* MISC;
    unsigned* ctl;
    int tid, lane, wave, G;
    float* out;
    unsigned char* ws;
    __device__ __forceinline__ const float* inp(int k) const {
        const LAS unsigned* p = (const LAS unsigned*)(lds + PTAB_OFF) + 2 * k; const unsigned lo = __builtin_amdgcn_readfirstlane(p[0]), hi = __builtin_amdgcn_readfirstlane(p[1]);
        return (const float*)(const GAS float*)(((unsigned long long)hi << 32) | lo); }
};
__device__ __forceinline__ int tid_now() { int t = threadIdx.x; asm volatile("" : "+v"(t)); return t; }
__device__ __forceinline__ unsigned char* opaque(unsigned char* p) { unsigned z = 0u; asm volatile("" : "+s"(z)); return p + z; }
#define LDS_WAIT() asm volatile("s_waitcnt lgkmcnt(0)" ::: "memory")

__device__ __forceinline__ void transpose_item(const float* W, int ldw, int nvalid, bf16* WT, int Kd, int k0, int n0, int drow0, LAS float* scr, int lane) {
    const int cn = n0 + (lane & 31); const bool ok = cn < nvalid;
#pragma unroll 8
    for (int i = 0; i < 32; ++i) { const int kk = 2 * i + (lane >> 5); scr[kk * 33 + (lane & 31)] = ok ? W[(size_t)(k0 + kk) * ldw + cn] : 0.f; }
    LDS_WAIT(); asm volatile("" ::: "memory");
    const int c = lane & 7;
#pragma unroll
    for (int j = 0; j < 4; ++j) { const int n = (lane >> 3) + 8 * j; const LAS float* s = scr + (8 * c) * 33 + n;
        u32x4 o; o.x = pk2(s[0 * 33], s[1 * 33]); o.y = pk2(s[2 * 33], s[3 * 33]); o.z = pk2(s[4 * 33], s[5 * 33]); o.w = pk2(s[6 * 33], s[7 * 33]);
        *(u32x4*)(WT + (size_t)(drow0 + n) * Kd + k0 + 8 * c) = o; }
    LDS_WAIT(); asm volatile("" ::: "memory");
}

__device__ __forceinline__ void ph_convert_mixer(Frame& F) {
    const int tid = tid_now(), lane = tid & 63, wave = __builtin_amdgcn_readfirstlane(tid >> 6); (void)lane; (void)wave;
    unsigned char* const wsl = opaque(F.ws);
    LAS float* scr = (LAS float*)(F.lds + wave * 16384);
    const int gw = blockIdx.x * 8 + wave, NGW = F.G * 8;
    constexpr int I_IN = 16 * 152, I_G = 3 * 16 * 32, I_B = 3 * 8 * 32, I_O = 16 * 32, I_L = I_IN + I_G + I_B + I_O;
    for (int it = gw; it < 2 * I_L; it += NGW) {
        const int l = it / I_L; int r = it % I_L;
        unsigned char* wb = wsl + WS_WMIX + (size_t)l * WMIX_LAYER;
        if (r < I_IN) { const int kb = r / 152, nb = r % 152;
            transpose_item(F.inp(3) + (size_t)l * 1024 * 4624, 4624, 4624, (bf16*)(wb + WO_WIN), 1024, kb * 64, nb * 32, nb * 32, scr, lane); continue; }
        r -= I_IN;
        if (r < I_G) { const int z = r / 512, q = r % 512, kb = q / 32, nb = q % 32;
            transpose_item(F.inp(11) + ((size_t)l * 3 + z) * 1024 * 1024, 1024, 1024, (bf16*)(wb + WO_WG), 1024, kb * 64, nb * 32, z * 1024 + nb * 32, scr, lane); continue; }
        r -= I_G;
        if (r < I_B) { const int z = r / 256, q = r % 256, kb = q / 32, nb = q % 32;
            transpose_item(F.inp(12) + ((size_t)l * 3 + z) * 512 * 1024, 1024, 1024, (bf16*)(wb + WO_WB) + (size_t)z * 1024 * 512, 512, kb * 64, nb * 32, nb * 32, scr, lane); continue; }
        r -= I_B;
        { const int kb = r / 32, nb = r % 32;
            transpose_item(F.inp(13) + (size_t)l * 1024 * 1024, 1024, 1024, (bf16*)(wb + WO_WO), 1024, kb * 64, nb * 32, nb * 32, scr, lane); }
    }
}
__device__ __forceinline__ void ph_convert_experts(Frame& F, int l) {
    const int tid = tid_now(), lane = tid & 63, wave = __builtin_amdgcn_readfirstlane(tid >> 6); (void)lane; (void)wave;
    unsigned char* const wsl = opaque(F.ws);
    LAS float* scr = (LAS float*)(F.lds + wave * 16384);
    const int gw = blockIdx.x * 8 + wave, NGW = F.G * 8;
    constexpr int I_1 = 32 * 16 * 32, I_2 = 32 * 8 * 32;
    bf16* W1T = (bf16*)(wsl + WS_W1T); bf16* WdT = (bf16*)(wsl + WS_WDT);
    for (int it = gw; it < I_1 + I_2; it += NGW) {
        if (it < I_1) { const int e = it / 512, q = it % 512, kb = q / 32, j = q % 32, half = j >> 4, nb = j & 15;
            const float* src = (half ? F.inp(20) : F.inp(19)) + ((size_t)l * 32 + e) * 1024 * 512;
            const int t = nb >> 2, drow = t * 256 + half * 128 + (nb & 3) * 32;
            transpose_item(src, 512, 512, W1T + (size_t)e * 1024 * 1024, 1024, kb * 64, nb * 32, drow, scr, lane);
        } else { const int r = it - I_1, e = r / 256, q = r % 256, kb = q / 32, nb = q % 32;
            transpose_item(F.inp(21) + ((size_t)l * 32 + e) * 512 * 1024, 1024, 1024, WdT + (size_t)e * 1024 * 512, 512, kb * 64, nb * 32, nb * 32, scr, lane); }
    }
}
template <bool COMBINE, bool NORM>
__device__ __forceinline__ void ph_norm(Frame& F, const float* xin, const float* gain, bf16* H) {
    const int tid = tid_now(), lane = tid & 63, wave = __builtin_amdgcn_readfirstlane(tid >> 6); (void)lane; (void)wave;
    unsigned char* const wsl = opaque(F.ws);
    const int gw = blockIdx.x * 8 + wave, NGW = F.G * 8;
    const int* toks = (const int*)(wsl + WS_TOKS); const bf16* ys = (const bf16*)(wsl + WS_YS);
    f32x4 g[4];
#pragma unroll
    for (int j = 0; j < 4; ++j) g[j] = NORM ? *((const f32x4*)gain + 64 * j + lane) : (f32x4){0.f, 0.f, 0.f, 0.f};
    for (int m = gw; m < T_; m += NGW) {
        const f32x4* xr = (const f32x4*)(xin + (size_t)m * 1024) + lane;
        f32x4 v[4];
#pragma unroll
        for (int j = 0; j < 4; ++j) v[j] = xr[64 * j];
        if (COMBINE) {
            const int s0 = toks[2 * m], s1 = toks[2 * m + 1];
            const u32x2* y0 = (const u32x2*)(ys + (size_t)s0 * 1024) + lane; const u32x2* y1 = (const u32x2*)(ys + (size_t)s1 * 1024) + lane;
#pragma unroll
            for (int j = 0; j < 4; ++j) { const u32x2 a = y0[64 * j], b = y1[64 * j];
                v[j].x += bflo(a.x) + bflo(b.x); v[j].y += bfhi(a.x) + bfhi(b.x); v[j].z += bflo(a.y) + bflo(b.y); v[j].w += bfhi(a.y) + bfhi(b.y); }
            f32x4* xo = (f32x4*)(F.out + (size_t)m * 1024) + lane;
#pragma unroll
            for (int j = 0; j < 4; ++j) xo[64 * j] = v[j];
        }
        if (NORM) {
            float ss = 0.f;
#pragma unroll
            for (int j = 0; j < 4; ++j) ss += (v[j].x * v[j].x + v[j].y * v[j].y) + (v[j].z * v[j].z + v[j].w * v[j].w);
            const float rs = rsqrtf(wave_sum(ss) * (1.f / 1024.f) + RMS_EPS);
            u32x2* o8 = (u32x2*)(H + (size_t)m * 1024) + lane;
#pragma unroll
            for (int j = 0; j < 4; ++j) { u32x2 w; w.x = pk2(v[j].x * rs * g[j].x, v[j].y * rs * g[j].y); w.y = pk2(v[j].z * rs * g[j].z, v[j].w * rs * g[j].w); o8[64 * j] = w; }
        }
    }
}

__device__ __forceinline__ void ph_conv(Frame& F, int l) {
    const int tid = tid_now(), lane = tid & 63, wave = __builtin_amdgcn_readfirstlane(tid >> 6); (void)lane; (void)wave;
    unsigned char* const wsl = opaque(F.ws);
    const bf16* Pc = (const bf16*)(wsl + WS_PC); bf16* Y = (bf16*)(wsl + WS_Y);
    const float* cw = F.inp(4) + (size_t)l * 3 * 512; const float* cbias = F.inp(5) + (size_t)l * 512;
    const int gt = blockIdx.x * 512 + tid, NT = F.G * 512;
    for (int item = gt; item < T_ * 64; item += NT) {
        const int r = item >> 6, c8 = (item & 63) * 8, s = r & (SEQ - 1);
        const bf16* p = Pc + (size_t)r * NPC + c8;
        float cb[8], a[8], b[8], u0[8], u1[8], u2[8];
        unpack8(*(const u32x4*)p, cb);
        unpack8(*(const u32x4*)(p + 512), a); unpack8(*(const u32x4*)(p + 1024), b);
#pragma unroll
        for (int e = 0; e < 8; ++e) u2[e] = a[e] * b[e];
        if (s >= 1) { unpack8(*(const u32x4*)(p - NPC + 512), a); unpack8(*(const u32x4*)(p - NPC + 1024), b);
#pragma unroll
            for (int e = 0; e < 8; ++e) u1[e] = a[e] * b[e]; }
        else {
#pragma unroll
            for (int e = 0; e < 8; ++e) u1[e] = 0.f; }
        if (s >= 2) { unpack8(*(const u32x4*)(p - 2 * NPC + 512), a); unpack8(*(const u32x4*)(p - 2 * NPC + 1024), b);
#pragma unroll
            for (int e = 0; e < 8; ++e) u0[e] = a[e] * b[e]; }
        else {
#pragma unroll
            for (int e = 0; e < 8; ++e) u0[e] = 0.f; }
        float o[8];
#pragma unroll
        for (int e = 0; e < 8; ++e) o[e] = cb[e] * (cbias[c8 + e] + cw[c8 + e] * u0[e] + cw[512 + c8 + e] * u1[e] + cw[1024 + c8 + e] * u2[e]);
        *(u32x4*)(Y + (size_t)r * NYC + c8) = pack8(o);
    }
}
__device__ __forceinline__ void ph_qknorm(Frame& F, int l) {
    const int tid = tid_now(), lane = tid & 63, wave = __builtin_amdgcn_readfirstlane(tid >> 6); (void)lane; (void)wave;
    unsigned char* const wsl = opaque(F.ws);
    bf16* Pa = (bf16*)(wsl + WS_PA); float* kmean = (float*)(wsl + WS_KMEAN);
    LAS float* red = (LAS float*)F.lds;
    for (int unit = blockIdx.x; unit < 256; unit += F.G) {
        const int blk = unit >> 1, isk = unit & 1;
        const float* gn = (isk ? F.inp(7) : F.inp(6)) + l * 64 + (lane & 7) * 8;
        float g[8], ksum[8];
#pragma unroll
        for (int e = 0; e < 8; ++e) { g[e] = gn[e] * (isk ? 1.f : QSCALE); ksum[e] = 0.f; }
        for (int rr = 0; rr < 32; ++rr) {
            const int r = blk * 256 + wave * 32 + rr;
            bf16* p = Pa + (size_t)r * NPA + isk * 512 + lane * 8;
            float v[8]; unpack8(*(const u32x4*)p, v);
            float ss = 0.f;
#pragma unroll
            for (int e = 0; e < 8; ++e) ss += v[e] * v[e];
            ss += __shfl_xor(ss, 1); ss += __shfl_xor(ss, 2); ss += __shfl_xor(ss, 4);
            const float rs = rsqrtf(ss * (1.f / 64.f) + RMS_EPS);
#pragma unroll
            for (int e = 0; e < 8; ++e) { v[e] = v[e] * rs * g[e]; ksum[e] += v[e]; }
            *(u32x4*)p = pack8(v);
        }
        if (isk) {
#pragma unroll
            for (int e = 0; e < 8; ++e) red[wave * 512 + lane * 8 + e] = ksum[e];
            __syncthreads();
            { const int col = tid; float s = 0.f;
#pragma unroll
              for (int w = 0; w < 8; ++w) s += red[w * 512 + col];
              const int b = blk >> 5, n = blk & 31, h = col >> 6, d = col & 63;
              kmean[((size_t)((b * 8 + h) * 32 + n)) * 64 + d] = s * (1.f / 256.f); }
            __syncthreads();
        }
    }
}
__device__ __forceinline__ void ph_moba_gate(Frame& F) {
    const int tid = tid_now(), lane = tid & 63, wave = __builtin_amdgcn_readfirstlane(tid >> 6); (void)lane; (void)wave;
    unsigned char* const wsl = opaque(F.ws);
    const bf16* Pa = (const bf16*)(wsl + WS_PA); const float* kmean = (const float*)(wsl + WS_KMEAN); unsigned* sel = (unsigned*)(wsl + WS_SEL);
    LAS float* km = (LAS float*)(F.lds + wave * 8192);
    const int gw = blockIdx.x * 8 + wave, NGW = F.G * 8;
    for (int it = gw; it < 512 * 8; it += NGW) {
        const int rb = it >> 3, h = it & 7, r = rb * 64 + lane, b = rb >> 7, qb = (rb & 127) >> 2;
        for (int i = lane; i < 2048; i += 64) km[i] = kmean[(size_t)(b * 8 + h) * 2048 + i];
        float q[64];
#pragma unroll
        for (int c = 0; c < 8; ++c) { float t8[8]; unpack8(*(const u32x4*)(Pa + (size_t)r * NPA + h * 64 + c * 8), t8);
#pragma unroll
            for (int e = 0; e < 8; ++e) q[c * 8 + e] = t8[e]; }
        LDS_WAIT(); asm volatile("" ::: "memory");
        float v0 = -INFINITY, v1 = -INFINITY, v2 = -INFINITY; int i0 = 0, i1 = 1, i2 = 2;
        for (int n = 0; n < qb; ++n) {
            float s = 0.f;
#pragma unroll
            for (int d = 0; d < 64; ++d) s += q[d] * km[n * 64 + d];
            if (s > v0) { v2 = v1; i2 = i1; v1 = v0; i1 = i0; v0 = s; i0 = n; }
            else if (s > v1) { v2 = v1; i2 = i1; v1 = s; i1 = n; }
            else if (s > v2) { v2 = s; i2 = n; }
        }
        const int nv = qb < 3 ? qb : 3;
        sel[(size_t)(b * 8 + h) * SEQ + (r & (SEQ - 1))] = (unsigned)i0 | ((unsigned)i1 << 8) | ((unsigned)i2 << 16) | ((unsigned)nv << 24);
        asm volatile("" ::: "memory");
    }
}
__device__ __forceinline__ void ph_gla_scan(Frame& F) {
    const int tid = tid_now(), lane = tid & 63, wave = __builtin_amdgcn_readfirstlane(tid >> 6); (void)lane; (void)wave;
    unsigned char* const wsl = opaque(F.ws);
    bf16* GK = (bf16*)(wsl + WS_GLA); const float* DEC = (const float*)(wsl + WS_DEC);
    const int gt = blockIdx.x * 512 + tid, NT = F.G * 512;
    for (int e = gt; e < 16 * 8192; e += NT) {
        const int bh = e >> 13, dv = e & 8191, d = dv & 63;
        bf16* p = GK + (size_t)bh * 128 * 8192 + dv; const float* dc = DEC + (size_t)bh * 128 * 64 + d;
        float st = 0.f;
        for (int n0 = 0; n0 < 128; n0 += 16) {
            float kv[16], de[16];
#pragma unroll
            for (int i = 0; i < 16; ++i) { kv[i] = bf1(p[(size_t)(n0 + i) * 8192]); de[i] = dc[(n0 + i) * 64]; }
#pragma unroll
            for (int i = 0; i < 16; ++i) { p[(size_t)(n0 + i) * 8192] = (bf16)f2bf(st); st = de[i] * st + kv[i]; }
        }
    }
}
__device__ __forceinline__ void ph_moba_attn(Frame& F) {
    const int tid = tid_now(), lane = tid & 63, wave = __builtin_amdgcn_readfirstlane(tid >> 6); (void)lane; (void)wave;
    unsigned char* const wsl = opaque(F.ws);
    const bf16* Pa = (const bf16*)(wsl + WS_PA); const unsigned* sel = (const unsigned*)(wsl + WS_SEL); bf16* Y = (bf16*)(wsl + WS_Y);
    LAS float* pl = (LAS float*)(F.lds + wave * 8192);
    const LAS float* bias2 = (const LAS float*)(F.lds + LTAB_OFF);
    const LAS int* bucket = (const LAS int*)(F.lds + LTAB_OFF + 1024);
    const int gw = blockIdx.x * 8 + wave, NGW = F.G * 8;
    for (int it = gw; it < T_ * 8; it += NGW) {
        const int r = it >> 3, h = it & 7, b = r >> 13, s = r & (SEQ - 1), qb = s >> 8;
        const unsigned sw = sel[(size_t)(b * 8 + h) * SEQ + s]; const int nv = (int)(sw >> 24);
        float q[64];
#pragma unroll
        for (int c = 0; c < 8; ++c) { float t8[8]; unpack8(*(const u32x4*)(Pa + (size_t)r * NPA + h * 64 + c * 8), t8);
#pragma unroll
            for (int e = 0; e < 8; ++e) q[c * 8 + e] = t8[e]; }
        float sc[4][4]; float mx = -INFINITY;
#pragma unroll
        for (int i = 0; i < 4; ++i) {
            const bool valid = (i < 3) ? (i < nv) : true;
            const int blk = (i < 3) ? (int)((sw >> (8 * i)) & 0xffu) : qb;
            if (valid) {
#pragma unroll
                for (int kk = 0; kk < 4; ++kk) {
                    const int kpos = blk * 256 + lane + 64 * kk;
                    const bf16* kp = Pa + (size_t)(b * SEQ + kpos) * NPA + 512 + h * 64;
                    float d = 0.f;
#pragma unroll
                    for (int c = 0; c < 8; ++c) { float t8[8]; unpack8(*(const u32x4*)(kp + c * 8), t8);
#pragma unroll
                        for (int e = 0; e < 8; ++e) d += q[c * 8 + e] * t8[e]; }
                    const int rel = s - kpos;
                    const float v = (rel < 0) ? -INFINITY : d + bias2[h * 32 + bucket[rel > 255 ? 255 : rel]];
                    sc[i][kk] = v; mx = fmaxf(mx, v);
                    asm volatile("" ::: "memory");
                }
            } else {
#pragma unroll
                for (int kk = 0; kk < 4; ++kk) sc[i][kk] = -INFINITY;
            }
        }
        mx = wave_max(mx);
        float ls = 0.f;
#pragma unroll
        for (int i = 0; i < 4; ++i)
#pragma unroll
            for (int kk = 0; kk < 4; ++kk) { const float p = __builtin_amdgcn_exp2f(sc[i][kk] - mx); ls += p; pl[i * 256 + lane + 64 * kk] = p; }
        ls = wave_sum(ls);
        LDS_WAIT(); asm volatile("" ::: "memory");
        float acc[8];
#pragma unroll
        for (int e = 0; e < 8; ++e) acc[e] = 0.f;
#pragma unroll
        for (int i = 0; i < 4; ++i) {
            const bool valid = (i < 3) ? (i < nv) : true;
            const int blk = (i < 3) ? (int)((sw >> (8 * i)) & 0xffu) : qb;
            if (valid) {
                const bf16* vp = Pa + (size_t)(b * SEQ + blk * 256 + (lane >> 3)) * NPA + 1024 + h * 64 + (lane & 7) * 8;
#pragma unroll 4
                for (int k0 = 0; k0 < 256; k0 += 8) {
                    const float p = pl[i * 256 + k0 + (lane >> 3)];
                    float t8[8]; unpack8(*(const u32x4*)(vp + (size_t)k0 * NPA), t8);
#pragma unroll
                    for (int e = 0; e < 8; ++e) acc[e] += p * t8[e];
                }
            }
        }
#pragma unroll
        for (int e = 0; e < 8; ++e) { acc[e] += __shfl_xor(acc[e], 8); acc[e] += __shfl_xor(acc[e], 16); acc[e] += __shfl_xor(acc[e], 32); }
        const float inv = 1.f / ls;
        if (lane < 8) { float o[8];
#pragma unroll
            for (int e = 0; e < 8; ++e) o[e] = acc[e] * inv;
            *(u32x4*)(Y + (size_t)r * NYC + 512 + h * 64 + lane * 8) = pack8(o); }
        asm volatile("" ::: "memory");
    }
}

namespace moba {
typedef float f32x16 __attribute__((ext_vector_type(16)));
constexpr int KPB = 144;
constexpr int VPB = 520;
constexpr int L_K = 0, L_V = 36864, L_TB = 70144, L_LIST = 72192, L_OST = 88576, L_WS = 125440, L_CNT = 129536;
constexpr int OSP = 72;
constexpr int OFP = 68;
__device__ __forceinline__ int crow(int r, int hi) { return (r & 3) + 8 * (r >> 2) + 4 * hi; }
__device__ __forceinline__ unsigned cvtpk(float lo, float hi) { unsigned r; asm volatile("v_cvt_pk_bf16_f32 %0, %1, %2" : "=v"(r) : "v"(lo), "v"(hi)); return r; }

__device__ __forceinline__ void stage_kv(LAS unsigned char* lds, const bf16* Pa, int krow0, int h, const float* relb, int tid) {
#pragma unroll
    for (int i = 0; i < 4; ++i) { const int id = tid + 512 * i, kv = id >> 3, dc = id & 7;
        const bf16* src = Pa + (size_t)(krow0 + kv) * NPA + h * 64 + dc * 8;
        const u32x4 kw = *(const u32x4*)(src + 512), vw = *(const u32x4*)(src + 1024);
        *(LAS u32x4*)(lds + L_K + kv * KPB + dc * 16) = kw;
        LAS bf16* vt = (LAS bf16*)(lds + L_V) + (dc * 8) * (VPB / 2) + kv;
        vt[0 * (VPB / 2)] = (bf16)(vw.x & 0xffffu); vt[1 * (VPB / 2)] = (bf16)(vw.x >> 16); vt[2 * (VPB / 2)] = (bf16)(vw.y & 0xffffu); vt[3 * (VPB / 2)] = (bf16)(vw.y >> 16);
        vt[4 * (VPB / 2)] = (bf16)(vw.z & 0xffffu); vt[5 * (VPB / 2)] = (bf16)(vw.z >> 16); vt[6 * (VPB / 2)] = (bf16)(vw.w & 0xffffu); vt[7 * (VPB / 2)] = (bf16)(vw.w >> 16); }
    if (tid < 256) { const int n = tid; int bq; if (n < 16) bq = n; else { const float sc = logf((float)n / 16.0f) / 2.0794415416798357f; bq = 16 + (int)(sc * 16.0f); if (bq > 31) bq = 31; }
        ((LAS float*)(lds + L_TB))[256 + n] = relb[bq * 8 + h] * LOG2E; ((LAS float*)(lds + L_TB))[n] = -INFINITY; }
}

__device__ __forceinline__ void half_scores(const LAS unsigned char* lds, const bf16x8 (&qf)[4], int c, int hi, int half, f32x16 (&p)[4]) {
#pragma unroll
    for (int t2 = 0; t2 < 4; ++t2) {
        f32x16 acc = {0.f, 0.f, 0.f, 0.f, 0.f, 0.f, 0.f, 0.f, 0.f, 0.f, 0.f, 0.f, 0.f, 0.f, 0.f, 0.f};
#pragma unroll
        for (int st = 0; st < 4; ++st) { const bf16x8 kf = *(const LAS bf16x8*)(lds + L_K + (128 * half + 32 * t2 + c) * KPB + st * 32 + hi * 16); acc = __builtin_amdgcn_mfma_f32_32x32x16_bf16(kf, qf[st], acc, 0, 0, 0); }
        p[t2] = acc;
        __builtin_amdgcn_sched_barrier(0);
    }
}
__device__ __forceinline__ void half_bias(const LAS unsigned char* lds, int hi, int half, int relbase, f32x16 (&p)[4]) {
    const LAS float* tb = (const LAS float*)(lds + L_TB);
#pragma unroll
    for (int t2 = 0; t2 < 4; ++t2) {
#pragma unroll
        for (int r = 0; r < 16; ++r) { int idx = relbase - (128 * half + 32 * t2 + crow(r, hi)) + 256; idx = idx > 511 ? 511 : idx; p[t2][r] += tb[idx]; }
        __builtin_amdgcn_sched_barrier(0); }
}
__device__ __forceinline__ float half_max(const f32x16 (&p)[4]) {
    float m = -INFINITY;
#pragma unroll
    for (int t2 = 0; t2 < 4; ++t2)
#pragma unroll
        for (int r = 0; r < 16; ++r) m = fmaxf(m, p[t2][r]);
    return fmaxf(m, __shfl_xor(m, 32));
}
__device__ __forceinline__ float half_pv(const LAS unsigned char* lds, int c, int hi, int half, float m, f32x16 (&p)[4], f32x16 (&o)[2]) {
    float l = 0.f;
#pragma unroll
    for (int t2 = 0; t2 < 4; ++t2)
#pragma unroll
        for (int r = 0; r < 16; ++r) { const float e = __builtin_amdgcn_exp2f(p[t2][r] - m); l += e; p[t2][r] = e; }
    l += __shfl_xor(l, 32);
    __builtin_amdgcn_sched_barrier(0);
#pragma unroll
    for (int t2 = 0; t2 < 4; ++t2) {
#pragma unroll
        for (int s2 = 0; s2 < 2; ++s2) {
            u32x4 aw; aw.x = cvtpk(p[t2][8 * s2 + 0], p[t2][8 * s2 + 1]); aw.y = cvtpk(p[t2][8 * s2 + 2], p[t2][8 * s2 + 3]); aw.z = cvtpk(p[t2][8 * s2 + 4], p[t2][8 * s2 + 5]); aw.w = cvtpk(p[t2][8 * s2 + 6], p[t2][8 * s2 + 7]);
            const bf16x8 af = __builtin_bit_cast(bf16x8, aw);
#pragma unroll
            for (int dc = 0; dc < 2; ++dc) {
                const LAS unsigned char* vp = lds + L_V + (32 * dc + c) * VPB + (128 * half + 32 * t2 + 16 * s2 + 4 * hi) * 2;
                const u32x2 b0 = *(const LAS u32x2*)vp, b1 = *(const LAS u32x2*)(vp + 16);
                u32x4 bw; bw.x = b0.x; bw.y = b0.y; bw.z = b1.x; bw.w = b1.y;
                o[dc] = __builtin_amdgcn_mfma_f32_32x32x16_bf16(af, __builtin_bit_cast(bf16x8, bw), o[dc], 0, 0, 0);
            }
            __builtin_amdgcn_sched_barrier(0);
        }
    }
    return l;
}
template <bool OWN>
__device__ __forceinline__ void tile_attn(const LAS unsigned char* lds, LAS float* scr, const bf16x8 (&qf)[4], int c, int hi, int w, int relbase, bool nearb, float& m_out, float& l_out, f32x16 (&o)[2]) {
    f32x16 p[4];
#pragma unroll
    for (int dc = 0; dc < 2; ++dc)
#pragma unroll
        for (int r = 0; r < 16; ++r) o[dc][r] = 0.f;
    half_scores(lds, qf, c, hi, 0, p);
    if (OWN) half_bias(lds, hi, 0, relbase, p); else if (__any(nearb)) { if (nearb) half_bias(lds, hi, 0, relbase, p); }
    float m = half_max(p);
    float l = half_pv(lds, c, hi, 0, m, p, o);
    if (!OWN || w >= 4) {
        half_scores(lds, qf, c, hi, 1, p);
        if (OWN) half_bias(lds, hi, 1, relbase, p); else if (__any(nearb)) { if (nearb) half_bias(lds, hi, 1, relbase, p); }
        const float mn = fmaxf(m, half_max(p));
        const float sc = __builtin_amdgcn_exp2f(m - mn);
        if (hi == 0) scr[c] = sc;
        asm volatile("s_waitcnt lgkmcnt(0)" ::: "memory");
#pragma unroll
        for (int g = 0; g < 4; ++g) { const f32x4 f = *(const LAS f32x4*)(scr + 8 * g + 4 * hi);
#pragma unroll
            for (int dc = 0; dc < 2; ++dc) { o[dc][4 * g + 0] *= f.x; o[dc][4 * g + 1] *= f.y; o[dc][4 * g + 2] *= f.z; o[dc][4 * g + 3] *= f.w; } }
        asm volatile("s_waitcnt lgkmcnt(0)" ::: "memory");
        l = l * sc + half_pv(lds, c, hi, 1, mn, p, o);
        m = mn;
    }
    m_out = m; l_out = l;
}
}

__device__ __forceinline__ void ph_moba_routed(Frame& F, int l) {
    const int tid = tid_now(), lane = tid & 63, wave = __builtin_amdgcn_readfirstlane(tid >> 6); (void)lane; (void)wave;
    unsigned char* const wsl = opaque(F.ws);
    using namespace moba;
    const bf16* Pa = (const bf16*)(wsl + WS_PA); const unsigned* sel = (const unsigned*)(wsl + WS_SEL);
    bf16* OP = (bf16*)(wsl + WS_OP); float* ML = (float*)(wsl + WS_ML);
    const float* relb = F.inp(1);
    LAS unsigned char* lds = F.lds;
    LAS unsigned short* list = (LAS unsigned short*)(lds + L_LIST);
    LAS unsigned* cnt = (LAS unsigned*)(lds + L_CNT);
    const int c = lane & 31, hi = lane >> 5;
    for (;;) {
        __syncthreads();
        if (tid == 0) { cnt[0] = 0u; cnt[1] = __hip_atomic_fetch_add(F.ctl + CW_Q + l, 1u, RLX_AGENT); }
        __syncthreads();
        const int u = (int)cnt[1];
        if (u >= 31 * 32) break;
        const int n = u >> 5, bh = u & 31, b = bh >> 3, h = bh & 7;
        stage_kv(lds, Pa, b * SEQ + n * 256, h, relb, tid);
        const unsigned* sp = sel + (size_t)bh * SEQ;
        for (int s0 = (n + 1) * 256; s0 < SEQ; s0 += 512) {
            const int s = s0 + tid; int slot = -1;
            if (s < SEQ) { const unsigned wv = sp[s]; const int nv = (int)(wv >> 24);
                if (nv > 0 && (int)(wv & 0xffu) == n) slot = 0; else if (nv > 1 && (int)((wv >> 8) & 0xffu) == n) slot = 1; else if (nv > 2 && (int)((wv >> 16) & 0xffu) == n) slot = 2; }
            const unsigned long long bal = __ballot(slot >= 0);
            unsigned base = 0u;
            if (lane == 0 && bal) base = __hip_atomic_fetch_add(&cnt[0], (unsigned)__popcll(bal), __ATOMIC_RELAXED, __HIP_MEMORY_SCOPE_WORKGROUP);
            base = __shfl(base, 0);
            if (slot >= 0) list[base + __popcll(bal & ((1ull << lane) - 1ull))] = (unsigned short)((s << 2) | slot);
        }
        __syncthreads();
        const int L = (int)cnt[0];
        const float c31 = ((const LAS float*)(lds + L_TB))[511];
        LAS bf16* ost = (LAS bf16*)(lds + L_OST + wave * 4608);
        for (int tile = wave; tile * 32 < L; tile += 8) {
            int qi = tile * 32 + c; const bool valid = qi < L; qi = valid ? qi : L - 1;
            const unsigned ent = list[qi]; const int s = (int)(ent >> 2), slot = (int)(ent & 3u);
            const bf16* qp = Pa + (size_t)(b * SEQ + s) * NPA + h * 64 + hi * 8;
            bf16x8 qf[4];
#pragma unroll
            for (int st = 0; st < 4; ++st) qf[st] = *(const bf16x8*)(qp + st * 16);
            const bool nearb = (s >> 8) == n + 1;
            float m, ls; f32x16 o[2];
            tile_attn<false>(lds, (LAS float*)(lds + L_WS + wave * 512), qf, c, hi, 0, s - n * 256, nearb, m, ls, o);
            if (!nearb) m += c31;
            if (valid && hi == 0) { float* mp = ML + ((size_t)((b * SEQ + s) * 8 + h) * 3 + slot) * 2; mp[0] = m; mp[1] = ls; }
#pragma unroll
            for (int dc = 0; dc < 2; ++dc)
#pragma unroll
                for (int r = 0; r < 16; ++r) ost[crow(r, hi) * OSP + 32 * dc + c] = (bf16)f2bf(o[dc][r]);
            asm volatile("s_waitcnt lgkmcnt(0)" ::: "memory");
            { const int q = lane >> 1, half = lane & 1; int qj = tile * 32 + q; const bool vq = qj < L; qj = vq ? qj : L - 1;
              const unsigned e2 = list[qj]; const int s2 = (int)(e2 >> 2), sl2 = (int)(e2 & 3u);
              bf16* dst = OP + ((size_t)((b * SEQ + s2) * 8 + h) * 3 + sl2) * 64 + half * 32;
              if (vq) {
#pragma unroll
                  for (int i = 0; i < 4; ++i) *(u32x4*)(dst + i * 8) = *(const LAS u32x4*)(ost + q * OSP + half * 32 + i * 8); } }
            asm volatile("s_waitcnt lgkmcnt(0)" ::: "memory");
        }
    }
}
__device__ __forceinline__ void ph_moba_own(Frame& F) {
    const int tid = tid_now(), lane = tid & 63, wave = __builtin_amdgcn_readfirstlane(tid >> 6); (void)lane; (void)wave;
    unsigned char* const wsl = opaque(F.ws);
    using namespace moba;
    const bf16* Pa = (const bf16*)(wsl + WS_PA); const unsigned* sel = (const unsigned*)(wsl + WS_SEL);
    const bf16* OP = (const bf16*)(wsl + WS_OP); const float* ML = (const float*)(wsl + WS_ML); bf16* Y = (bf16*)(wsl + WS_Y);
    const float* relb = F.inp(1);
    LAS unsigned char* lds = F.lds;
    const int c = lane & 31, hi = lane >> 5;
    for (int u = blockIdx.x; u < 1024; u += F.G) {
        const int bh = u >> 5, qb = u & 31, b = bh >> 3, h = bh & 7;
        __syncthreads();
        stage_kv(lds, Pa, b * SEQ + qb * 256, h, relb, tid);
        __syncthreads();
        const int s = qb * 256 + wave * 32 + c;
        const bf16* qp = Pa + (size_t)(b * SEQ + s) * NPA + h * 64 + hi * 8;
        bf16x8 qf[4];
#pragma unroll
        for (int st = 0; st < 4; ++st) qf[st] = *(const bf16x8*)(qp + st * 16);
        float m, ls; f32x16 o[2];
        int relb_own = wave * 32 + c; asm volatile("" : "+v"(relb_own));
        tile_attn<true>(lds, (LAS float*)(lds + L_WS + wave * 512), qf, c, hi, wave, relb_own, true, m, ls, o);
        asm volatile("" ::: "memory");
        const unsigned wv = sel[(size_t)bh * SEQ + s]; const int nv = (int)(wv >> 24);
        float ms[3], lsv[3]; float M = m;
#pragma unroll
        for (int j = 0; j < 3; ++j) { if (j < nv) { const float* mp = ML + ((size_t)((b * SEQ + s) * 8 + h) * 3 + j) * 2; ms[j] = mp[0]; lsv[j] = mp[1]; M = fmaxf(M, ms[j]); } else { ms[j] = -INFINITY; lsv[j] = 0.f; } }
        const float a_own = __builtin_amdgcn_exp2f(m - M); float a[3]; float Ls = a_own * ls;
#pragma unroll
        for (int j = 0; j < 3; ++j) { a[j] = (j < nv) ? __builtin_amdgcn_exp2f(ms[j] - M) : 0.f; Ls += a[j] * lsv[j]; }
        const float inv = 1.f / Ls;
        __syncthreads();
        LAS float* fsc = (LAS float*)(lds + L_WS + wave * 512);
        if (hi == 0) { *(LAS f32x4*)(fsc + c * 4) = (f32x4){a_own * inv, a[0] * inv, a[1] * inv, a[2] * inv}; }
        LAS float* of = (LAS float*)(lds + wave * (32 * OFP * 4));
#pragma unroll
        for (int dc = 0; dc < 2; ++dc)
#pragma unroll
            for (int r = 0; r < 16; ++r) of[crow(r, hi) * OFP + 32 * dc + c] = o[dc][r];
        asm volatile("s_waitcnt lgkmcnt(0)" ::: "memory");
#pragma unroll
        for (int it = 0; it < 4; ++it) {
            const int q = it * 8 + (lane >> 3), ch = lane & 7, sq = qb * 256 + wave * 32 + q;
            const f32x4 f = *(const LAS f32x4*)(fsc + q * 4);
            const f32x4 o0 = *(const LAS f32x4*)(of + q * OFP + ch * 8), o1 = *(const LAS f32x4*)(of + q * OFP + ch * 8 + 4);
            float v[8] = {o0.x * f.x, o0.y * f.x, o0.z * f.x, o0.w * f.x, o1.x * f.x, o1.y * f.x, o1.z * f.x, o1.w * f.x};
            const bf16* pp = OP + ((size_t)((b * SEQ + sq) * 8 + h) * 3) * 64 + ch * 8;
#pragma unroll
            for (int j = 0; j < 3; ++j) { const float fj = f[1 + j]; if (fj != 0.f) { float t8[8]; unpack8(*(const u32x4*)(pp + j * 64), t8);
#pragma unroll
                for (int e = 0; e < 8; ++e) v[e] += fj * t8[e]; } }
            *(u32x4*)(Y + (size_t)(b * SEQ + sq) * NYC + 512 + h * 64 + ch * 8) = pack8(v);
        }
    }
}

namespace gla {
typedef float f32x16 __attribute__((ext_vector_type(16)));
constexpr int G_ZS = 0, G_WA = 4096, G_BA = 12288, G_GS = 12800, G_QE = 16384, G_KE = 34816, G_VT = 53248, G_RED = 90112;
constexpr int PB = 144;
__device__ __forceinline__ int crow(int r, int hi) { return (r & 3) + 8 * (r >> 2) + 4 * hi; }
__device__ __forceinline__ unsigned cvtpk(float lo, float hi) { unsigned r; asm volatile("v_cvt_pk_bf16_f32 %0, %1, %2" : "=v"(r) : "v"(lo), "v"(hi)); return r; }
__device__ __forceinline__ float gates(Frame& F, LAS unsigned char* lds, const bf16* Pg, int l, int r0, int hp, int tid, float (&bc)[16]) {
    LAS float* zs = (LAS float*)(lds + G_ZS); LAS float* wa = (LAS float*)(lds + G_WA); LAS float* ba = (LAS float*)(lds + G_BA); LAS float* gs = (LAS float*)(lds + G_GS);
    const int hh = tid >> 8, jg = (tid >> 6) & 3, d = tid & 63;
    for (int i = tid; i < 1024; i += 512) { const int j = i >> 4, rr = i & 15; zs[i] = bf1(Pg[(size_t)(r0 + j) * NPG + 1536 + rr]); }
    const float* wal = F.inp(8) + (size_t)l * 16 * 256; const float* bal = F.inp(9) + l * 256;
    for (int i = tid; i < 2048; i += 512) { const int h2 = i >> 10, rr = (i >> 6) & 15, dd = i & 63; wa[i] = wal[rr * 256 + (2 * hp + h2) * 64 + dd]; }
    if (tid < 128) ba[tid] = bal[(2 * hp) * 64 + tid];
    __syncthreads();
    float run = 0.f;
#pragma unroll
    for (int jj = 0; jj < 16; ++jj) { const int j = 16 * jg + jj; float x = ba[hh * 64 + d];
#pragma unroll
        for (int rr = 0; rr < 16; ++rr) x += zs[j * 16 + rr] * wa[(hh * 16 + rr) * 64 + d];
        const float ls = fminf(x, 0.f) - __logf(1.f + __expf(-fabsf(x)));
        run += ls * (1.f / 16.f); bc[jj] = run; }
    gs[(hh * 4 + jg) * 64 + d] = run;
    __syncthreads();
    float off = 0.f, tot = 0.f;
#pragma unroll
    for (int g = 0; g < 4; ++g) { const float v = gs[(hh * 4 + g) * 64 + d]; tot += v; off += (g < jg) ? v : 0.f; }
#pragma unroll
    for (int jj = 0; jj < 16; ++jj) bc[jj] += off;
    return tot;
}
__device__ __forceinline__ void stage_vt(LAS unsigned char* lds, const bf16* Pg, int r0, int hp, int tid) {
#pragma unroll
    for (int i = 0; i < 4; ++i) { const int id = tid + 512 * i, j = id >> 5, vc = id & 31;
        const u32x4 vw = *(const u32x4*)(Pg + (size_t)(r0 + j) * NPG + 512 + hp * 256 + vc * 8);
        LAS bf16* vt = (LAS bf16*)(lds + G_VT) + (vc * 8) * (PB / 2) + j;
        vt[0 * (PB / 2)] = (bf16)(vw.x & 0xffffu); vt[1 * (PB / 2)] = (bf16)(vw.x >> 16); vt[2 * (PB / 2)] = (bf16)(vw.y & 0xffffu); vt[3 * (PB / 2)] = (bf16)(vw.y >> 16);
        vt[4 * (PB / 2)] = (bf16)(vw.z & 0xffffu); vt[5 * (PB / 2)] = (bf16)(vw.z >> 16); vt[6 * (PB / 2)] = (bf16)(vw.w & 0xffffu); vt[7 * (PB / 2)] = (bf16)(vw.w >> 16); }
}
}

__device__ __forceinline__ void ph_gla_kv(Frame& F, int l) {
    const int tid = tid_now(), lane = tid & 63, wave = __builtin_amdgcn_readfirstlane(tid >> 6); (void)lane; (void)wave;
    unsigned char* const wsl = opaque(F.ws);
    using namespace gla;
    const bf16* Pg = (const bf16*)(wsl + WS_PG); bf16* GK = (bf16*)(wsl + WS_GLA); float* DEC = (float*)(wsl + WS_DEC);
    LAS unsigned char* lds = F.lds;
    const int c = lane & 31, hi = lane >> 5;
    for (int unit = blockIdx.x; unit < 1024; unit += F.G) {
        const int hp = unit & 1, cg = unit >> 1, b = cg >> 7, ch = cg & 127, r0 = b * SEQ + ch * 64;
        __syncthreads();
        float bc[16];
        const float bt = gates(F, lds, Pg, l, r0, hp, tid, bc);
        const int hh = tid >> 8, jg = (tid >> 6) & 3, d = tid & 63;
        { float kd[16];
#pragma unroll
          for (int jj = 0; jj < 16; ++jj) kd[jj] = bf1(Pg[(size_t)(r0 + 16 * jg + jj) * NPG + 256 + (2 * hp + hh) * 64 + d]) * __expf(bt - bc[jj]);
          LAS unsigned char* dst = lds + G_QE + (hh * 64 + d) * PB + jg * 32;
          u32x4 w0, w1; w0.x = pk2(kd[0], kd[1]); w0.y = pk2(kd[2], kd[3]); w0.z = pk2(kd[4], kd[5]); w0.w = pk2(kd[6], kd[7]);
          w1.x = pk2(kd[8], kd[9]); w1.y = pk2(kd[10], kd[11]); w1.z = pk2(kd[12], kd[13]); w1.w = pk2(kd[14], kd[15]);
          *(LAS u32x4*)dst = w0; *(LAS u32x4*)(dst + 16) = w1; }
        if (jg == 0) DEC[((size_t)((b * 4 + 2 * hp + hh) * 128 + ch)) * 64 + d] = __expf(bt);
        stage_vt(lds, Pg, r0, hp, tid);
        __syncthreads();
        { const int h2 = wave >> 2, vt = wave & 3;
          f32x16 acc[2];
#pragma unroll
          for (int dt = 0; dt < 2; ++dt)
#pragma unroll
              for (int r = 0; r < 16; ++r) acc[dt][r] = 0.f;
#pragma unroll
          for (int ks = 0; ks < 4; ++ks) {
              const bf16x8 af = *(const LAS bf16x8*)(lds + G_VT + (h2 * 128 + 32 * vt + c) * PB + ks * 32 + hi * 16);
#pragma unroll
              for (int dt = 0; dt < 2; ++dt) { const bf16x8 bfv = *(const LAS bf16x8*)(lds + G_QE + (h2 * 64 + 32 * dt + c) * PB + ks * 32 + hi * 16);
                  acc[dt] = __builtin_amdgcn_mfma_f32_32x32x16_bf16(af, bfv, acc[dt], 0, 0, 0); } }
          bf16* o = GK + ((size_t)((b * 4 + 2 * hp + h2) * 128 + ch)) * 8192;
#pragma unroll
          for (int dt = 0; dt < 2; ++dt)
#pragma unroll
              for (int r = 0; r < 16; ++r) o[(32 * vt + crow(r, hi)) * 64 + 32 * dt + c] = (bf16)f2bf(acc[dt][r]); }
    }
}
__device__ __forceinline__ void ph_gla_out(Frame& F, int l) {
    const int tid = tid_now(), lane = tid & 63, wave = __builtin_amdgcn_readfirstlane(tid >> 6); (void)lane; (void)wave;
    unsigned char* const wsl = opaque(F.ws);
    using namespace gla;
    const bf16* Pg = (const bf16*)(wsl + WS_PG); const bf16* GK = (const bf16*)(wsl + WS_GLA); bf16* Y = (bf16*)(wsl + WS_Y);
    LAS unsigned char* lds = F.lds;
    const int c = lane & 31, hi = lane >> 5;
    const float* gnp = F.inp(10) + l * 128;
    for (int unit = blockIdx.x; unit < 1024; unit += F.G) {
        const int hp = unit & 1, cg = unit >> 1, b = cg >> 7, ch = cg & 127, r0 = b * SEQ + ch * 64;
        __syncthreads();
        float bc[16];
        (void)gates(F, lds, Pg, l, r0, hp, tid, bc);
        { const int hh = tid >> 8, jg = (tid >> 6) & 3, d = tid & 63;
#pragma unroll
          for (int jj = 0; jj < 16; ++jj) { const int j = 16 * jg + jj; const bf16* p = Pg + (size_t)(r0 + j) * NPG + (2 * hp + hh) * 64 + d;
              ((LAS bf16*)(lds + G_QE))[(hh * 64 + j) * (PB / 2) + d] = (bf16)f2bf(bf1(p[0]) * 0.125f * __expf(bc[jj]));
              ((LAS bf16*)(lds + G_KE))[(hh * 64 + j) * (PB / 2) + d] = (bf16)f2bf(bf1(p[256]) * __expf(-bc[jj])); } }
        stage_vt(lds, Pg, r0, hp, tid);
        __syncthreads();
        const int h2 = wave >> 2, it = (wave >> 1) & 1, vh = wave & 1, h = 2 * hp + h2;
        f32x16 X[2];
#pragma unroll
        for (int jt = 0; jt < 2; ++jt) {
#pragma unroll
            for (int r = 0; r < 16; ++r) X[jt][r] = 0.f;
            if (jt <= it) {
#pragma unroll
                for (int ks = 0; ks < 4; ++ks) {
                    const bf16x8 af = *(const LAS bf16x8*)(lds + G_KE + (h2 * 64 + 32 * jt + c) * PB + ks * 32 + hi * 16);
                    const bf16x8 bfv = *(const LAS bf16x8*)(lds + G_QE + (h2 * 64 + 32 * it + c) * PB + ks * 32 + hi * 16);
                    X[jt] = __builtin_amdgcn_mfma_f32_32x32x16_bf16(af, bfv, X[jt], 0, 0, 0); }
                if (jt == it) {
#pragma unroll
                    for (int r = 0; r < 16; ++r) X[jt][r] = (crow(r, hi) > c) ? 0.f : X[jt][r]; }
            }
        }
        f32x16 acc[2];
        const bf16* sp = GK + ((size_t)((b * 4 + h) * 128 + ch)) * 8192;
#pragma unroll
        for (int v2 = 0; v2 < 2; ++v2) {
            const int vrow = h2 * 128 + 32 * (2 * vh + v2) + c;
#pragma unroll
            for (int r = 0; r < 16; ++r) acc[v2][r] = 0.f;
#pragma unroll
            for (int ks = 0; ks < 4; ++ks) {
                const bf16x8 af = *(const bf16x8*)(sp + (size_t)(32 * (2 * vh + v2) + c) * 64 + ks * 16 + hi * 8);
                const bf16x8 bfv = *(const LAS bf16x8*)(lds + G_QE + (h2 * 64 + 32 * it + c) * PB + ks * 32 + hi * 16);
                acc[v2] = __builtin_amdgcn_mfma_f32_32x32x16_bf16(af, bfv, acc[v2], 0, 0, 0); }
#pragma unroll
            for (int jt = 0; jt < 2; ++jt) if (jt <= it) {
#pragma unroll
                for (int s2 = 0; s2 < 2; ++s2) {
                    u32x4 xw; xw.x = cvtpk(X[jt][8 * s2 + 0], X[jt][8 * s2 + 1]); xw.y = cvtpk(X[jt][8 * s2 + 2], X[jt][8 * s2 + 3]); xw.z = cvtpk(X[jt][8 * s2 + 4], X[jt][8 * s2 + 5]); xw.w = cvtpk(X[jt][8 * s2 + 6], X[jt][8 * s2 + 7]);
                    const LAS unsigned char* vp = lds + G_VT + vrow * PB + (32 * jt + 16 * s2 + 4 * hi) * 2;
                    const u32x2 a0 = *(const LAS u32x2*)vp, a1 = *(const LAS u32x2*)(vp + 16);
                    u32x4 aw; aw.x = a0.x; aw.y = a0.y; aw.z = a1.x; aw.w = a1.y;
                    acc[v2] = __builtin_amdgcn_mfma_f32_32x32x16_bf16(__builtin_bit_cast(bf16x8, aw), __builtin_bit_cast(bf16x8, xw), acc[v2], 0, 0, 0); } }
        }
        float ss = 0.f;
#pragma unroll
        for (int v2 = 0; v2 < 2; ++v2)
#pragma unroll
            for (int r = 0; r < 16; ++r) ss += acc[v2][r] * acc[v2][r];
        ss += __shfl_xor(ss, 32);
        LAS float* red = (LAS float*)(lds + G_RED);
        if (hi == 0) red[wave * 32 + c] = ss;
        __syncthreads();
        const float rs = rsqrtf((ss + red[(wave ^ 1) * 32 + c]) * (1.f / 128.f) + RMS_EPS);
        const size_t row = (size_t)(r0 + 32 * it + c);
#pragma unroll
        for (int v2 = 0; v2 < 2; ++v2)
#pragma unroll
            for (int g = 0; g < 4; ++g) { const int v0 = 32 * (2 * vh + v2) + 8 * g + 4 * hi;
                const u32x2 rw = *(const u32x2*)(Pg + row * NPG + 1024 + h * 128 + v0);
                const f32x4 gn = *(const f32x4*)(gnp + v0);
                const float r0f = bflo(rw.x), r1f = bfhi(rw.x), r2f = bflo(rw.y), r3f = bfhi(rw.y);
                u32x2 ow; ow.x = pk2(acc[v2][4 * g + 0] * rs * gn.x * (r0f * sigmoidf_(r0f)), acc[v2][4 * g + 1] * rs * gn.y * (r1f * sigmoidf_(r1f)));
                ow.y = pk2(acc[v2][4 * g + 2] * rs * gn.z * (r2f * sigmoidf_(r2f)), acc[v2][4 * g + 3] * rs * gn.w * (r3f * sigmoidf_(r3f)));
                *(u32x2*)(Y + row * NYC + 1024 + h * 128 + v0) = ow; }
    }
}
__device__ __forceinline__ void ph_norm_router(Frame& F, int l) {
    const int tid = tid_now(), lane = tid & 63, wave = __builtin_amdgcn_readfirstlane(tid >> 6); (void)lane; (void)wave;
    unsigned char* const wsl = opaque(F.ws);
    const int gw = blockIdx.x * 8 + wave, NGW = F.G * 8;
    const float* gain = F.inp(14) + (size_t)l * 1024; bf16* H = (bf16*)(wsl + WS_H);
    const float* wrg = F.inp(15) + (size_t)l * 1024 * 4; const float* brg = F.inp(16) + l * 4;
    const float* wre = F.inp(17) + (size_t)l * 1024 * 32; const float* bre = F.inp(18) + l * 32;
    int* toke = (int*)(wsl + WS_TOKE); float* tokw = (float*)(wsl + WS_TOKW);
    LAS unsigned* hist = (LAS unsigned*)(F.lds + LTAB_OFF);
    if (tid < 32) hist[tid] = 0u;
    __syncthreads();
    f32x4 g[4];
#pragma unroll
    for (int j = 0; j < 4; ++j) g[j] = *((const f32x4*)gain + 64 * j + lane);
    for (int m = gw; m < T_; m += NGW) {
        const f32x4* xr = (const f32x4*)(F.out + (size_t)m * 1024) + lane;
        f32x4 v[4]; float ss = 0.f;
#pragma unroll
        for (int j = 0; j < 4; ++j) { v[j] = xr[64 * j]; ss += (v[j].x * v[j].x + v[j].y * v[j].y) + (v[j].z * v[j].z + v[j].w * v[j].w); }
        const float rs = rsqrtf(wave_sum(ss) * (1.f / 1024.f) + RMS_EPS);
        u32x2* o8 = (u32x2*)(H + (size_t)m * 1024) + lane;
#pragma unroll
        for (int j = 0; j < 4; ++j) { v[j] = v[j] * rs * g[j]; u32x2 w; w.x = pk2(v[j].x, v[j].y); w.y = pk2(v[j].z, v[j].w); o8[64 * j] = w; }
        float lg[4] = {0.f, 0.f, 0.f, 0.f};
#pragma unroll
        for (int j = 0; j < 4; ++j)
#pragma unroll
            for (int e = 0; e < 4; ++e) { const int k = 4 * (64 * j + lane) + e; const f32x4 w = *(const f32x4*)(wrg + (size_t)k * 4); const float hv = v[j][e];
                lg[0] += hv * w.x; lg[1] += hv * w.y; lg[2] += hv * w.z; lg[3] += hv * w.w; }
#pragma unroll
        for (int i = 0; i < 4; ++i) lg[i] = wave_sum(lg[i]) + brg[i];
        int grp = 0; float gm = lg[0];
#pragma unroll
        for (int i = 1; i < 4; ++i) if (lg[i] > gm) { gm = lg[i]; grp = i; }
        float gs = 0.f;
#pragma unroll
        for (int i = 0; i < 4; ++i) gs += __expf(lg[i] - gm);
        const float pgt = 1.f / gs;
        float le[8];
#pragma unroll
        for (int i = 0; i < 8; ++i) le[i] = 0.f;
#pragma unroll
        for (int j = 0; j < 4; ++j)
#pragma unroll
            for (int e = 0; e < 4; ++e) { const int k = 4 * (64 * j + lane) + e; const float* wp = wre + (size_t)k * 32 + grp * 8; const f32x4 w0 = *(const f32x4*)wp, w1 = *(const f32x4*)(wp + 4); const float hv = v[j][e];
                le[0] += hv * w0.x; le[1] += hv * w0.y; le[2] += hv * w0.z; le[3] += hv * w0.w; le[4] += hv * w1.x; le[5] += hv * w1.y; le[6] += hv * w1.z; le[7] += hv * w1.w; }
#pragma unroll
        for (int i = 0; i < 8; ++i) le[i] = wave_sum(le[i]) + bre[grp * 8 + i];
        int e0 = 0; float m0 = le[0];
#pragma unroll
        for (int i = 1; i < 8; ++i) if (le[i] > m0) { m0 = le[i]; e0 = i; }
        int e1 = -1; float m1 = -INFINITY;
#pragma unroll
        for (int i = 0; i < 8; ++i) if (i != e0 && le[i] > m1) { m1 = le[i]; e1 = i; }
        const float t = __expf(m1 - m0), w0 = pgt / (1.f + t), w1 = pgt * t / (1.f + t);
        if (lane == 0) { toke[2 * m] = grp * 8 + e0; toke[2 * m + 1] = grp * 8 + e1; tokw[2 * m] = w0; tokw[2 * m + 1] = w1;
            (void)__hip_atomic_fetch_add(&hist[grp * 8 + e0], 1u, __ATOMIC_RELAXED, __HIP_MEMORY_SCOPE_WORKGROUP); (void)__hip_atomic_fetch_add(&hist[grp * 8 + e1], 1u, __ATOMIC_RELAXED, __HIP_MEMORY_SCOPE_WORKGROUP); }
    }
    __syncthreads();
    if (tid < 32 && hist[tid]) (void)__hip_atomic_fetch_add(F.ctl + CW_CNT + l * 64 + tid, hist[tid], RLX_AGENT);
    __syncthreads();
}
__device__ __forceinline__ void ph_dispatch(Frame& F, int l) {
    const int tid = tid_now(), lane = tid & 63, wave = __builtin_amdgcn_readfirstlane(tid >> 6); (void)lane; (void)wave;
    unsigned char* const wsl = opaque(F.ws);
    LAS int* pstart = (LAS int*)(F.lds + LTAB_OFF); LAS int* cnt = pstart + 32; LAS unsigned* lhist = (LAS unsigned*)(cnt + 32); LAS int* lbase = (LAS int*)(lhist + 32);
    LAS int* rowof = lbase + 32;
        const int* toke = (const int*)(wsl + WS_TOKE); const float* tokw = (const float*)(wsl + WS_TOKW);
    int* toks = (int*)(wsl + WS_TOKS); float* roww = (float*)(wsl + WS_ROWW); int* blke = (int*)(wsl + WS_BLKE);
    const bf16* H = (const bf16*)(wsl + WS_H); bf16* xs = (bf16*)(wsl + WS_XS);
    if (tid < 32) { cnt[tid] = (int)__hip_atomic_load(F.ctl + CW_CNT + l * 64 + tid, RLX_AGENT); lhist[tid] = 0u; }
    __syncthreads();
    if (tid == 0) { int a = 0; for (int e = 0; e < 32; ++e) { pstart[e] = a; a += ((cnt[e] + 255) >> 8) << 8; } pstart[32 + 32 + 32 + 32 + 256] = a; }
    __syncthreads();
    const int total = pstart[32 + 32 + 32 + 32 + 256];
    if (blockIdx.x == 0) {
        for (int rb = tid; rb < 288; rb += 512) { int e = 31; for (int k = 31; k >= 0; --k) if (rb * 256 < pstart[k] + (((cnt[k] + 255) >> 8) << 8)) e = k; blke[rb] = e; }
        if (tid == 0) blke[300] = total >> 8;
    }
    for (int e = blockIdx.x; e < 32; e += F.G) {
        const int p0 = pstart[e] + cnt[e], p1 = pstart[e] + (((cnt[e] + 255) >> 8) << 8);
        for (int i = tid; i < (p1 - p0) * 128; i += 512) { const int rr = p0 + (i >> 7); *((u32x4*)(xs + (size_t)rr * 1024) + (i & 127)) = (u32x4){0u, 0u, 0u, 0u}; }
        for (int rr = p0 + tid; rr < p1; rr += 512) roww[rr] = 0.f;
    }
    const int tpw = T_ / F.G, t0 = blockIdx.x * tpw;
    int myexp = -1, myrank = 0;
    if (tid < 2 * tpw) { myexp = toke[2 * t0 + tid]; myrank = (int)__hip_atomic_fetch_add(&lhist[myexp], 1u, __ATOMIC_RELAXED, __HIP_MEMORY_SCOPE_WORKGROUP); }
    __syncthreads();
    if (tid < 32) lbase[tid] = lhist[tid] ? (int)__hip_atomic_fetch_add(F.ctl + CW_CUR + l * 64 + tid, lhist[tid], RLX_AGENT) : 0;
    __syncthreads();
    if (tid < 2 * tpw) { const int row = pstart[myexp] + lbase[myexp] + myrank; rowof[tid] = row; toks[2 * t0 + tid] = row; roww[row] = tokw[2 * t0 + tid]; }
    __syncthreads();
    for (int a = wave; a < 2 * tpw; a += 8) { const int row = rowof[a], t = t0 + (a >> 1);
        const u32x4* src = (const u32x4*)(H + (size_t)t * 1024) + lane; u32x4* dst = (u32x4*)(xs + (size_t)row * 1024) + lane;
        dst[0] = src[0]; dst[64] = src[64]; }
    __syncthreads();
}

struct Args { const float* in[22]; float* out; unsigned char* ws; int ph_lo, ph_hi; };
constexpr int NPH = 13;

__global__ void __launch_bounds__(512, 2) fwd_kernel(Args args) {
    extern __shared__ __attribute__((aligned(16))) unsigned char lds_raw[];
    Frame F;
    F.lds = (LAS unsigned char*)lds_raw;
    F.MISC = (volatile LAS unsigned*)(F.lds + MISC_OFF);
    F.tid = threadIdx.x; F.lane = F.tid & 63; F.wave = __builtin_amdgcn_readfirstlane(F.tid >> 6); F.G = gridDim.x;
    F.out = args.out; F.ws = args.ws; F.ctl = (unsigned*)(args.ws + WS_CTL);
    for (int u = F.tid; u < (LDS_BYTES - LDSCTL_OFF) / 4; u += 512) ((LAS unsigned*)(F.lds + LDSCTL_OFF))[u] = 0u;
    __syncthreads();
    if (F.tid < 22) ((LAS unsigned long long*)(F.lds + PTAB_OFF))[F.tid] = (unsigned long long)args.in[F.tid];
    __syncthreads();
    const int lo = args.ph_lo, hi = args.ph_hi;
    const bool use_bar = (hi - lo) > 1;
    XcdBarrier bar; bar.bar = F.ctl + CW_BAR; bar.x = 0; bar.st = nullptr;
    if (use_bar) bar = xcd_barrier_post(F.ctl + CW_BAR, F.MISC + 8);
#define IN(k) (lo <= (k) && (k) < hi)
#define SEAM(k) do { if (IN(k) && IN((k) + 1)) xcd_barrier(bar); } while (0)
    for (int l = 0; l < DEPTH; ++l) {
        const int pb = l * NPH;
#define WSL unsigned char* const ws = opaque(F.ws); unsigned char* const wmix = ws + WS_WMIX + (size_t)l * WMIX_LAYER; (void)wmix
        if (IN(pb + 0)) { WSL;
            if (l == 0) { PM(0) ph_convert_mixer(F); __syncthreads(); PM(11) ph_norm<false, true>(F, F.inp(0), F.inp(2), (bf16*)(ws + WS_H)); }
            else PM(12) ph_norm<true, true>(F, F.out, F.inp(2) + 1024, (bf16*)(ws + WS_H));
        }
        SEAM(pb + 0);
        if (IN(pb + 1)) { WSL;
            pg8::SchedPlain S{(const char*)(ws + WS_H), (const char*)(wmix + WO_WIN), 128, 19, F.G, (int)blockIdx.x, (size_t)256 * 1024 * 2, (size_t)256 * 1024 * 2};
            pg8::EpiInProj E{(bf16*)(ws + WS_PC), (bf16*)(ws + WS_PA), (bf16*)(ws + WS_PG)};
            PM(16) pg8::gemm_phase(F.lds, 1024, 1024, S, E);
        }
        SEAM(pb + 1);
        if (IN(pb + 2)) { PM(1) ph_conv(F, l); PM(2) ph_qknorm(F, l); __syncthreads(); PM(3) ph_gla_kv(F, l); }
        SEAM(pb + 2);
        if (IN(pb + 3)) { PM(4) ph_moba_gate(F); PM(5) ph_gla_scan(F); }
        SEAM(pb + 3);
        if (IN(pb + 4)) {
#if defined(MOBA_NAIVE)
            { LAS float* bias2 = (LAS float*)(F.lds + LTAB_OFF); LAS int* bucket = (LAS int*)(F.lds + LTAB_OFF + 1024);
              if (F.tid < 256) { const int bk = F.tid >> 3, hh = F.tid & 7; bias2[hh * 32 + bk] = F.inp(1)[bk * 8 + hh] * LOG2E;
                  const int n = F.tid; int bq; if (n < 16) bq = n; else { const float sc = logf((float)n / 16.0f) / 2.0794415416798357f; bq = 16 + (int)(sc * 16.0f); if (bq > 31) bq = 31; }
                  bucket[n] = bq; }
              __syncthreads(); }
            PM(6) ph_moba_attn(F); __syncthreads(); PM(7) ph_gla_out(F, l);
#else
            PM(7) ph_gla_out(F, l); __syncthreads(); PM(6) ph_moba_routed(F, l);
#endif
        }
        SEAM(pb + 4);
        if (IN(pb + 12)) {
#if !defined(MOBA_NAIVE)
            PM(14) ph_moba_own(F);
#endif
        }
        SEAM(pb + 12);
        if (IN(pb + 5)) { WSL;
            pg8::SchedBranch S{(const char*)(ws + WS_Y), (const char*)(wmix + WO_WB), F.G, (int)blockIdx.x};
            pg8::EpiBranch E{(bf16*)(ws + WS_BB)};
            PM(17) pg8::gemm_phase(F.lds, 512, NYC, S, E);
        }
        SEAM(pb + 5);
        if (IN(pb + 6)) { WSL;
            pg8::SchedGate S{(const char*)(ws + WS_H), (const char*)(wmix + WO_WG), F.G, (int)blockIdx.x};
            pg8::EpiGateMerge E{(const bf16*)(ws + WS_BB), (bf16*)(ws + WS_MRG)};
            PM(18) pg8::gemm_phase(F.lds, 1024, 1024, S, E);
        }
        SEAM(pb + 6);
        if (IN(pb + 7)) { WSL;
            pg8::SchedPlain S{(const char*)(ws + WS_MRG), (const char*)(wmix + WO_WO), 128, 4, F.G, (int)blockIdx.x, (size_t)256 * 1024 * 2, (size_t)256 * 1024 * 2};
            pg8::EpiOut E{l == 0 ? F.inp(0) : (const float*)F.out, F.out};
            PM(19) pg8::gemm_phase(F.lds, 1024, 1024, S, E);
        }
        SEAM(pb + 7);
        if (IN(pb + 8)) { PM(8) ph_norm_router(F, l); PM(9) ph_convert_experts(F, l); }
        SEAM(pb + 8);
        if (IN(pb + 9)) PM(10) ph_dispatch(F, l);
        SEAM(pb + 9);
        if (IN(pb + 10) || IN(pb + 11)) { WSL;
            LAS int* tab = (LAS int*)(F.lds + LTAB_OFF + 2048);
            const int* blke = (const int*)(ws + WS_BLKE);
            for (int i = F.tid; i < 304; i += 512) tab[i] = blke[i];
            __syncthreads();
            const int nblk = tab[300];
            if (IN(pb + 10)) {
                pg8::SchedMoe S{(const char*)(ws + WS_XS), (const char*)(ws + WS_W1T), tab, nblk * 4, F.G, (int)blockIdx.x, (size_t)256 * 1024 * 2, (size_t)1024 * 1024 * 2, (size_t)256 * 1024 * 2};
                pg8::EpiSwiGLU E{(bf16*)(ws + WS_ACT)};
                PM(20) pg8::gemm_phase(F.lds, 1024, 1024, S, E);
            }
            SEAM(pb + 10);
            if (IN(pb + 11)) {
                pg8::SchedMoe S{(const char*)(ws + WS_ACT), (const char*)(ws + WS_WDT), tab, nblk * 4, F.G, (int)blockIdx.x, (size_t)256 * 512 * 2, (size_t)1024 * 512 * 2, (size_t)256 * 512 * 2};
                pg8::EpiMoeDown E{(bf16*)(ws + WS_YS), (const float*)(ws + WS_ROWW)};
                PM(21) pg8::gemm_phase(F.lds, 512, 512, S, E);
            }
        }
        SEAM(pb + 11);
    }
    if (IN(2 * NPH)) PM(13) ph_norm<true, false>(F, F.out, nullptr, nullptr);
#undef IN
#undef SEAM
#undef WSL
}

extern "C" void kernel_launch(void* const* d_in, const int* in_sizes, int n_in, void* d_out, int out_size, void* d_ws, size_t ws_size, hipStream_t stream) {
    static int grid = 0;
    if (grid == 0) {
        if (n_in != 22 || out_size != T_ * DM || ws_size < WS_END) { fprintf(stderr, "kernel_launch: unexpected shapes (n_in %d out %d ws %zu)\n", n_in, out_size, ws_size); grid = -1; return; }
        if (hipFuncSetAttribute((const void*)fwd_kernel, hipFuncAttributeMaxDynamicSharedMemorySize, LDS_BYTES) != hipSuccess) { fprintf(stderr, "kernel_launch: hipFuncSetAttribute failed\n"); grid = -1; return; }
        int dev = 0, cus = 0, per_cu = 0;
        hipGetDevice(&dev); hipDeviceGetAttribute(&cus, hipDeviceAttributeMultiprocessorCount, dev);
        if (hipOccupancyMaxActiveBlocksPerMultiprocessor(&per_cu, (const void*)fwd_kernel, 512, LDS_BYTES) != hipSuccess || per_cu < 1) fprintf(stderr, "kernel_launch: occupancy query reports %d\n", per_cu);
        (void)hipGetLastError();
        grid = cus > 256 ? 256 : cus;
    }
    if (grid < 0) return;
    (void)hipMemsetAsync((char*)d_ws + WS_CTL, 0, CTL_ZERO_BYTES, stream);
    Args a{};
    for (int i = 0; i < 22; ++i) a.in[i] = (const float*)d_in[i];
    a.out = (float*)d_out; a.ws = (unsigned char*)d_ws; a.ph_lo = 0; a.ph_hi = 2 * NPH + 1;
    hipLaunchKernelGGL(fwd_kernel, dim3(grid), dim3(512), LDS_BYTES, stream, a);
}
```

```cpp
#include <hip/hip_runtime.h>
#include <cstdio>
#include <cstdint>

#define LAS __attribute__((address_space(3)))
#ifndef PHASE_MASK
#define PHASE_MASK 0xffffffffu
#endif
#define PM(k) if ((PHASE_MASK >> (k)) & 1u)
#ifndef REP_MASK
#define REP_MASK 0u
#endif
#define PROBE_A (-1)
#define PROBE_B (-1)
#define PROBE_QA 5
#define PROBE_QB 5
#define PROBE_KA 0
#define PROBE_KB 0
#define PROBE_BLK 0
#define PROBE_ON (PROBE_A >= 0 || PROBE_B >= 0)
#define SP_T0() unsigned long long sp_t_ = PROBE_ON ? __builtin_amdgcn_s_memrealtime() : 0ull
#define SP_ADD(i) do { if (PROBE_ON && blockIdx.x == PROBE_BLK && tid == 0) { const unsigned long long n_ = __builtin_amdgcn_s_memrealtime(); ((LAS unsigned long long*)(F.lds + LTAB_OFF + 4096 + 512))[i] += n_ - sp_t_; sp_t_ = n_; } else if (PROBE_ON) sp_t_ = __builtin_amdgcn_s_memrealtime(); } while (0)
#define RUN(k, ...) do { if ((PHASE_MASK >> (k)) & 1u) { __VA_ARGS__; if ((REP_MASK >> (k)) & 1u) { __syncthreads(); __VA_ARGS__; } } } while (0)
#define GAS __attribute__((address_space(1)))
typedef unsigned short bf16;
typedef short bf16x8 __attribute__((ext_vector_type(8)));
typedef float f32x4 __attribute__((ext_vector_type(4)));
typedef float f32x2 __attribute__((ext_vector_type(2)));
typedef unsigned u32x4 __attribute__((ext_vector_type(4)));
typedef unsigned u32x2 __attribute__((ext_vector_type(2)));
typedef GAS unsigned gu32;

constexpr int T_ = 32768, SEQ = 8192, DM = 1024, DEPTH = 2;
constexpr int NPC = 1536, NPA = 1536, NPG = 1792, NIN = 4864;
constexpr int NYC = 1536;
constexpr int MAXROWS = 73728;
constexpr float RMS_EPS = 1e-6f;
constexpr float LOG2E = 1.4426950408889634f;
constexpr float QSCALE = 0.125f * LOG2E;

constexpr size_t MiB = 1u << 20;
constexpr size_t WS_CTL = 0, CTL_ZERO_BYTES = 1 * MiB;
constexpr size_t WS_MISC = 1 * MiB;
constexpr size_t WS_KMEAN = WS_MISC;
constexpr size_t WS_SEL = WS_MISC + 256 * 1024;
constexpr size_t WS_DEC = WS_SEL + 1 * MiB;
constexpr size_t WS_TOKE = WS_DEC + 512 * 1024;
constexpr size_t WS_TOKW = WS_TOKE + 256 * 1024;
constexpr size_t WS_TOKS = WS_TOKW + 256 * 1024;
constexpr size_t WS_ROWW = WS_TOKS + 256 * 1024;
constexpr size_t WS_BLKE = WS_ROWW + 288 * 1024;
constexpr size_t WS_TOKRS = 4 * MiB;
constexpr size_t WS_KM2 = 4 * MiB + 512 * 1024;
constexpr size_t WS_HIST = 4 * MiB + 256 * 1024;
constexpr size_t WS_WR = 5 * MiB;
constexpr size_t WS_ROWTOK = 5 * MiB + 512 * 1024;
constexpr size_t WS_ZB = 6 * MiB;
constexpr size_t WS_WMIX = 8 * MiB;
constexpr size_t WMIX_LAYER = 22 * MiB;
constexpr size_t WO_WIN = 0, WO_WG = (size_t)NIN * 1024 * 2, WO_WB = WO_WG + (size_t)3072 * 1024 * 2, WO_WO = WO_WB + (size_t)3 * 1024 * 512 * 2;
constexpr size_t WS_H = 52 * MiB;
constexpr size_t WS_PC = 116 * MiB;
constexpr size_t WS_PA = 212 * MiB;
constexpr size_t WS_PG = 308 * MiB;
constexpr size_t WS_Y = 420 * MiB;
constexpr size_t WS_GLA = 516 * MiB;
constexpr size_t WS_ML = 548 * MiB;
constexpr size_t WS_END = 556 * MiB;
constexpr size_t WS_OP = WS_PC;
constexpr size_t WS_BB = WS_PC;
constexpr size_t WS_MRG = WS_PG;
constexpr size_t WS_W1T = WS_Y;
constexpr size_t WS_WDT = WS_Y + 64 * MiB;
constexpr size_t WS_XS = WS_PC;
constexpr size_t WS_ACT = WS_PG;
constexpr size_t WS_YS = WS_PC;
static_assert(WMIX_LAYER >= WO_WO + (size_t)1024 * 1024 * 2, "mixer weights fit");
static_assert(WS_WMIX + 2 * WMIX_LAYER <= WS_H && WS_BLKE + 2048 <= WS_WMIX, "map");
static_assert((size_t)MAXROWS * 1024 * 2 <= WS_PG - WS_PC && (size_t)MAXROWS * 512 * 2 <= WS_Y - WS_PG, "moe aliases fit");

constexpr int CW_BAR = 4096;
constexpr int CW_CNT = 16384;
constexpr int CW_CUR = 16384 + 256;
constexpr int CW_Q = 16384 + 512;
constexpr int CW_ARR = 32768;

constexpr int RING_BYTES = 131072;
constexpr int LDSCTL_OFF = RING_BYTES;
constexpr int MISC_OFF = LDSCTL_OFF + 320;
constexpr int PTAB_OFF = LDSCTL_OFF + 512;
constexpr int LTAB_OFF = LDSCTL_OFF + 1024;
constexpr int LDS_BYTES = 147456;
constexpr int LDS_BASE = 16;

#define RLX_AGENT __ATOMIC_RELAXED, __HIP_MEMORY_SCOPE_AGENT
__device__ __forceinline__ float bflo(unsigned w) { return __uint_as_float(w << 16); }
__device__ __forceinline__ float bfhi(unsigned w) { return __uint_as_float(w & 0xffff0000u); }
__device__ __forceinline__ float bf1(bf16 b) { return __uint_as_float((unsigned)b << 16); }
__device__ __forceinline__ unsigned f2bf(float f) { unsigned u = __float_as_uint(f); return (u + 0x7fffu + ((u >> 16) & 1u)) >> 16; }
__device__ __forceinline__ unsigned pk2(float lo, float hi) { return f2bf(lo) | (f2bf(hi) << 16); }
__device__ __forceinline__ void unpack8(const u32x4 w, float (&v)[8]) {
    v[0] = bflo(w.x); v[1] = bfhi(w.x); v[2] = bflo(w.y); v[3] = bfhi(w.y); v[4] = bflo(w.z); v[5] = bfhi(w.z); v[6] = bflo(w.w); v[7] = bfhi(w.w);
}
__device__ __forceinline__ u32x4 pack8(const float (&v)[8]) { u32x4 w; w.x = pk2(v[0], v[1]); w.y = pk2(v[2], v[3]); w.z = pk2(v[4], v[5]); w.w = pk2(v[6], v[7]); return w; }
__device__ __forceinline__ float wave_sum(float v) {
#pragma unroll
    for (int o = 1; o < 64; o <<= 1) v += __shfl_xor(v, o);
    return v;
}
__device__ __forceinline__ float wave_max(float v) {
#pragma unroll
    for (int o = 1; o < 64; o <<= 1) v = fmaxf(v, __shfl_xor(v, o));
    return v;
}
__device__ __forceinline__ float sigmoidf_(float x) { return __builtin_amdgcn_rcpf(1.0f + __builtin_amdgcn_exp2f(-x * LOG2E)); }

__device__ __forceinline__ int tid_now_() { int t = threadIdx.x; asm volatile("" : "+v"(t)); return t; }
namespace pg8 {
constexpr int BM = 256, BK = 64, HALF = 128, HTB = HALF * BK * 2, STAGE_BYTES = 8 * HTB;
__host__ __device__ __forceinline__ int lds_byte(int r, int c) { const int st = (r >> 4) * 2 + (c >> 5), rr = r & 15, cc = c & 31, ob = rr * 64 + cc * 2; return st * 1024 + (ob ^ (((ob >> 9) & 1) << 5)); }
__host__ __device__ __forceinline__ void stage_rc(int b, int& R, int& C) { const int st = b / 1024, sb = b % 1024, swz = sb ^ (((sb >> 9) & 1) << 5); R = (st >> 1) * 16 + swz / 64; C = (st & 1) * 32 + (swz % 64) / 2; }
__host__ __device__ __forceinline__ int perm32(int rho) { const int n = rho >> 4, i = rho & 15; return 8 * (i >> 2) + 4 * n + (i & 3); }
struct Unit { int pm, pn, z; };
__device__ __forceinline__ void tile_map(int w, int nM, int nN, int& pm, int& pn) {
    const int nwg = nM * nN, q = nwg / 8, r = nwg % 8, xcd = w % 8, off = w / 8;
    const int wg = (xcd < r ? xcd * (q + 1) : r * (q + 1) + (xcd - r) * q) + off;
    const int nig = 8 * nN, gid = wg / nig, fm = gid * 8, gsz = (nM - fm) < 8 ? (nM - fm) : 8;
    pm = fm + ((wg % nig) % gsz); pn = (wg % nig) / gsz;
}
__device__ __forceinline__ unsigned cvt_pk_bf16(float lo, float hi) { typedef float f32x2_c __attribute__((ext_vector_type(2))); typedef __bf16 bf16x2_c __attribute__((ext_vector_type(2))); const f32x2_c v = {lo, hi}; const bf16x2_c b = __builtin_convertvector(v, bf16x2_c); return __builtin_bit_cast(unsigned, b); }

__device__ __forceinline__ unsigned xsrc_bytes(int fr, int fq) { const int lane = fq * 16 + fr; return (unsigned)(((lane & 3) * 16 + (lane >> 2)) * 4); }
__device__ __forceinline__ u32x4 to_rows(const u32x4 v, unsigned sb) { u32x4 o; o.x = (unsigned)__builtin_amdgcn_ds_bpermute((int)sb, (int)v.x); o.y = (unsigned)__builtin_amdgcn_ds_bpermute((int)sb, (int)v.y);
    o.z = (unsigned)__builtin_amdgcn_ds_bpermute((int)sb, (int)v.z); o.w = (unsigned)__builtin_amdgcn_ds_bpermute((int)sb, (int)v.w); return o; }
__device__ __forceinline__ f32x4 to_rows(const f32x4 v, unsigned sb) { return __builtin_bit_cast(f32x4, to_rows(__builtin_bit_cast(u32x4, v), sb)); }
template <class Epi, class Sched>
__device__ __forceinline__ void gemm_phase(LAS unsigned char* lds, const int K, const int lda, const Sched& S, const Epi& E) {
    const int tid = tid_now_(), wid = __builtin_amdgcn_readfirstlane(tid >> 6), lane = tid & 63, wr = wid >> 2, wc = wid & 3, fr = lane & 15, fq = lane >> 4;
    const int nt = K / BK;
    unsigned voffA[2], voffB[2];
#pragma unroll
    for (int i = 0; i < 2; ++i) { int R, C; stage_rc(tid * 16 + i * 8192, R, C); const int Rb = Epi::PERM ? ((R & ~31) + perm32(R & 31)) : R;
        voffA[i] = (unsigned)(R * lda + C) * 2u; voffB[i] = (unsigned)(Rb * K + C) * 2u; }
    const size_t kstep = (size_t)(BK * 2);
    const size_t hstepA = (size_t)HALF * lda * 2, hstepB = (size_t)HALF * K * 2;
    const unsigned ldsw = (unsigned)wid * 1024u;
    const int aoff = lds_byte(wr * 64 + fr, fq * 8), boff = lds_byte(wc * 32 + fr, fq * 8);
#define PG8_SA(b, h) (((b) * 2 + (h)) * HTB)
#define PG8_SB(b, h) ((4 + (b) * 2 + (h)) * HTB)
#define PG8_STAGE(bufoff, gbase, voff) do { _Pragma("unroll") for (int _i = 0; _i < 2; ++_i) \
        __builtin_amdgcn_global_load_lds((const unsigned*)((const char*)(gbase) + (voff)[_i]), (LAS unsigned*)(lds + (bufoff) + ldsw + _i * 8192), 16, 0, 0); } while (0)
#define PG8_LDA(dst, b, h) do { _Pragma("unroll") for (int m = 0; m < 4; ++m) _Pragma("unroll") for (int k = 0; k < 2; ++k) dst[m][k] = *(const LAS bf16x8*)(lds + PG8_SA(b, h) + aoff + m * 2048 + k * 1024); } while (0)
#define PG8_LDB(dst, b, h) do { _Pragma("unroll") for (int n = 0; n < 2; ++n) _Pragma("unroll") for (int k = 0; k < 2; ++k) dst[n][k] = *(const LAS bf16x8*)(lds + PG8_SB(b, h) + boff + n * 2048 + k * 1024); } while (0)
#define PG8_MMA(ai, bj, At, Bt) do { __builtin_amdgcn_s_setprio(1); _Pragma("unroll") for (int m = 0; m < 4; ++m) _Pragma("unroll") for (int n = 0; n < 2; ++n) _Pragma("unroll") for (int k = 0; k < 2; ++k) \
        acc[ai][bj][m][n] = __builtin_amdgcn_mfma_f32_16x16x32_bf16(Bt[n][k], At[m][k], acc[ai][bj][m][n], 0, 0, 0); __builtin_amdgcn_s_setprio(0); } while (0)
#define PG8_WAIT_V(n) asm volatile("s_waitcnt vmcnt(" #n ")" ::: "memory")
#define PG8_WAIT_L(n) asm volatile("s_waitcnt lgkmcnt(" #n ")" ::: "memory")
#define PG8_BAR __builtin_amdgcn_s_barrier()
#define PG8_SCHED __builtin_amdgcn_sched_barrier(0)
    Unit cur, nxt; int ui = 0;
    if (!S.next(0, cur)) return;
    f32x4 acc[2][2][4][2];
#pragma unroll
    for (int a = 0; a < 2; ++a)
#pragma unroll
        for (int b = 0; b < 2; ++b)
#pragma unroll
            for (int m = 0; m < 4; ++m)
#pragma unroll
                for (int n = 0; n < 2; ++n) acc[a][b][m][n] = (f32x4){0.f, 0.f, 0.f, 0.f};
    bf16x8 At[4][2], B0[2][2], B1[2][2];
    const char* cA = S.a_ptr(cur); const char* cB = S.b_ptr(cur);
    PG8_STAGE(PG8_SB(0, 0), cB, voffB); PG8_STAGE(PG8_SB(0, 1), cB + hstepB, voffB); PG8_STAGE(PG8_SA(0, 0), cA, voffA); PG8_STAGE(PG8_SA(0, 1), cA + hstepA, voffA);
    if (wr == 1) PG8_BAR;
    PG8_WAIT_V(2); PG8_BAR;
    PG8_STAGE(PG8_SB(1, 0), cB + kstep, voffB); PG8_STAGE(PG8_SA(1, 0), cA + kstep, voffA); PG8_STAGE(PG8_SB(1, 1), cB + hstepB + kstep, voffB);
    PG8_WAIT_V(6); PG8_BAR;
    for (;;) {
        const bool has_next = S.next(ui + 1, nxt);
        const char* nA = has_next ? S.a_ptr(nxt) : cA; const char* nB = has_next ? S.b_ptr(nxt) : cB;
        for (int t = 0; t < nt; t += 2) {
            const bool last = (t == nt - 2);
            const char* a1 = cA + (size_t)(t + 1) * kstep;
            const char* a2 = last ? nA : cA + (size_t)(t + 2) * kstep; const char* b2 = last ? nB : cB + (size_t)(t + 2) * kstep;
            const char* a3 = a2 + kstep; const char* b3 = b2 + kstep;
            PG8_LDB(B0, 0, 0); PG8_LDB(B1, 0, 1); PG8_SCHED; PG8_LDA(At, 0, 0); PG8_STAGE(PG8_SA(1, 1), a1 + hstepA, voffA);
            PG8_WAIT_V(8); PG8_WAIT_L(0); PG8_BAR; PG8_MMA(0, 0, At, B0); PG8_MMA(0, 1, At, B1); PG8_BAR; PG8_SCHED;
            PG8_LDA(At, 0, 1); PG8_STAGE(PG8_SB(0, 0), b2, voffB); PG8_STAGE(PG8_SB(0, 1), b2 + hstepB, voffB); PG8_STAGE(PG8_SA(0, 0), a2, voffA);
            PG8_WAIT_V(8); PG8_WAIT_L(0); PG8_BAR; PG8_MMA(1, 0, At, B0); PG8_MMA(1, 1, At, B1); PG8_BAR; PG8_SCHED;
            PG8_LDB(B0, 1, 0); PG8_LDB(B1, 1, 1); PG8_SCHED; PG8_LDA(At, 1, 0); PG8_STAGE(PG8_SA(0, 1), a2 + hstepA, voffA);
            PG8_WAIT_V(8); PG8_WAIT_L(0); PG8_BAR; PG8_MMA(0, 0, At, B0); PG8_MMA(0, 1, At, B1); PG8_BAR; PG8_SCHED;
            PG8_LDA(At, 1, 1); PG8_STAGE(PG8_SB(1, 0), b3, voffB); PG8_STAGE(PG8_SB(1, 1), b3 + hstepB, voffB); PG8_STAGE(PG8_SA(1, 0), a3, voffA);
            PG8_WAIT_V(8); PG8_WAIT_L(0); PG8_BAR; PG8_MMA(1, 0, At, B0); PG8_MMA(1, 1, At, B1); PG8_BAR; PG8_SCHED;
        }
        if (wr == 0) PG8_BAR;
        E(acc, cur, wr, wc, fr, fq);
        if (!has_next) break;
#pragma unroll
        for (int a = 0; a < 2; ++a)
#pragma unroll
            for (int b = 0; b < 2; ++b)
#pragma unroll
                for (int m = 0; m < 4; ++m)
#pragma unroll
                    for (int n = 0; n < 2; ++n) acc[a][b][m][n] = (f32x4){0.f, 0.f, 0.f, 0.f};
        cur = nxt; cA = nA; cB = nB; ++ui;
        if (wr == 1) PG8_BAR;
    }
    PG8_WAIT_V(0);
    PG8_BAR;
#undef PG8_SA
#undef PG8_SB
#undef PG8_STAGE
#undef PG8_LDA
#undef PG8_LDB
#undef PG8_MMA
#undef PG8_WAIT_V
#undef PG8_WAIT_L
#undef PG8_BAR
#undef PG8_SCHED
}

template <class Epi, class Sched>
__device__ __forceinline__ void gemm_phase_gather(LAS unsigned char* lds, const int K, const Sched& S, const Epi& E) {
    const int tid = tid_now_(), wid = __builtin_amdgcn_readfirstlane(tid >> 6), lane = tid & 63, wr = wid >> 2, wc = wid & 3, fr = lane & 15, fq = lane >> 4;
    const int nt = K / BK;
    unsigned voffA[2], voffB[2]; int rowA[2];
#pragma unroll
    for (int i = 0; i < 2; ++i) { int R, C; stage_rc(tid * 16 + i * 8192, R, C); const int Rb = Epi::PERM ? ((R & ~31) + perm32(R & 31)) : R;
        voffA[i] = (unsigned)C * 2u; voffB[i] = (unsigned)(Rb * K + C) * 2u; rowA[i] = R; }
    const size_t kstep = (size_t)(BK * 2);
    const size_t hstepB = (size_t)HALF * K * 2;
    const unsigned rowbytes = (unsigned)K * 2u;
    const unsigned ldsw = (unsigned)wid * 1024u;
    const int aoff = lds_byte(wr * 64 + fr, fq * 8), boff = lds_byte(wc * 32 + fr, fq * 8);
#define PG8_SA(b, h) (((b) * 2 + (h)) * HTB)
#define PG8_SB(b, h) ((4 + (b) * 2 + (h)) * HTB)
#define PG8_STAGE(bufoff, gbase, voff) do { _Pragma("unroll") for (int _i = 0; _i < 2; ++_i) \
        __builtin_amdgcn_global_load_lds((const unsigned*)((const char*)(gbase) + (voff)[_i]), (LAS unsigned*)(lds + (bufoff) + ldsw + _i * 8192), 16, 0, 0); } while (0)
#define PG8_LDA(dst, b, h) do { _Pragma("unroll") for (int m = 0; m < 4; ++m) _Pragma("unroll") for (int k = 0; k < 2; ++k) dst[m][k] = *(const LAS bf16x8*)(lds + PG8_SA(b, h) + aoff + m * 2048 + k * 1024); } while (0)
#define PG8_LDB(dst, b, h) do { _Pragma("unroll") for (int n = 0; n < 2; ++n) _Pragma("unroll") for (int k = 0; k < 2; ++k) dst[n][k] = *(const LAS bf16x8*)(lds + PG8_SB(b, h) + boff + n * 2048 + k * 1024); } while (0)
#define PG8_MMA(ai, bj, At, Bt) do { __builtin_amdgcn_s_setprio(1); _Pragma("unroll") for (int m = 0; m < 4; ++m) _Pragma("unroll") for (int n = 0; n < 2; ++n) _Pragma("unroll") for (int k = 0; k < 2; ++k) \
        acc[ai][bj][m][n] = __builtin_amdgcn_mfma_f32_16x16x32_bf16(Bt[n][k], At[m][k], acc[ai][bj][m][n], 0, 0, 0); __builtin_amdgcn_s_setprio(0); } while (0)
#define PG8_WAIT_V(n) asm volatile("s_waitcnt vmcnt(" #n ")" ::: "memory")
#define PG8_WAIT_L(n) asm volatile("s_waitcnt lgkmcnt(" #n ")" ::: "memory")
#define PG8_BAR __builtin_amdgcn_s_barrier()
#define PG8_SCHED __builtin_amdgcn_sched_barrier(0)
    Unit cur, nxt; int ui = 0;
    if (!S.next(0, cur)) return;
    f32x4 acc[2][2][4][2];
#pragma unroll
    for (int a = 0; a < 2; ++a)
#pragma unroll
        for (int b = 0; b < 2; ++b)
#pragma unroll
            for (int m = 0; m < 4; ++m)
#pragma unroll
                for (int n = 0; n < 2; ++n) acc[a][b][m][n] = (f32x4){0.f, 0.f, 0.f, 0.f};
    bf16x8 At[4][2], B0[2][2], B1[2][2];
    const char* const gA = S.a_base(); const char* cB = S.b_ptr(cur);
    unsigned offC[2][2], offN[2][2];
#define PG8_GOFF(dst, u) do { _Pragma("unroll") for (int _h = 0; _h < 2; ++_h) _Pragma("unroll") for (int _i = 0; _i < 2; ++_i) dst[_h][_i] = (unsigned)S.tok(u, _h * HALF + rowA[_i]) * rowbytes + voffA[_i]; } while (0)
    PG8_GOFF(offC, cur);
    PG8_STAGE(PG8_SB(0, 0), cB, voffB); PG8_STAGE(PG8_SB(0, 1), cB + hstepB, voffB); PG8_STAGE(PG8_SA(0, 0), gA, offC[0]); PG8_STAGE(PG8_SA(0, 1), gA, offC[1]);
    if (wr == 1) PG8_BAR;
    PG8_WAIT_V(2); PG8_BAR;
    PG8_STAGE(PG8_SB(1, 0), cB + kstep, voffB); PG8_STAGE(PG8_SA(1, 0), gA + kstep, offC[0]); PG8_STAGE(PG8_SB(1, 1), cB + hstepB + kstep, voffB);
    PG8_WAIT_V(6); PG8_BAR;
    for (;;) {
        const bool has_next = S.next(ui + 1, nxt);
        const char* nB = has_next ? S.b_ptr(nxt) : cB;
        if (has_next) PG8_GOFF(offN, nxt); else { _Pragma("unroll") for (int _h = 0; _h < 2; ++_h) _Pragma("unroll") for (int _i = 0; _i < 2; ++_i) offN[_h][_i] = offC[_h][_i]; }
        for (int t = 0; t < nt; t += 2) {
            const bool last = (t == nt - 2);
            const char* a1 = gA + (size_t)(t + 1) * kstep;
            const char* a2 = last ? gA : gA + (size_t)(t + 2) * kstep; const char* b2 = last ? nB : cB + (size_t)(t + 2) * kstep;
            const char* a3 = a2 + kstep; const char* b3 = b2 + kstep;
            unsigned s0[2], s1[2];
            _Pragma("unroll") for (int _i = 0; _i < 2; ++_i) { s0[_i] = last ? offN[0][_i] : offC[0][_i]; s1[_i] = last ? offN[1][_i] : offC[1][_i]; }
            PG8_LDB(B0, 0, 0); PG8_LDB(B1, 0, 1); PG8_SCHED; PG8_LDA(At, 0, 0); PG8_STAGE(PG8_SA(1, 1), a1, offC[1]);
            PG8_WAIT_V(8); PG8_WAIT_L(0); PG8_BAR; PG8_MMA(0, 0, At, B0); PG8_MMA(0, 1, At, B1); PG8_BAR; PG8_SCHED;
            PG8_LDA(At, 0, 1); PG8_STAGE(PG8_SB(0, 0), b2, voffB); PG8_STAGE(PG8_SB(0, 1), b2 + hstepB, voffB); PG8_STAGE(PG8_SA(0, 0), a2, s0);
            PG8_WAIT_V(8); PG8_WAIT_L(0); PG8_BAR; PG8_MMA(1, 0, At, B0); PG8_MMA(1, 1, At, B1); PG8_BAR; PG8_SCHED;
            PG8_LDB(B0, 1, 0); PG8_LDB(B1, 1, 1); PG8_SCHED; PG8_LDA(At, 1, 0); PG8_STAGE(PG8_SA(0, 1), a2, s1);
            PG8_WAIT_V(8); PG8_WAIT_L(0); PG8_BAR; PG8_MMA(0, 0, At, B0); PG8_MMA(0, 1, At, B1); PG8_BAR; PG8_SCHED;
            PG8_LDA(At, 1, 1); PG8_STAGE(PG8_SB(1, 0), b3, voffB); PG8_STAGE(PG8_SB(1, 1), b3 + hstepB, voffB); PG8_STAGE(PG8_SA(1, 0), a3, s0);
            PG8_WAIT_V(8); PG8_WAIT_L(0); PG8_BAR; PG8_MMA(1, 0, At, B0); PG8_MMA(1, 1, At, B1); PG8_BAR; PG8_SCHED;
        }
        if (wr == 0) PG8_BAR;
        E(acc, cur, wr, wc, fr, fq);
        if (!has_next) break;
#pragma unroll
        for (int a = 0; a < 2; ++a)
#pragma unroll
            for (int b = 0; b < 2; ++b)
#pragma unroll
                for (int m = 0; m < 4; ++m)
#pragma unroll
                    for (int n = 0; n < 2; ++n) acc[a][b][m][n] = (f32x4){0.f, 0.f, 0.f, 0.f};
        cur = nxt; cB = nB; ++ui;
        _Pragma("unroll") for (int _h = 0; _h < 2; ++_h) _Pragma("unroll") for (int _i = 0; _i < 2; ++_i) offC[_h][_i] = offN[_h][_i];
        if (wr == 1) PG8_BAR;
    }
    PG8_WAIT_V(0);
    PG8_BAR;
#undef PG8_GOFF
#undef PG8_SA
#undef PG8_SB
#undef PG8_STAGE
#undef PG8_LDA
#undef PG8_LDB
#undef PG8_MMA
#undef PG8_WAIT_V
#undef PG8_WAIT_L
#undef PG8_BAR
#undef PG8_SCHED
}

struct SchedPlain {
    const char* A; const char* Bt; int nM, nN, G, c; size_t astep, bstep;
    __device__ __forceinline__ bool next(int i, Unit& u) const { const int L = i * G + c; if (L >= nM * nN) return false; tile_map(L, nM, nN, u.pm, u.pn); u.z = 0; return true; }
    __device__ __forceinline__ const char* a_ptr(const Unit& u) const { return A + (size_t)u.pm * astep; }
    __device__ __forceinline__ const char* b_ptr(const Unit& u) const { return Bt + (size_t)u.pn * bstep; }
};
struct SchedBranch {
    const char* Y; const char* Wb; int G, c;
    __device__ __forceinline__ bool next(int i, Unit& u) const { const int L = i * G + c; if (L >= 1536) return false; u.z = L / 512; tile_map(L % 512, 128, 4, u.pm, u.pn); return true; }
    __device__ __forceinline__ const char* a_ptr(const Unit& u) const { return Y + (size_t)u.pm * (256 * NYC * 2) + (size_t)u.z * 1024; }
    __device__ __forceinline__ const char* b_ptr(const Unit& u) const { return Wb + (size_t)u.z * (1024 * 512 * 2) + (size_t)u.pn * (256 * 512 * 2); }
};
struct SchedGate {
    const char* H; const char* Wg; int G, c;
    __device__ __forceinline__ bool next(int i, Unit& u) const { const int L = (i / 3) * G + c; if (L >= 512) return false; u.z = i % 3; tile_map(L, 128, 4, u.pm, u.pn); return true; }
    __device__ __forceinline__ const char* a_ptr(const Unit& u) const { return H + (size_t)u.pm * (256 * 1024 * 2); }
    __device__ __forceinline__ const char* b_ptr(const Unit& u) const { return Wg + (size_t)(u.z * 4 + u.pn) * (256 * 1024 * 2); }
};
struct SchedMoe {
    const char* A; const char* W; const LAS int* blk_e; int nU, G, c; size_t astep, estep, bstep;
    __device__ __forceinline__ bool next(int i, Unit& u) const { const int L = i * G + (c & 7) * (G >> 3) + (c >> 3); if (L >= nU) return false; u.pm = L >> 2; u.pn = L & 3; u.z = blk_e[u.pm]; return true; }
    __device__ __forceinline__ const char* a_ptr(const Unit& u) const { return A + (size_t)u.pm * astep; }
    __device__ __forceinline__ const char* b_ptr(const Unit& u) const { return W + (size_t)u.z * estep + (size_t)u.pn * bstep; }
};

struct SchedMoeG {
    const char* Hb; const int* rowtok; const char* W; const LAS int* blk_e; int nU, G, c; size_t estep, bstep;
    __device__ __forceinline__ bool next(int i, Unit& u) const { const int L = i * G + (c & 7) * (G >> 3) + (c >> 3); if (L >= nU) return false; u.pm = L >> 2; u.pn = L & 3; u.z = blk_e[u.pm]; return true; }
    __device__ __forceinline__ const char* a_base() const { return Hb; }
    __device__ __forceinline__ int tok(const Unit& u, int r) const { return rowtok[u.pm * 256 + r]; }
    __device__ __forceinline__ const char* b_ptr(const Unit& u) const { return W + (size_t)u.z * estep + (size_t)u.pn * bstep; }
};
#define EPI_ROWS_BEGIN _Pragma("unroll") for (int ai = 0; ai < 2; ++ai) _Pragma("unroll") for (int m = 0; m < 4; ++m)
struct EpiInProj {
    static constexpr bool PERM = true;
    bf16* Pc; bf16* Pa; bf16* Pg; float* kmean; const LAS float* gq; const LAS float* gk;
    __device__ __forceinline__ void operator()(const f32x4 (&acc)[2][2][4][2], const Unit& u, int wr, int wc, int fr, int fq) const {
        if (u.pn >= 6 && u.pn < 10) {
            const int isk = (u.pn - 6) >> 1, head = 4 * (u.pn & 1) + wc;
            const LAS float* gt = isk ? gk : gq;
            float ks[2][8];
#pragma unroll
            for (int bj = 0; bj < 2; ++bj)
#pragma unroll
                for (int e = 0; e < 8; ++e) ks[bj][e] = 0.f;
            const int ln = fq * 16 + fr, sr = ln >> 2, sc = ln & 3; const unsigned sb = xsrc_bytes(fr, fq);
            const int row0 = u.pm * BM + wr * 64 + sr;
            EPI_ROWS_BEGIN {
                float ss = 0.f;
#pragma unroll
                for (int bj = 0; bj < 2; ++bj)
#pragma unroll
                    for (int n = 0; n < 2; ++n) { const f32x4 v = acc[ai][bj][m][n]; ss += (v[0] * v[0] + v[1] * v[1]) + (v[2] * v[2] + v[3] * v[3]); }
                ss += __shfl_xor(ss, 16); ss += __shfl_xor(ss, 32);
                const float rs = rsqrtf(ss * (1.f / 64.f) + RMS_EPS);
                bf16* rowp = Pa + (size_t)(row0 + ai * HALF + m * 16) * NPA + isk * 512 + head * 64 + 8 * sc;
#pragma unroll
                for (int bj = 0; bj < 2; ++bj) { float o[8];
                    const f32x4 g0 = *(const LAS f32x4*)(gt + 32 * bj + 8 * fq), g1 = *(const LAS f32x4*)(gt + 32 * bj + 8 * fq + 4);
#pragma unroll
                    for (int e = 0; e < 8; ++e) { o[e] = acc[ai][bj][m][e >> 2][e & 3] * rs * (e < 4 ? g0[e & 3] : g1[e & 3]); ks[bj][e] += o[e]; }
                    u32x4 w; w.x = cvt_pk_bf16(o[0], o[1]); w.y = cvt_pk_bf16(o[2], o[3]); w.z = cvt_pk_bf16(o[4], o[5]); w.w = cvt_pk_bf16(o[6], o[7]);
                    *(u32x4*)(rowp + 32 * bj) = to_rows(w, sb); }
            }
            if (isk) {
#pragma unroll
                for (int bj = 0; bj < 2; ++bj)
#pragma unroll
                    for (int e = 0; e < 8; ++e) { float v = ks[bj][e]; v += __shfl_xor(v, 1); v += __shfl_xor(v, 2); v += __shfl_xor(v, 4); v += __shfl_xor(v, 8); ks[bj][e] = v; }
                if (fr == 0) { float* kp = kmean + (size_t)wr * (4 * 8 * 32 * 64) + ((size_t)(((u.pm >> 5) * 8 + head) * 32 + (u.pm & 31))) * 64 + 8 * fq;
#pragma unroll
                    for (int bj = 0; bj < 2; ++bj) { *(f32x4*)(kp + 32 * bj) = (f32x4){ks[bj][0], ks[bj][1], ks[bj][2], ks[bj][3]} * (1.f / 256.f); *(f32x4*)(kp + 32 * bj + 4) = (f32x4){ks[bj][4], ks[bj][5], ks[bj][6], ks[bj][7]} * (1.f / 256.f); } }
            }
            return;
        }
        bf16* base; int ld, colt;
        if (u.pn < 6) { base = Pc; ld = NPC; colt = u.pn * 256; } else if (u.pn < 12) { base = Pa; ld = NPA; colt = (u.pn - 6) * 256; } else { base = Pg; ld = NPG; colt = (u.pn - 12) * 256; }
        const int ln = fq * 16 + fr, sr = ln >> 2, sc = ln & 3; const unsigned sb = xsrc_bytes(fr, fq);
        const int row0 = u.pm * BM + wr * 64 + sr, col0 = colt + wc * 32 + 8 * sc;
        EPI_ROWS_BEGIN { bf16* rowp = base + (size_t)(row0 + ai * HALF + m * 16) * ld + col0;
#pragma unroll
            for (int bj = 0; bj < 2; ++bj) { const f32x4 v0 = acc[ai][bj][m][0], v1 = acc[ai][bj][m][1];
                u32x4 w; w.x = cvt_pk_bf16(v0[0], v0[1]); w.y = cvt_pk_bf16(v0[2], v0[3]); w.z = cvt_pk_bf16(v1[0], v1[1]); w.w = cvt_pk_bf16(v1[2], v1[3]);
                *(u32x4*)(rowp + bj * HALF) = to_rows(w, sb); } }
    }
};
struct EpiBranch {
    static constexpr bool PERM = true;
    bf16* Bb;
    __device__ __forceinline__ void operator()(const f32x4 (&acc)[2][2][4][2], const Unit& u, int wr, int wc, int fr, int fq) const {
        const int ln = fq * 16 + fr, sr = ln >> 2, sc = ln & 3; const unsigned sb = xsrc_bytes(fr, fq);
        const int row0 = u.pm * BM + wr * 64 + sr, col0 = u.z * 1024 + u.pn * 256 + wc * 32 + 8 * sc;
        EPI_ROWS_BEGIN { bf16* rowp = Bb + (size_t)(row0 + ai * HALF + m * 16) * 3072 + col0;
#pragma unroll
            for (int bj = 0; bj < 2; ++bj) { const f32x4 v0 = acc[ai][bj][m][0], v1 = acc[ai][bj][m][1];
                u32x4 w; w.x = cvt_pk_bf16(v0[0], v0[1]); w.y = cvt_pk_bf16(v0[2], v0[3]); w.z = cvt_pk_bf16(v1[0], v1[1]); w.w = cvt_pk_bf16(v1[2], v1[3]);
                *(u32x4*)(rowp + bj * HALF) = to_rows(w, sb); } }
    }
};
struct EpiGateMerge {
    static constexpr bool PERM = true;
    const bf16* Bb; bf16* Mg;
    __device__ __forceinline__ void operator()(const f32x4 (&acc)[2][2][4][2], const Unit& u, int wr, int wc, int fr, int fq) const {
        const int ln = fq * 16 + fr, sr = ln >> 2, sc = ln & 3; const unsigned sb = xsrc_bytes(fr, fq);
        const int row0 = u.pm * BM + wr * 64 + sr, col0 = u.pn * 256 + wc * 32 + 8 * sc;
        u32x4 bw[2][2][2], mw[2][2][2];
#define GM_LOAD(q, buf) do { _Pragma("unroll") for (int mm = 0; mm < 2; ++mm) _Pragma("unroll") for (int bj = 0; bj < 2; ++bj) { const size_t r = (size_t)(row0 + ((q) >> 1) * HALF + (2 * ((q) & 1) + mm) * 16); \
            bw[buf][mm][bj] = *(const u32x4*)(Bb + r * 3072 + u.z * 1024 + col0 + bj * HALF); \
            mw[buf][mm][bj] = (u.z != 0) ? *(const u32x4*)(Mg + r * 1024 + col0 + bj * HALF) : (u32x4){0u, 0u, 0u, 0u}; } } while (0)
#define GM_PROC(q, buf) do { _Pragma("unroll") for (int mm = 0; mm < 2; ++mm) _Pragma("unroll") for (int bj = 0; bj < 2; ++bj) { const int ai = (q) >> 1, m = 2 * ((q) & 1) + mm; const size_t r = (size_t)(row0 + ai * HALF + m * 16); \
            float b[8], pm_[8], o[8]; unpack8(bw[buf][mm][bj], b); unpack8(mw[buf][mm][bj], pm_); \
            const f32x4 a0 = to_rows(acc[ai][bj][m][0], sb), a1 = to_rows(acc[ai][bj][m][1], sb);     \
            _Pragma("unroll") for (int e = 0; e < 8; ++e) o[e] = sigmoidf_(e < 4 ? a0[e & 3] : a1[e & 3]) * b[e] + pm_[e]; \
            u32x4 w; w.x = cvt_pk_bf16(o[0], o[1]); w.y = cvt_pk_bf16(o[2], o[3]); w.z = cvt_pk_bf16(o[4], o[5]); w.w = cvt_pk_bf16(o[6], o[7]); \
            *(u32x4*)(Mg + r * 1024 + col0 + bj * HALF) = w; } } while (0)
        GM_LOAD(0, 0); GM_LOAD(1, 1); __builtin_amdgcn_sched_barrier(0);
        GM_PROC(0, 0); __builtin_amdgcn_sched_barrier(0); GM_LOAD(2, 0); __builtin_amdgcn_sched_barrier(0);
        GM_PROC(1, 1); __builtin_amdgcn_sched_barrier(0); GM_LOAD(3, 1); __builtin_amdgcn_sched_barrier(0);
        GM_PROC(2, 0); __builtin_amdgcn_sched_barrier(0);
        GM_PROC(3, 1);
#undef GM_LOAD
#undef GM_PROC
    }
};
struct EpiOut {
    static constexpr bool PERM = false;
    const float* xin; float* out;
    __device__ __forceinline__ void operator()(const f32x4 (&acc)[2][2][4][2], const Unit& u, int wr, int wc, int fr, int fq) const {
        const int ln = fq * 16 + fr, sr = ln >> 2, sc = ln & 3; const unsigned sb = xsrc_bytes(fr, fq);
        const int row0 = u.pm * BM + wr * 64 + sr, col0 = u.pn * BM + wc * 32 + 4 * sc;
        f32x4 xv[2][2][2][2];
#define EO_LOAD(q, buf) do { _Pragma("unroll") for (int mm = 0; mm < 2; ++mm) { const size_t off = (size_t)(row0 + ((q) >> 1) * HALF + (2 * ((q) & 1) + mm) * 16) * 1024 + col0; \
            _Pragma("unroll") for (int bj = 0; bj < 2; ++bj) _Pragma("unroll") for (int n = 0; n < 2; ++n) xv[buf][mm][bj][n] = *(const f32x4*)(xin + off + bj * HALF + n * 16); } } while (0)
#define EO_PROC(q, buf) do { _Pragma("unroll") for (int mm = 0; mm < 2; ++mm) { const int ai = (q) >> 1, m = 2 * ((q) & 1) + mm; const size_t off = (size_t)(row0 + ai * HALF + m * 16) * 1024 + col0; \
            _Pragma("unroll") for (int bj = 0; bj < 2; ++bj) _Pragma("unroll") for (int n = 0; n < 2; ++n) *(f32x4*)(out + off + bj * HALF + n * 16) = xv[buf][mm][bj][n] + to_rows(acc[ai][bj][m][n], sb); } } while (0)
        EO_LOAD(0, 0); EO_LOAD(1, 1); __builtin_amdgcn_sched_barrier(0);
        EO_PROC(0, 0); __builtin_amdgcn_sched_barrier(0); EO_LOAD(2, 0); __builtin_amdgcn_sched_barrier(0);
        EO_PROC(1, 1); __builtin_amdgcn_sched_barrier(0); EO_LOAD(3, 1); __builtin_amdgcn_sched_barrier(0);
        EO_PROC(2, 0); __builtin_amdgcn_sched_barrier(0);
        EO_PROC(3, 1);
#undef EO_LOAD
#undef EO_PROC
    }
};
struct EpiSwiGLU {
    static constexpr bool PERM = true;
    bf16* act; const float* rowrs;
    __device__ __forceinline__ void operator()(const f32x4 (&acc)[2][2][4][2], const Unit& u, int wr, int wc, int fr, int fq) const {
        const int ln = fq * 16 + fr, sr = ln >> 2, sc = ln & 3; const unsigned sb = xsrc_bytes(fr, fq);
        const int row0 = u.pm * BM + wr * 64 + fr, col0 = u.pn * 128 + wc * 32 + 8 * sc;
        float rsv[2][4];
#pragma unroll
        for (int ai = 0; ai < 2; ++ai)
#pragma unroll
            for (int m = 0; m < 4; ++m) rsv[ai][m] = rowrs[row0 + ai * HALF + m * 16];
        EPI_ROWS_BEGIN { bf16* rowp = act + (size_t)(row0 - fr + sr + ai * HALF + m * 16) * 512 + col0; const float rs = rsv[ai][m];
            float o[8];
#pragma unroll
            for (int e = 0; e < 8; ++e) { const float g = acc[ai][0][m][e >> 2][e & 3] * rs, up = acc[ai][1][m][e >> 2][e & 3] * rs; o[e] = g * sigmoidf_(g) * up; }
            u32x4 w; w.x = cvt_pk_bf16(o[0], o[1]); w.y = cvt_pk_bf16(o[2], o[3]); w.z = cvt_pk_bf16(o[4], o[5]); w.w = cvt_pk_bf16(o[6], o[7]);
            *(u32x4*)rowp = to_rows(w, sb); }
    }
};
struct EpiMoeDown {
    static constexpr bool PERM = true;
    bf16* ys;
    __device__ __forceinline__ void operator()(const f32x4 (&acc)[2][2][4][2], const Unit& u, int wr, int wc, int fr, int fq) const {
        const int ln = fq * 16 + fr, sr = ln >> 2, sc = ln & 3; const unsigned sb = xsrc_bytes(fr, fq);
        const int row0 = u.pm * BM + wr * 64 + sr, col0 = u.pn * 256 + wc * 32 + 8 * sc;
        EPI_ROWS_BEGIN { const int r = row0 + ai * HALF + m * 16; bf16* rowp = ys + (size_t)r * 1024 + col0;
#pragma unroll
            for (int bj = 0; bj < 2; ++bj) { const f32x4 v0 = acc[ai][bj][m][0], v1 = acc[ai][bj][m][1];
                u32x4 w; w.x = cvt_pk_bf16(v0[0], v0[1]); w.y = cvt_pk_bf16(v0[2], v0[3]); w.z = cvt_pk_bf16(v1[0], v1[1]); w.w = cvt_pk_bf16(v1[2], v1[3]);
                *(u32x4*)(rowp + bj * HALF) = to_rows(w, sb); } }
    }
};
}

#define XB_TMO      128
#define XB_XCNT(j)  (256  + 64 * (j))
#define XB_XSUB(j)  (1280 + 64 * (j))
#define XB_XGEN(j)  (2304 + 64 * (j))
#define XB_TOP      3328
#define XB_TOPGEN   3392
#define XCD_BAR_WORDS 3456
#define XB_SPIN_CAP (1u << 18)
__device__ __forceinline__ unsigned xb_ld(unsigned* p)              { return __hip_atomic_load(p, __ATOMIC_RELAXED, __HIP_MEMORY_SCOPE_AGENT); }
__device__ __forceinline__ unsigned xb_add(unsigned* p, unsigned v) { return __hip_atomic_fetch_add(p, v, __ATOMIC_RELAXED, __HIP_MEMORY_SCOPE_AGENT); }
__device__ __forceinline__ unsigned xb_xcc_id() { return (unsigned)__builtin_amdgcn_s_getreg((3 << 11) | 20) & 0xFu; }
#define XB_SPIN(cond, bar) do { unsigned _sp = 0; while (cond) { __builtin_amdgcn_s_sleep(1); \
    if ((++_sp & 255u) == 0u) { if (xb_ld(&(bar)[XB_TMO])) break; if (_sp > XB_SPIN_CAP) { atomicAdd(&(bar)[XB_TMO], 1u); break; } } } } while (0)
struct XcdBarrier { unsigned* bar; unsigned x; volatile LAS unsigned* st; };
__device__ __forceinline__ XcdBarrier xcd_barrier_post(unsigned* bar, volatile LAS unsigned* st) {
    XcdBarrier b; b.bar = bar; b.x = xb_xcc_id(); b.st = st;
    if (threadIdx.x == 0) (void)xb_add(&bar[XB_XCNT(b.x)], 1u);
    return b;
}
__device__ __forceinline__ void xcd_barrier_complete(unsigned* bar, unsigned x, unsigned& nloc, unsigned& nx) {
    const unsigned G = gridDim.x * gridDim.y * gridDim.z;
    unsigned sum, cnt, mine, sp = 0u;
    for (;;) {
        sum = 0u; cnt = 0u; mine = 0u;
#pragma unroll
        for (unsigned j = 0; j < 16; ++j) { const unsigned c = xb_ld(&bar[XB_XCNT(j)]); sum += c; cnt += (c > 0u) ? 1u : 0u; mine = (j == x) ? c : mine; }
        if (sum == G) break;
        __builtin_amdgcn_s_sleep(1);
        if ((++sp & 255u) == 0u) { if (xb_ld(&bar[XB_TMO])) break; if (sp > XB_SPIN_CAP) { atomicAdd(&bar[XB_TMO], 1u); break; } }
    }
    nloc = mine > 0u ? mine : 1u; nx = cnt > 0u ? cnt : 1u;
}
__device__ __forceinline__ void xcd_barrier(const XcdBarrier& b) {
    asm volatile("s_waitcnt vmcnt(0)" ::: "memory");
    __syncthreads();
    if (threadIdx.x == 0) {
        unsigned* bar = b.bar;
        __builtin_amdgcn_s_waitcnt(0);
        unsigned nloc = b.st[0], nx = b.st[1];
        if (nloc == 0u) { xcd_barrier_complete(bar, b.x, nloc, nx); b.st[0] = nloc; b.st[1] = nx; }
        const unsigned old = xb_add(&bar[XB_XSUB(b.x)], 1u);
        const unsigned gen = old / nloc;
        if (old + 1u == (gen + 1u) * nloc) {
            __builtin_amdgcn_fence(__ATOMIC_RELEASE, "agent");
            asm volatile("s_waitcnt vmcnt(0)" ::: "memory");
            const unsigned og = xb_add(&bar[XB_TOP], 1u);
            const unsigned tg = og / nx;
            if (og + 1u == (tg + 1u) * nx) xb_add(&bar[XB_TOPGEN], 1u);
            else XB_SPIN(xb_ld(&bar[XB_TOPGEN]) == tg, bar);
            __builtin_amdgcn_fence(__ATOMIC_ACQUIRE, "agent");
            xb_add(&bar[XB_XGEN(b.x)], 1u);
            asm volatile("s_waitcnt vmcnt(0)" ::: "memory");
        } else {
            XB_SPIN(xb_ld(&bar[XB_XGEN(b.x)]) == gen, bar);
            __builtin_amdgcn_fence(__ATOMIC_ACQUIRE, "agent");
            asm volatile("s_waitcnt vmcnt(0)" ::: "memory");
        }
    }
    __syncthreads();
}

struct Frame {
    LAS unsigned char* lds;
    volatile LAS unsigned* MISC;
    unsigned* ctl;
    int tid, lane, wave;
    static constexpr int G = 256;
    float* out;
    unsigned char* ws;
    __device__ __forceinline__ const float* inp(int k) const {
        const LAS unsigned* p = (const LAS unsigned*)(lds + PTAB_OFF) + 2 * k; const unsigned lo = __builtin_amdgcn_readfirstlane(p[0]), hi = __builtin_amdgcn_readfirstlane(p[1]);
        return (const float*)(const GAS float*)(((unsigned long long)hi << 32) | lo); }
};
__device__ __forceinline__ int tid_now() { int t = threadIdx.x; asm volatile("" : "+v"(t)); return t; }
__device__ __forceinline__ unsigned char* opaque(unsigned char* p) { unsigned z = 0u; asm volatile("" : "+s"(z)); return p + z; }
#define LDS_WAIT() asm volatile("s_waitcnt lgkmcnt(0)" ::: "memory")

__device__ __forceinline__ void transpose_item(const float* W, int ldw, int nvalid, bf16* WT, int Kd, int k0, int n0, int drow0, LAS float* scr, int lane) {
    const int cn = n0 + (lane & 31); const bool ok = cn < nvalid;
    float tv[32];
#pragma unroll
    for (int i = 0; i < 32; ++i) { const int kk = 2 * i + (lane >> 5); tv[i] = ok ? W[(size_t)(k0 + kk) * ldw + cn] : 0.f; }
#pragma unroll
    for (int i = 0; i < 32; ++i) { const int kk = 2 * i + (lane >> 5); scr[kk * 33 + (lane & 31)] = tv[i]; }
    LDS_WAIT(); asm volatile("" ::: "memory");
    const int c = lane & 7;
#pragma unroll
    for (int j = 0; j < 4; ++j) { const int n = (lane >> 3) + 8 * j; const LAS float* s = scr + (8 * c) * 33 + n;
        u32x4 o; o.x = pk2(s[0 * 33], s[1 * 33]); o.y = pk2(s[2 * 33], s[3 * 33]); o.z = pk2(s[4 * 33], s[5 * 33]); o.w = pk2(s[6 * 33], s[7 * 33]);
        *(u32x4*)(WT + (size_t)(drow0 + n) * Kd + k0 + 8 * c) = o; }
    LDS_WAIT(); asm volatile("" ::: "memory");
}

__device__ __forceinline__ void ph_convert_mixer(Frame& F) {
    const int tid = tid_now(), lane = tid & 63, wave = __builtin_amdgcn_readfirstlane(tid >> 6); (void)lane; (void)wave;
    unsigned char* const wsl = opaque(F.ws);
    LAS float* scr = (LAS float*)(F.lds + wave * 16384);
    const int gw = blockIdx.x * 8 + wave, NGW = F.G * 8;
    constexpr int I_IN = 16 * 152, I_G = 3 * 16 * 32, I_B = 3 * 8 * 32, I_O = 16 * 32, I_L = I_IN + I_G + I_B + I_O;
    for (int it = gw; it < 2 * I_L; it += NGW) {
        const int l = it / I_L; int r = it % I_L;
        unsigned char* wb = wsl + WS_WMIX + (size_t)l * WMIX_LAYER;
        if (r < I_IN) { const int kb = r / 152, nb = r % 152;
            int drow = nb * 32;
            if (nb >= 48 && nb < 80) { const int rel = nb - 48, isk = rel >> 4, head = (rel & 15) >> 1, bjj = rel & 1;
                drow = (6 + 2 * isk + (head >> 2)) * 256 + 128 * bjj + 32 * (head & 3); }
            transpose_item(F.inp(3) + (size_t)l * 1024 * 4624, 4624, 4624, (bf16*)(wb + WO_WIN), 1024, kb * 64, nb * 32, drow, scr, lane); continue; }
        r -= I_IN;
        if (r < I_G) { const int z = r / 512, q = r % 512, kb = q / 32, nb = q % 32;
            transpose_item(F.inp(11) + ((size_t)l * 3 + z) * 1024 * 1024, 1024, 1024, (bf16*)(wb + WO_WG), 1024, kb * 64, nb * 32, z * 1024 + nb * 32, scr, lane); continue; }
        r -= I_G;
        if (r < I_B) { const int z = r / 256, q = r % 256, kb = q / 32, nb = q % 32;
            transpose_item(F.inp(12) + ((size_t)l * 3 + z) * 512 * 1024, 1024, 1024, (bf16*)(wb + WO_WB) + (size_t)z * 1024 * 512, 512, kb * 64, nb * 32, nb * 32, scr, lane); continue; }
        r -= I_B;
        { const int kb = r / 32, nb = r % 32;
            transpose_item(F.inp(13) + (size_t)l * 1024 * 1024, 1024, 1024, (bf16*)(wb + WO_WO), 1024, kb * 64, nb * 32, nb * 32, scr, lane); }
    }
    { bf16* WR = (bf16*)(wsl + WS_WR);
      for (int i = blockIdx.x * 512 + tid; i < 2 * 48 * 1024; i += F.G * 512) { const int l = i / (48 * 1024), n = (i >> 10) % 48, k = i & 1023;
          float w = 0.f;
          if (n < 32) w = F.inp(17)[((size_t)l * 1024 + k) * 32 + n]; else if (n < 36) w = F.inp(15)[((size_t)l * 1024 + k) * 4 + (n - 32)];
          const unsigned hi = f2bf(w), lo = f2bf(w - __uint_as_float(hi << 16));
          WR[((size_t)(l * 2 + 0) * 48 + n) * 1024 + k] = (bf16)hi; WR[((size_t)(l * 2 + 1) * 48 + n) * 1024 + k] = (bf16)lo; } }
}
__device__ __forceinline__ void ph_convert_experts(Frame& F, int l) {
    const int tid = tid_now(), lane = tid & 63, wave = __builtin_amdgcn_readfirstlane(tid >> 6); (void)lane; (void)wave;
    unsigned char* const wsl = opaque(F.ws);
    LAS float* scr = (LAS float*)(F.lds + wave * 16384);
    const int gw = blockIdx.x * 8 + wave, NGW = F.G * 8;
    constexpr int I_1 = 32 * 16 * 32, I_2 = 32 * 8 * 32;
    bf16* W1T = (bf16*)(wsl + WS_W1T); bf16* WdT = (bf16*)(wsl + WS_WDT);
    for (int it = gw; it < I_1 + I_2; it += NGW) {
        if (it < I_1) { const int e = it / 512, q = it % 512, kb = q / 32, j = q % 32, half = j >> 4, nb = j & 15;
            const float* src = (half ? F.inp(20) : F.inp(19)) + ((size_t)l * 32 + e) * 1024 * 512;
            const int t = nb >> 2, drow = t * 256 + half * 128 + (nb & 3) * 32;
            transpose_item(src, 512, 512, W1T + (size_t)e * 1024 * 1024, 1024, kb * 64, nb * 32, drow, scr, lane);
        } else { const int r = it - I_1, e = r / 256, q = r % 256, kb = q / 32, nb = q % 32;
            transpose_item(F.inp(21) + ((size_t)l * 32 + e) * 512 * 1024, 1024, 1024, WdT + (size_t)e * 1024 * 512, 512, kb * 64, nb * 32, nb * 32, scr, lane); }
    }
}
template <bool COMBINE, bool NORM>
__device__ __forceinline__ void ph_norm(Frame& F, const float* xin, const float* gain, bf16* H) {
    const int tid = tid_now(), lane = tid & 63, wave = __builtin_amdgcn_readfirstlane(tid >> 6); (void)lane; (void)wave;
    unsigned char* const wsl = opaque(F.ws);
    const int gw = blockIdx.x * 8 + wave, NGW = F.G * 8;
    const int* toks = (const int*)(wsl + WS_TOKS); const bf16* ys = (const bf16*)(wsl + WS_YS); const float* tokw = (const float*)(wsl + WS_TOKW);
    constexpr int R = 4;
    f32x4 g[4];
#pragma unroll
    for (int j = 0; j < 4; ++j) g[j] = NORM ? *((const f32x4*)gain + 64 * j + lane) : (f32x4){0.f, 0.f, 0.f, 0.f};
    for (int it_ = 0; it_ < T_ / (NGW * R); ++it_) { const int m0 = (blockIdx.x * (T_ / F.G)) + (it_ * 8 + wave) * R;
        f32x4 v[R][4];
        int sl[R][2]; float sw[R][2];
        if (COMBINE) {
#pragma unroll
            for (int rr = 0; rr < R; ++rr) { sl[rr][0] = toks[2 * (m0 + rr)]; sl[rr][1] = toks[2 * (m0 + rr) + 1]; sw[rr][0] = tokw[2 * (m0 + rr)]; sw[rr][1] = tokw[2 * (m0 + rr) + 1]; } }
#pragma unroll
        for (int rr = 0; rr < R; ++rr) { const f32x4* xr = (const f32x4*)(xin + (size_t)(m0 + rr) * 1024) + lane;
#pragma unroll
            for (int j = 0; j < 4; ++j) v[rr][j] = xr[64 * j]; }
        if (COMBINE) {
            u32x2 ya[R][4], yb[R][4];
#pragma unroll
            for (int rr = 0; rr < R; ++rr) { const u32x2* y0 = (const u32x2*)(ys + (size_t)sl[rr][0] * 1024) + lane; const u32x2* y1 = (const u32x2*)(ys + (size_t)sl[rr][1] * 1024) + lane;
#pragma unroll
                for (int j = 0; j < 4; ++j) { ya[rr][j] = y0[64 * j]; yb[rr][j] = y1[64 * j]; } }
#pragma unroll
            for (int rr = 0; rr < R; ++rr) { f32x4* xo = (f32x4*)(F.out + (size_t)(m0 + rr) * 1024) + lane;
#pragma unroll
                for (int j = 0; j < 4; ++j) { const u32x2 a = ya[rr][j], b = yb[rr][j];
                    const float w0 = sw[rr][0], w1 = sw[rr][1];
                    v[rr][j].x += w0 * bflo(a.x) + w1 * bflo(b.x); v[rr][j].y += w0 * bfhi(a.x) + w1 * bfhi(b.x); v[rr][j].z += w0 * bflo(a.y) + w1 * bflo(b.y); v[rr][j].w += w0 * bfhi(a.y) + w1 * bfhi(b.y);
                    xo[64 * j] = v[rr][j]; } }
        }
        if (NORM) {
#pragma unroll
            for (int rr = 0; rr < R; ++rr) {
                float ss = 0.f;
#pragma unroll
                for (int j = 0; j < 4; ++j) ss += (v[rr][j].x * v[rr][j].x + v[rr][j].y * v[rr][j].y) + (v[rr][j].z * v[rr][j].z + v[rr][j].w * v[rr][j].w);
                const float rs = rsqrtf(wave_sum(ss) * (1.f / 1024.f) + RMS_EPS);
                u32x2* o8 = (u32x2*)(H + (size_t)(m0 + rr) * 1024) + lane;
#pragma unroll
                for (int j = 0; j < 4; ++j) { u32x2 w; w.x = pk2(v[rr][j].x * rs * g[j].x, v[rr][j].y * rs * g[j].y); w.y = pk2(v[rr][j].z * rs * g[j].z, v[rr][j].w * rs * g[j].w); o8[64 * j] = w; }
            }
        }
    }
}

__device__ __forceinline__ void ph_gla_z(Frame& F, int l) {
    const int tid = tid_now(), lane = tid & 63, wave = __builtin_amdgcn_readfirstlane(tid >> 6); (void)lane; (void)wave;
    unsigned char* const wsl = opaque(F.ws);
    const bf16* H = (const bf16*)(wsl + WS_H); float* ZB = (float*)(wsl + WS_ZB);
    const float* wz = F.inp(3) + (size_t)l * 1024 * 4624 + 4608;
    LAS bf16* wl = (LAS bf16*)F.lds;
    constexpr int WP = 1032;
    asm volatile("s_waitcnt vmcnt(0)" ::: "memory");
    __syncthreads();
    { f32x4 wv[8];
#pragma unroll
      for (int i = 0; i < 8; ++i) { const int idx = tid + 512 * i; wv[i] = *(const f32x4*)(wz + (size_t)(idx >> 2) * 4624 + (idx & 3) * 4); }
#pragma unroll
      for (int i = 0; i < 8; ++i) { const int idx = tid + 512 * i, k = idx >> 2, n0 = (idx & 3) * 4;
          wl[(n0 + 0) * WP + k] = (bf16)f2bf(wv[i].x); wl[(n0 + 1) * WP + k] = (bf16)f2bf(wv[i].y); wl[(n0 + 2) * WP + k] = (bf16)f2bf(wv[i].z); wl[(n0 + 3) * WP + k] = (bf16)f2bf(wv[i].w); } }
    __syncthreads();
    const int t = lane & 15, kg = lane >> 4;
    const int row = blockIdx.x * (T_ / F.G) + wave * 16 + t;
    const bf16* hr = H + (size_t)row * 1024 + kg * 8;
    f32x4 acc = {0.f, 0.f, 0.f, 0.f};
    bf16x8 hv[32];
#pragma unroll
    for (int ks = 0; ks < 32; ++ks) hv[ks] = *(const bf16x8*)(hr + 32 * ks);
#pragma unroll
    for (int ks = 0; ks < 32; ++ks) { const bf16x8 af = *(const LAS bf16x8*)(wl + t * WP + 32 * ks + kg * 8);
        acc = __builtin_amdgcn_mfma_f32_16x16x32_bf16(af, hv[ks], acc, 0, 0, 0); }
    *(f32x4*)(ZB + (size_t)row * 16 + 4 * kg) = acc;
    __syncthreads();
}
__device__ __forceinline__ void ph_conv(Frame& F, int l) {
    const int tid = tid_now(), lane = tid & 63, wave = __builtin_amdgcn_readfirstlane(tid >> 6); (void)lane; (void)wave;
    unsigned char* const wsl = opaque(F.ws);
    const bf16* Pc = (const bf16*)(wsl + WS_PC); bf16* Y = (bf16*)(wsl + WS_Y);
    const float* cw = F.inp(4) + (size_t)l * 3 * 512; const float* cbias = F.inp(5) + (size_t)l * 512;
    const int gt = blockIdx.x * 512 + tid, NT = F.G * 512;
    (void)gt; (void)NT;
    float w0[8], w1[8], w2[8], bb[8];
#pragma unroll
    for (int e = 0; e < 8; ++e) { w0[e] = cw[lane * 8 + e]; w1[e] = cw[512 + lane * 8 + e]; w2[e] = cw[1024 + lane * 8 + e]; bb[e] = cbias[lane * 8 + e]; }
    for (int it_ = 0; it_ < (T_ / F.G) / 8; it_ += 4) {
        const int r0 = blockIdx.x * (T_ / F.G) + (it_ / 4) * 32 + wave * 4, c8 = lane * 8, s0 = r0 & (SEQ - 1);
        const bf16* p = Pc + (size_t)r0 * NPC + c8;
        u32x4 wcb[4], wcc[6], wcx[6];
#pragma unroll
        for (int q = 0; q < 6; ++q) { const bool okr = (s0 + q - 2) >= 0; const bf16* pr = p + (long)(q - 2) * NPC;
            wcc[q] = okr ? *(const u32x4*)(pr + 512) : (u32x4){0u, 0u, 0u, 0u}; wcx[q] = okr ? *(const u32x4*)(pr + 1024) : (u32x4){0u, 0u, 0u, 0u}; }
#pragma unroll
        for (int q = 0; q < 4; ++q) wcb[q] = *(const u32x4*)(p + (size_t)q * NPC);
        float u[6][8];
#pragma unroll
        for (int q = 0; q < 6; ++q) { float a[8], b[8]; unpack8(wcc[q], a); unpack8(wcx[q], b);
#pragma unroll
            for (int e = 0; e < 8; ++e) u[q][e] = a[e] * b[e]; }
#pragma unroll
        for (int q = 0; q < 4; ++q) { float cb[8], o[8]; unpack8(wcb[q], cb);
#pragma unroll
            for (int e = 0; e < 8; ++e) o[e] = cb[e] * (bb[e] + w0[e] * u[q][e] + w1[e] * u[q + 1][e] + w2[e] * u[q + 2][e]);
            *(u32x4*)(Y + (size_t)(r0 + q) * NYC + c8) = pack8(o); }
    }
}
__device__ __forceinline__ void ph_qknorm(Frame& F, int l, bool probe = false) {
    const int tid = tid_now(), lane = tid & 63, wave = __builtin_amdgcn_readfirstlane(tid >> 6); (void)lane; (void)wave;
    unsigned char* const wsl = opaque(F.ws);
    bf16* Pa = (bf16*)(wsl + WS_PA); float* kmean = (float*)(wsl + WS_KMEAN);
    LAS float* red = (LAS float*)F.lds;
    for (int unit = blockIdx.x; unit < 256; unit += F.G) {
        const int blk = unit >> 1, isk = unit & 1;
        const float* gn = (isk ? F.inp(7) : F.inp(6)) + l * 64 + (lane & 7) * 8;
        float g[8], ksum[8];
#pragma unroll
        for (int e = 0; e < 8; ++e) { g[e] = gn[e] * (isk ? 1.f : QSCALE); ksum[e] = 0.f; }
        for (int rr0 = 0; rr0 < 32; rr0 += 8) {
            u32x4 raw[8];
#pragma unroll
            for (int q8 = 0; q8 < 8; ++q8) raw[q8] = *(const u32x4*)(Pa + (size_t)(blk * 256 + wave * 32 + rr0 + q8) * NPA + isk * 512 + lane * 8);
#pragma unroll
            for (int q8 = 0; q8 < 8; ++q8) {
                bf16* p = Pa + (size_t)(blk * 256 + wave * 32 + rr0 + q8) * NPA + isk * 512 + lane * 8;
                float v[8]; unpack8(raw[q8], v);
                float ss = 0.f;
#pragma unroll
                for (int e = 0; e < 8; ++e) ss += v[e] * v[e];
                ss += __shfl_xor(ss, 1); ss += __shfl_xor(ss, 2); ss += __shfl_xor(ss, 4);
                const float rs = rsqrtf(ss * (1.f / 64.f) + RMS_EPS);
#pragma unroll
                for (int e = 0; e < 8; ++e) { v[e] = v[e] * rs * g[e]; ksum[e] += v[e]; }
                *(u32x4*)(probe ? (bf16*)(wsl + WS_END) + ((p - Pa) & (8 * 1024 * 1024 - 1)) : p) = pack8(v);
            }
        }
        if (isk) {
#pragma unroll
            for (int e = 0; e < 8; ++e) red[wave * 512 + lane * 8 + e] = ksum[e];
            __syncthreads();
            { const int col = tid; float s = 0.f;
#pragma unroll
              for (int w = 0; w < 8; ++w) s += red[w * 512 + col];
              const int b = blk >> 5, n = blk & 31, h = col >> 6, d = col & 63;
              kmean[((size_t)((b * 8 + h) * 32 + n)) * 64 + d] = s * (1.f / 256.f); }
            __syncthreads();
        }
    }
}
__device__ __forceinline__ void ph_moba_gate(Frame& F) {
    const int tid = tid_now(), lane = tid & 63, wave = __builtin_amdgcn_readfirstlane(tid >> 6); (void)lane; (void)wave;
    unsigned char* const wsl = opaque(F.ws);
    const bf16* Pa = (const bf16*)(wsl + WS_PA); const float* kmean = (const float*)(wsl + WS_KM2); unsigned* sel = (unsigned*)(wsl + WS_SEL);
    const int gw = blockIdx.x * 8 + wave, NGW = F.G * 8;
    const int c = lane & 31, hi = lane >> 5;
    typedef float f32x16g __attribute__((ext_vector_type(16)));
    for (int it = gw; it < 512 * 8; it += NGW) {
        int rb = it >> 3; const int h = it & 7;
        if (it >= 2048) rb = (rb & ~127) | (127 - (rb & 127));
        const int b = rb >> 7, qb = (rb & 127) >> 2;
        const float* k0 = kmean + ((size_t)((b * 8 + h) * 32 + c)) * 64 + hi * 8; const float* k1 = k0 + 4 * 8 * 32 * 64;
        f32x4 ka[4][2], kb[4][2]; bf16x8 qf[2][4];
#pragma unroll
        for (int ks = 0; ks < 4; ++ks) { ka[ks][0] = *(const f32x4*)(k0 + 16 * ks); ka[ks][1] = *(const f32x4*)(k0 + 16 * ks + 4); kb[ks][0] = *(const f32x4*)(k1 + 16 * ks); kb[ks][1] = *(const f32x4*)(k1 + 16 * ks + 4); }
#pragma unroll
        for (int t = 0; t < 2; ++t)
#pragma unroll
            for (int ks = 0; ks < 4; ++ks) qf[t][ks] = *(const bf16x8*)(Pa + (size_t)(rb * 64 + 32 * t + c) * NPA + h * 64 + 16 * ks + 8 * hi);
        bf16x8 ah[4], al[4];
#pragma unroll
        for (int ks = 0; ks < 4; ++ks) { const f32x4 s0 = ka[ks][0] + kb[ks][0], s1 = ka[ks][1] + kb[ks][1];
            u32x4 hw, lw; hw.x = pk2(s0.x, s0.y); hw.y = pk2(s0.z, s0.w); hw.z = pk2(s1.x, s1.y); hw.w = pk2(s1.z, s1.w);
            lw.x = pk2(s0.x - bflo(hw.x), s0.y - bfhi(hw.x)); lw.y = pk2(s0.z - bflo(hw.y), s0.w - bfhi(hw.y)); lw.z = pk2(s1.x - bflo(hw.z), s1.y - bfhi(hw.z)); lw.w = pk2(s1.z - bflo(hw.w), s1.w - bfhi(hw.w));
            ah[ks] = __builtin_bit_cast(bf16x8, hw); al[ks] = __builtin_bit_cast(bf16x8, lw); }
#pragma unroll
        for (int t = 0; t < 2; ++t) {
            f32x16g acc = {0.f, 0.f, 0.f, 0.f, 0.f, 0.f, 0.f, 0.f, 0.f, 0.f, 0.f, 0.f, 0.f, 0.f, 0.f, 0.f};
#pragma unroll
            for (int ks = 0; ks < 4; ++ks) { acc = __builtin_amdgcn_mfma_f32_32x32x16_bf16(ah[ks], qf[t][ks], acc, 0, 0, 0); acc = __builtin_amdgcn_mfma_f32_32x32x16_bf16(al[ks], qf[t][ks], acc, 0, 0, 0); }
            float v0 = -INFINITY, v1 = -INFINITY, v2 = -INFINITY; int i0 = 255, i1 = 255, i2 = 255;
#define GATE_INS(vv, ii) do { const float v_ = (vv); const int i_ = (ii); \
                if (v_ > v0 || (v_ == v0 && i_ < i0)) { v2 = v1; i2 = i1; v1 = v0; i1 = i0; v0 = v_; i0 = i_; } \
                else if (v_ > v1 || (v_ == v1 && i_ < i1)) { v2 = v1; i2 = i1; v1 = v_; i1 = i_; } \
                else if (v_ > v2 || (v_ == v2 && i_ < i2)) { v2 = v_; i2 = i_; } } while (0)
#pragma unroll
            for (int r = 0; r < 16; ++r) { const int n = (r & 3) + 8 * (r >> 2) + 4 * hi; GATE_INS(n < qb ? acc[r] : -INFINITY, n); }
            { const float p0 = __shfl_xor(v0, 32), p1 = __shfl_xor(v1, 32), p2 = __shfl_xor(v2, 32); const int j0 = __shfl_xor(i0, 32), j1 = __shfl_xor(i1, 32), j2 = __shfl_xor(i2, 32);
              GATE_INS(p0, j0); GATE_INS(p1, j1); GATE_INS(p2, j2); }
#undef GATE_INS
            const int nv = qb < 3 ? qb : 3;
            if (hi == 0) sel[(size_t)(b * 8 + h) * SEQ + ((rb * 64 + 32 * t + c) & (SEQ - 1))] = (unsigned)(i0 & 255) | ((unsigned)(i1 & 255) << 8) | ((unsigned)(i2 & 255) << 16) | ((unsigned)nv << 24);
        }
        asm volatile("" ::: "memory");
    }
}
__device__ __forceinline__ void ph_gla_scan(Frame& F, bool probe = false) {
    const int tid = tid_now(), lane = tid & 63, wave = __builtin_amdgcn_readfirstlane(tid >> 6); (void)lane; (void)wave;
    unsigned char* const wsl = opaque(F.ws);
    bf16* GK = (bf16*)(wsl + WS_GLA); const float* DEC = (const float*)(wsl + WS_DEC);
    const int gt = blockIdx.x * 512 + tid, NT = F.G * 512;
    for (int e = gt; e < 16 * 8192; e += NT) {
        const int bh = e >> 13, dv = e & 8191, d = dv & 63;
        bf16* p = GK + (size_t)bh * 128 * 8192 + dv; const float* dc = DEC + (size_t)bh * 128 * 64 + d;
        float st = 0.f;
        float kv[16], de[16], kn[16], dn[16];
#pragma unroll
        for (int i = 0; i < 16; ++i) { kv[i] = bf1(p[(size_t)i * 8192]); de[i] = dc[i * 64]; }
        for (int n0 = 0; n0 < 128; n0 += 16) {
            const int nn = (n0 + 16 < 128) ? n0 + 16 : n0;
#pragma unroll
            for (int i = 0; i < 16; ++i) { kn[i] = bf1(p[(size_t)(nn + i) * 8192]); dn[i] = dc[(nn + i) * 64]; }
#pragma unroll
            for (int i = 0; i < 16; ++i) { (probe ? (bf16*)(wsl + WS_PC) + (p - GK) : p)[(size_t)(n0 + i) * 8192] = (bf16)f2bf(st); st = de[i] * st + kv[i]; }
#pragma unroll
            for (int i = 0; i < 16; ++i) { kv[i] = kn[i]; de[i] = dn[i]; }
        }
    }
}
__device__ __forceinline__ void ph_moba_attn(Frame& F) {
    const int tid = tid_now(), lane = tid & 63, wave = __builtin_amdgcn_readfirstlane(tid >> 6); (void)lane; (void)wave;
    unsigned char* const wsl = opaque(F.ws);
    const bf16* Pa = (const bf16*)(wsl + WS_PA); const unsigned* sel = (const unsigned*)(wsl + WS_SEL); bf16* Y = (bf16*)(wsl + WS_Y);
    LAS float* pl = (LAS float*)(F.lds + wave * 8192);
    const LAS float* bias2 = (const LAS float*)(F.lds + LTAB_OFF);
    const LAS int* bucket = (const LAS int*)(F.lds + LTAB_OFF + 1024);
    const int gw = blockIdx.x * 8 + wave, NGW = F.G * 8;
    for (int it = gw; it < T_ * 8; it += NGW) {
        const int r = it >> 3, h = it & 7, b = r >> 13, s = r & (SEQ - 1), qb = s >> 8;
        const unsigned sw = sel[(size_t)(b * 8 + h) * SEQ + s]; const int nv = (int)(sw >> 24);
        float q[64];
#pragma unroll
        for (int c = 0; c < 8; ++c) { float t8[8]; unpack8(*(const u32x4*)(Pa + (size_t)r * NPA + h * 64 + c * 8), t8);
#pragma unroll
            for (int e = 0; e < 8; ++e) q[c * 8 + e] = t8[e]; }
        float sc[4][4]; float mx = -INFINITY;
#pragma unroll
        for (int i = 0; i < 4; ++i) {
            const bool valid = (i < 3) ? (i < nv) : true;
            const int blk = (i < 3) ? (int)((sw >> (8 * i)) & 0xffu) : qb;
            if (valid) {
#pragma unroll
                for (int kk = 0; kk < 4; ++kk) {
                    const int kpos = blk * 256 + lane + 64 * kk;
                    const bf16* kp = Pa + (size_t)(b * SEQ + kpos) * NPA + 512 + h * 64;
                    float d = 0.f;
#pragma unroll
                    for (int c = 0; c < 8; ++c) { float t8[8]; unpack8(*(const u32x4*)(kp + c * 8), t8);
#pragma unroll
                        for (int e = 0; e < 8; ++e) d += q[c * 8 + e] * t8[e]; }
                    const int rel = s - kpos;
                    const float v = (rel < 0) ? -INFINITY : d + bias2[h * 32 + bucket[rel > 255 ? 255 : rel]];
                    sc[i][kk] = v; mx = fmaxf(mx, v);
                    asm volatile("" ::: "memory");
                }
            } else {
#pragma unroll
                for (int kk = 0; kk < 4; ++kk) sc[i][kk] = -INFINITY;
            }
        }
        mx = wave_max(mx);
        float ls = 0.f;
#pragma unroll
        for (int i = 0; i < 4; ++i)
#pragma unroll
            for (int kk = 0; kk < 4; ++kk) { const float p = __builtin_amdgcn_exp2f(sc[i][kk] - mx); ls += p; pl[i * 256 + lane + 64 * kk] = p; }
        ls = wave_sum(ls);
        LDS_WAIT(); asm volatile("" ::: "memory");
        float acc[8];
#pragma unroll
        for (int e = 0; e < 8; ++e) acc[e] = 0.f;
#pragma unroll
        for (int i = 0; i < 4; ++i) {
            const bool valid = (i < 3) ? (i < nv) : true;
            const int blk = (i < 3) ? (int)((sw >> (8 * i)) & 0xffu) : qb;
            if (valid) {
                const bf16* vp = Pa + (size_t)(b * SEQ + blk * 256 + (lane >> 3)) * NPA + 1024 + h * 64 + (lane & 7) * 8;
#pragma unroll 4
                for (int k0 = 0; k0 < 256; k0 += 8) {
                    const float p = pl[i * 256 + k0 + (lane >> 3)];
                    float t8[8]; unpack8(*(const u32x4*)(vp + (size_t)k0 * NPA), t8);
#pragma unroll
                    for (int e = 0; e < 8; ++e) acc[e] += p * t8[e];
                }
            }
        }
#pragma unroll
        for (int e = 0; e < 8; ++e) { acc[e] += __shfl_xor(acc[e], 8); acc[e] += __shfl_xor(acc[e], 16); acc[e] += __shfl_xor(acc[e], 32); }
        const float inv = 1.f / ls;
        if (lane < 8) { float o[8];
#pragma unroll
            for (int e = 0; e < 8; ++e) o[e] = acc[e] * inv;
            *(u32x4*)(Y + (size_t)r * NYC + 512 + h * 64 + lane * 8) = pack8(o); }
        asm volatile("" ::: "memory");
    }
}

namespace moba {
typedef float f32x16 __attribute__((ext_vector_type(16)));
constexpr int KPB = 144;
constexpr int VPB = 520;
constexpr int L_K = 0, L_V = 36864, L_TB = 70144, L_LIST = 72192, L_OST = 88576, L_WS = 125440, L_CNT = 129536;
constexpr int OSP = 72;
constexpr int OFP = 68;
__device__ __forceinline__ int crow(int r, int hi) { return (r & 3) + 8 * (r >> 2) + 4 * hi; }
__device__ __forceinline__ unsigned cvtpk(float lo, float hi) { typedef float f32x2_c __attribute__((ext_vector_type(2))); typedef __bf16 bf16x2_c __attribute__((ext_vector_type(2))); const f32x2_c v = {lo, hi}; const bf16x2_c b = __builtin_convertvector(v, bf16x2_c); return __builtin_bit_cast(unsigned, b); }

__device__ __forceinline__ void stage_kv(LAS unsigned char* lds, const bf16* Pa, int krow0, int h, const float* relb, int tid) {
#pragma unroll
    for (int i = 0; i < 4; ++i) { const int id = tid + 512 * i, kv = id >> 3, dc = id & 7;
        const bf16* src = Pa + (size_t)(krow0 + kv) * NPA + h * 64 + dc * 8;
        const u32x4 kw = *(const u32x4*)(src + 512), vw = *(const u32x4*)(src + 1024);
        *(LAS u32x4*)(lds + L_K + kv * KPB + dc * 16) = kw;
        LAS bf16* vt = (LAS bf16*)(lds + L_V) + (dc * 8) * (VPB / 2) + kv;
        vt[0 * (VPB / 2)] = (bf16)(vw.x & 0xffffu); vt[1 * (VPB / 2)] = (bf16)(vw.x >> 16); vt[2 * (VPB / 2)] = (bf16)(vw.y & 0xffffu); vt[3 * (VPB / 2)] = (bf16)(vw.y >> 16);
        vt[4 * (VPB / 2)] = (bf16)(vw.z & 0xffffu); vt[5 * (VPB / 2)] = (bf16)(vw.z >> 16); vt[6 * (VPB / 2)] = (bf16)(vw.w & 0xffffu); vt[7 * (VPB / 2)] = (bf16)(vw.w >> 16); }
    if (tid < 256) { const int n = tid; int bq; if (n < 16) bq = n; else { const float sc = logf((float)n / 16.0f) / 2.0794415416798357f; bq = 16 + (int)(sc * 16.0f); if (bq > 31) bq = 31; }
        ((LAS float*)(lds + L_TB))[256 + n] = relb[bq * 8 + h] * LOG2E; ((LAS float*)(lds + L_TB))[n] = -INFINITY; }
}

template <bool OWN>
__device__ __forceinline__ void tile_attn(const LAS unsigned char* lds, const bf16x8 (&qf)[4], int c, int hi, int w, int relbase, bool nearb, float negmb, float& l_out, f32x16 (&o)[2]) {
    const LAS float* tb = (const LAS float*)(lds + L_TB);
    const float c31 = tb[511];
    f32x16 negm;
#pragma unroll
    for (int r = 0; r < 16; ++r) negm[r] = negmb;
#pragma unroll
    for (int dc = 0; dc < 2; ++dc)
#pragma unroll
        for (int r = 0; r < 16; ++r) o[dc][r] = 0.f;
    float l = 0.f;
    const bool anynear = OWN ? true : (__any(nearb) != 0);
    const int tend = OWN ? w + 1 : 8;
#pragma unroll 1
    for (int t = 0; t < tend; ++t) {
        {
            f32x16 p = negm;
#pragma unroll
            for (int st = 0; st < 4; ++st) { const bf16x8 kf = *(const LAS bf16x8*)(lds + L_K + (32 * t + c) * KPB + st * 32 + hi * 16); p = __builtin_amdgcn_mfma_f32_32x32x16_bf16(kf, qf[st], p, 0, 0, 0); }
            if (OWN) {
                if (t >= w - 4) {
                    int rb = relbase; asm volatile("" : "+v"(rb));
#pragma unroll
                    for (int r = 0; r < 16; ++r) { int idx = rb - (32 * t + crow(r, hi)) + 256; idx = idx > 511 ? 511 : idx; p[r] += tb[idx]; }
                } else {
#pragma unroll
                    for (int r = 0; r < 16; ++r) p[r] += c31;
                }
            } else if (t >= 4 && anynear) {
                int rb = relbase; asm volatile("" : "+v"(rb));
#pragma unroll
                for (int r = 0; r < 16; ++r) { int idx = rb - (32 * t + crow(r, hi)) + 256; idx = idx > 511 ? 511 : idx; p[r] += tb[idx] - c31; }
            }
#pragma unroll
            for (int r = 0; r < 16; ++r) { const float e = __builtin_amdgcn_exp2f(p[r]); l += e; p[r] = e; }
#pragma unroll
            for (int s2 = 0; s2 < 2; ++s2) {
                u32x4 aw; aw.x = cvtpk(p[8 * s2 + 0], p[8 * s2 + 1]); aw.y = cvtpk(p[8 * s2 + 2], p[8 * s2 + 3]); aw.z = cvtpk(p[8 * s2 + 4], p[8 * s2 + 5]); aw.w = cvtpk(p[8 * s2 + 6], p[8 * s2 + 7]);
                const bf16x8 af = __builtin_bit_cast(bf16x8, aw);
#pragma unroll
                for (int dc = 0; dc < 2; ++dc) {
                    const LAS unsigned char* vp = lds + L_V + (32 * dc + c) * VPB + (32 * t + 16 * s2 + 4 * hi) * 2;
                    const u32x2 b0 = *(const LAS u32x2*)vp, b1 = *(const LAS u32x2*)(vp + 16);
                    u32x4 bw; bw.x = b0.x; bw.y = b0.y; bw.z = b1.x; bw.w = b1.y;
                    o[dc] = __builtin_amdgcn_mfma_f32_32x32x16_bf16(af, __builtin_bit_cast(bf16x8, bw), o[dc], 0, 0, 0);
                }
            }
            __builtin_amdgcn_sched_barrier(0);
        }
    }
    l += __shfl_xor(l, 32);
    l_out = l;
}
__device__ __forceinline__ void tile_attn2(const LAS unsigned char* lds, const bf16x8 (&qa)[4], const bf16x8 (&qb)[4], int c, int hi, int relA, int relB, bool anynear, float negA, float negB,
                                           float& lA_out, float& lB_out, f32x16 (&oa)[2], f32x16 (&ob)[2]) {
    const LAS float* tb = (const LAS float*)(lds + L_TB);
    const float c31 = tb[511];
#pragma unroll
    for (int dc = 0; dc < 2; ++dc)
#pragma unroll
        for (int r = 0; r < 16; ++r) { oa[dc][r] = 0.f; ob[dc][r] = 0.f; }
    float lA = 0.f, lB = 0.f;
#pragma unroll 1
    for (int t = 0; t < 8; ++t) {
        f32x16 pa, pb;
#pragma unroll
        for (int r = 0; r < 16; ++r) { pa[r] = negA; pb[r] = negB; }
#pragma unroll
        for (int st = 0; st < 4; ++st) { const bf16x8 kf = *(const LAS bf16x8*)(lds + L_K + (32 * t + c) * KPB + st * 32 + hi * 16);
            pa = __builtin_amdgcn_mfma_f32_32x32x16_bf16(kf, qa[st], pa, 0, 0, 0); pb = __builtin_amdgcn_mfma_f32_32x32x16_bf16(kf, qb[st], pb, 0, 0, 0); }
        if (t >= 4 && anynear) {
            int ra = relA, rb = relB; asm volatile("" : "+v"(ra), "+v"(rb));
#pragma unroll
            for (int r = 0; r < 16; ++r) { int ia = ra - (32 * t + crow(r, hi)) + 256; ia = ia > 511 ? 511 : ia; pa[r] += tb[ia] - c31; if ((r & 7) == 7) __builtin_amdgcn_sched_barrier(0); }
#pragma unroll
            for (int r = 0; r < 16; ++r) { int ib = rb - (32 * t + crow(r, hi)) + 256; ib = ib > 511 ? 511 : ib; pb[r] += tb[ib] - c31; if ((r & 7) == 7) __builtin_amdgcn_sched_barrier(0); }
        }
#pragma unroll
        for (int r = 0; r < 16; ++r) { const float ea = __builtin_amdgcn_exp2f(pa[r]); lA += ea; pa[r] = ea; const float eb = __builtin_amdgcn_exp2f(pb[r]); lB += eb; pb[r] = eb; }
#pragma unroll
        for (int s2 = 0; s2 < 2; ++s2) {
            u32x4 aw; aw.x = cvtpk(pa[8 * s2 + 0], pa[8 * s2 + 1]); aw.y = cvtpk(pa[8 * s2 + 2], pa[8 * s2 + 3]); aw.z = cvtpk(pa[8 * s2 + 4], pa[8 * s2 + 5]); aw.w = cvtpk(pa[8 * s2 + 6], pa[8 * s2 + 7]);
            u32x4 bw2; bw2.x = cvtpk(pb[8 * s2 + 0], pb[8 * s2 + 1]); bw2.y = cvtpk(pb[8 * s2 + 2], pb[8 * s2 + 3]); bw2.z = cvtpk(pb[8 * s2 + 4], pb[8 * s2 + 5]); bw2.w = cvtpk(pb[8 * s2 + 6], pb[8 * s2 + 7]);
            const bf16x8 afa = __builtin_bit_cast(bf16x8, aw), afb = __builtin_bit_cast(bf16x8, bw2);
#pragma unroll
            for (int dc = 0; dc < 2; ++dc) {
                const LAS unsigned char* vp = lds + L_V + (32 * dc + c) * VPB + (32 * t + 16 * s2 + 4 * hi) * 2;
                const u32x2 b0 = *(const LAS u32x2*)vp, b1 = *(const LAS u32x2*)(vp + 16);
                u32x4 bw; bw.x = b0.x; bw.y = b0.y; bw.z = b1.x; bw.w = b1.y;
                const bf16x8 vf = __builtin_bit_cast(bf16x8, bw);
                oa[dc] = __builtin_amdgcn_mfma_f32_32x32x16_bf16(afa, vf, oa[dc], 0, 0, 0); ob[dc] = __builtin_amdgcn_mfma_f32_32x32x16_bf16(afb, vf, ob[dc], 0, 0, 0);
            }
        }
    }
    lA += __shfl_xor(lA, 32); lB += __shfl_xor(lB, 32);
    lA_out = lA; lB_out = lB;
}
__device__ __forceinline__ float shift_bound(const bf16x8 (&qf)[4], float kb) {
    float n2 = 0.f;
#pragma unroll
    for (int st = 0; st < 4; ++st) { const u32x4 w = __builtin_bit_cast(u32x4, qf[st]);
        const float a0 = bflo(w.x), a1 = bfhi(w.x), a2 = bflo(w.y), a3 = bfhi(w.y), a4 = bflo(w.z), a5 = bfhi(w.z), a6 = bflo(w.w), a7 = bfhi(w.w);
        n2 += (a0 * a0 + a1 * a1) + (a2 * a2 + a3 * a3) + (a4 * a4 + a5 * a5) + (a6 * a6 + a7 * a7); }
    n2 += __shfl_xor(n2, 32);
    return sqrtf(n2) * kb;
}
__device__ __forceinline__ float key_norm_bound(const float* kgain, int lane) {
    float g = fabsf(kgain[lane]);
#pragma unroll
    for (int off = 1; off < 64; off <<= 1) g = fmaxf(g, __shfl_xor(g, off));
    return 8.16f * g;
}
}

__device__ __forceinline__ void ph_moba_routed(Frame& F, int l) {
    const int tid = tid_now(), lane = tid & 63, wave = __builtin_amdgcn_readfirstlane(tid >> 6); (void)lane; (void)wave;
    unsigned char* const wsl = opaque(F.ws);
    using namespace moba;
    const bf16* Pa = (const bf16*)(wsl + WS_PA); const unsigned* sel = (const unsigned*)(wsl + WS_SEL);
    bf16* OP = (bf16*)(wsl + WS_OP); float* ML = (float*)(wsl + WS_ML);
    const float* relb = F.inp(1);
    LAS unsigned char* lds = F.lds;
    LAS unsigned short* list = (LAS unsigned short*)(lds + L_LIST);
    LAS unsigned* cnt = (LAS unsigned*)(lds + L_CNT);
    const int c = lane & 31, hi = lane >> 5;
    const float kb = key_norm_bound(F.inp(7) + l * 64, lane);
    SP_T0();
    for (;;) {
        __syncthreads();
        SP_ADD(3);
        if (tid == 0) { cnt[0] = 0u; cnt[1] = __hip_atomic_fetch_add(F.ctl + CW_Q + l, 1u, RLX_AGENT); }
        __syncthreads();
        SP_ADD(0);
        int u = (int)cnt[1];
        if (u >= 31 * 32 * (((REP_MASK >> 6) & 1u) ? 2 : 1)) break;
        u %= 31 * 32;
        const int n = u >> 5, bh = u & 31, b = bh >> 3, h = bh & 7;
        int tl = tid; asm volatile("" : "+v"(tl));
        const unsigned* sp = sel + (size_t)bh * SEQ;
        __builtin_amdgcn_sched_barrier(0);
        unsigned wvs[16];
#pragma unroll
        for (int k = 0; k < 16; ++k) { const int s = (n + 1) * 256 + 512 * k + tid; wvs[k] = (s < SEQ) ? sp[s] : 0u; }
        __builtin_amdgcn_sched_barrier(0);
        stage_kv(lds, Pa, b * SEQ + n * 256, h, relb, tl);
        __builtin_amdgcn_sched_barrier(0);
        { int slots[16]; unsigned tot = 0u;
#pragma unroll
          for (int k = 0; k < 16; ++k) { const unsigned wv = wvs[k]; const int nv = (int)(wv >> 24); int slot = -1;
              if (nv > 0 && (int)(wv & 0xffu) == n) slot = 0; else if (nv > 1 && (int)((wv >> 8) & 0xffu) == n) slot = 1; else if (nv > 2 && (int)((wv >> 16) & 0xffu) == n) slot = 2;
              slots[k] = slot; tot += (unsigned)__popcll(__ballot(slot >= 0)); }
          unsigned base = 0u;
          if (lane == 0 && tot) base = __hip_atomic_fetch_add(&cnt[0], tot, __ATOMIC_RELAXED, __HIP_MEMORY_SCOPE_WORKGROUP);
          base = __shfl(base, 0);
#pragma unroll
          for (int k = 0; k < 16; ++k) { const unsigned long long bal = __ballot(slots[k] >= 0);
              if (slots[k] >= 0) list[base + __popcll(bal & ((1ull << lane) - 1ull))] = (unsigned short)((((n + 1) * 256 + 512 * k + tid) << 2) | slots[k]);
              base += (unsigned)__popcll(bal); } }
        __syncthreads();
        SP_ADD(1);
        const int L = (int)cnt[0];
        const float c31 = ((const LAS float*)(lds + L_TB))[511];
        LAS bf16* ost = (LAS bf16*)(lds + L_OST + wave * 4608);
        bf16x8 qna[4], qnb[4]; unsigned ena = 0u, enb = 0u;
#define LOAD_PAIR(pr) do { int qa_ = (pr) * 64 + c, qb_ = qa_ + 32; qa_ = qa_ < L ? qa_ : L - 1; qb_ = qb_ < L ? qb_ : L - 1; ena = list[qa_]; enb = list[qb_]; \
            const bf16* pa_ = Pa + (size_t)(b * SEQ + (int)(ena >> 2)) * NPA + h * 64 + hi * 8; const bf16* pb_ = Pa + (size_t)(b * SEQ + (int)(enb >> 2)) * NPA + h * 64 + hi * 8; \
            _Pragma("unroll") for (int st = 0; st < 4; ++st) { qna[st] = *(const bf16x8*)(pa_ + st * 16); qnb[st] = *(const bf16x8*)(pb_ + st * 16); } } while (0)
        for (int pr = wave; pr * 64 < L; pr += 8) {
            LOAD_PAIR(pr);
            const unsigned entA = ena, entB = enb;
            bf16x8 qfa[4], qfb[4];
#pragma unroll
            for (int st = 0; st < 4; ++st) { qfa[st] = qna[st]; qfb[st] = qnb[st]; }
            const int sA = (int)(entA >> 2), sB = (int)(entB >> 2);
            const bool anynear = __any(((sA >> 8) == n + 1) || ((sB >> 8) == n + 1)) != 0;
            float lsA, lsB; f32x16 oa[2], ob[2];
            const float mA = shift_bound(qfa, kb), mB = shift_bound(qfb, kb);
            tile_attn2(lds, qfa, qfb, c, hi, sA - n * 256, sB - n * 256, anynear, -mA, -mB, lsA, lsB, oa, ob);
#define ROUTED_EPI(half, ENT, MM, LL, OO) do { const int tile = 2 * pr + (half); const unsigned ent = (ENT); const int s = (int)(ent >> 2), slot = (int)(ent & 3u); \
                const bool valid = tile * 32 + c < L; \
                if (valid && hi == 0) { float* mp = ML + ((size_t)((b * SEQ + s) * 8 + h) * 3 + slot) * 2; mp[0] = (MM) + c31; mp[1] = (LL); } \
                _Pragma("unroll") for (int dc = 0; dc < 2; ++dc) _Pragma("unroll") for (int r = 0; r < 16; ++r) ost[crow(r, hi) * OSP + 32 * dc + c] = (bf16)f2bf(OO[dc][r]); \
                asm volatile("s_waitcnt lgkmcnt(0)" ::: "memory"); \
                { const int q = lane >> 1, hf = lane & 1; int qj = tile * 32 + q; const bool vq = qj < L; qj = vq ? qj : L - 1; \
                  const unsigned e2 = list[qj]; const int s2 = (int)(e2 >> 2), sl2 = (int)(e2 & 3u); \
                  bf16* dst = OP + ((size_t)((b * SEQ + s2) * 8 + h) * 3 + sl2) * 64 + hf * 32; \
                  if (vq) { _Pragma("unroll") for (int i = 0; i < 4; ++i) *(u32x4*)(dst + i * 8) = *(const LAS u32x4*)(ost + q * OSP + hf * 32 + i * 8); } } \
                asm volatile("s_waitcnt lgkmcnt(0)" ::: "memory"); } while (0)
            ROUTED_EPI(0, entA, mA, lsA, oa);
            __builtin_amdgcn_sched_barrier(0);
            ROUTED_EPI(1, entB, mB, lsB, ob);
#undef ROUTED_EPI
        }
#undef LOAD_PAIR
        SP_ADD(2);
    }
}
__device__ __forceinline__ void ph_moba_own(Frame& F, int l) {
    const int tid = tid_now(), lane = tid & 63, wave = __builtin_amdgcn_readfirstlane(tid >> 6); (void)lane; (void)wave;
    unsigned char* const wsl = opaque(F.ws);
    using namespace moba;
    const bf16* Pa = (const bf16*)(wsl + WS_PA); const unsigned* sel = (const unsigned*)(wsl + WS_SEL);
    const bf16* OP = (const bf16*)(wsl + WS_OP); const float* ML = (const float*)(wsl + WS_ML); bf16* Y = (bf16*)(wsl + WS_Y);
    const float* relb = F.inp(1);
    LAS unsigned char* lds = F.lds;
    const int c = lane & 31, hi = lane >> 5;
    const float kb = key_norm_bound(F.inp(7) + l * 64, lane);
    for (int u = blockIdx.x; u < 1024; u += F.G) {
        const int bh = u >> 5, qb = u & 31, b = bh >> 3, h = bh & 7;
        const int s = qb * 256 + wave * 32 + c;
        const bf16* qp = Pa + (size_t)(b * SEQ + s) * NPA + h * 64 + hi * 8;
        bf16x8 qf[4];
#pragma unroll
        for (int st = 0; st < 4; ++st) qf[st] = *(const bf16x8*)(qp + st * 16);
        const unsigned wv = sel[(size_t)bh * SEQ + s]; const int nv = (int)(wv >> 24);
        float msr[3], lsr[3];
#pragma unroll
        for (int j = 0; j < 3; ++j) { const float* mp = ML + ((size_t)((b * SEQ + s) * 8 + h) * 3 + j) * 2; msr[j] = mp[0]; lsr[j] = mp[1]; }
        __syncthreads();
        { int tl = tid; asm volatile("" : "+v"(tl)); stage_kv(lds, Pa, b * SEQ + qb * 256, h, relb, tl); }
        __syncthreads();
        u32x4 opw[2][3];
#pragma unroll
        for (int it = 0; it < 2; ++it) { const int q = it * 8 + (lane >> 3), ch = lane & 7, sq = qb * 256 + wave * 32 + q;
            const bf16* pp = OP + ((size_t)((b * SEQ + sq) * 8 + h) * 3) * 64 + ch * 8;
#pragma unroll
            for (int j = 0; j < 3; ++j) opw[it][j] = *(const u32x4*)(pp + j * 64); }
        float ls; f32x16 o[2];
        int relb_own = wave * 32 + c; asm volatile("" : "+v"(relb_own));
        const float m = shift_bound(qf, kb);
        tile_attn<true>(lds, qf, c, hi, wave, relb_own, true, -m, ls, o);
        asm volatile("" ::: "memory");
        float ms[3], lsv[3]; float M = m;
#pragma unroll
        for (int j = 0; j < 3; ++j) { ms[j] = (j < nv) ? msr[j] : -INFINITY; lsv[j] = (j < nv) ? lsr[j] : 0.f; M = fmaxf(M, ms[j]); }
        u32x4 opw2[2][3];
#pragma unroll
        for (int it = 2; it < 4; ++it) { const int q = it * 8 + (lane >> 3), ch = lane & 7, sq = qb * 256 + wave * 32 + q;
            const bf16* pp = OP + ((size_t)((b * SEQ + sq) * 8 + h) * 3) * 64 + ch * 8;
#pragma unroll
            for (int j = 0; j < 3; ++j) opw2[it - 2][j] = *(const u32x4*)(pp + j * 64); }
        const float a_own = __builtin_amdgcn_exp2f(m - M); float a[3]; float Ls = a_own * ls;
#pragma unroll
        for (int j = 0; j < 3; ++j) { a[j] = (j < nv) ? __builtin_amdgcn_exp2f(ms[j] - M) : 0.f; Ls += a[j] * lsv[j]; }
        const float inv = Ls > 0.f ? 1.f / Ls : 0.f;
        __syncthreads();
        LAS float* fsc = (LAS float*)(lds + L_WS + wave * 512);
        if (hi == 0) { *(LAS f32x4*)(fsc + c * 4) = (f32x4){a_own * inv, a[0] * inv, a[1] * inv, a[2] * inv}; }
        LAS float* of = (LAS float*)(lds + wave * (32 * OFP * 4));
#pragma unroll
        for (int dc = 0; dc < 2; ++dc)
#pragma unroll
            for (int r = 0; r < 16; ++r) of[crow(r, hi) * OFP + 32 * dc + c] = o[dc][r];
        asm volatile("s_waitcnt lgkmcnt(0)" ::: "memory");
#pragma unroll
        for (int it = 0; it < 4; ++it) {
            const int q = it * 8 + (lane >> 3), ch = lane & 7, sq = qb * 256 + wave * 32 + q;
            const f32x4 f = *(const LAS f32x4*)(fsc + q * 4);
            const f32x4 o0 = *(const LAS f32x4*)(of + q * OFP + ch * 8), o1 = *(const LAS f32x4*)(of + q * OFP + ch * 8 + 4);
            float v[8] = {o0.x * f.x, o0.y * f.x, o0.z * f.x, o0.w * f.x, o1.x * f.x, o1.y * f.x, o1.z * f.x, o1.w * f.x};
#pragma unroll
            for (int j = 0; j < 3; ++j) { const float fj = f[1 + j]; float t8[8]; unpack8(it < 2 ? opw[it & 1][j] : opw2[it & 1][j], t8);
#pragma unroll
                for (int e = 0; e < 8; ++e) v[e] += (fj != 0.f) ? fj * t8[e] : 0.f; }
            *(u32x4*)(Y + (size_t)(b * SEQ + sq) * NYC + 512 + h * 64 + ch * 8) = pack8(v);
        }
    }
}

namespace gla {
typedef float f32x16 __attribute__((ext_vector_type(16)));
constexpr int G_ZS = 0, G_WA = 4096, G_BA = 20480, G_GS = 21504, G_QE = 24576, G_KE = 43008, G_VT = 61440, G_RED = 98304;
constexpr int PB = 144;
__device__ __forceinline__ int crow(int r, int hi) { return (r & 3) + 8 * (r >> 2) + 4 * hi; }
__device__ __forceinline__ unsigned cvtpk(float lo, float hi) { typedef float f32x2_c __attribute__((ext_vector_type(2))); typedef __bf16 bf16x2_c __attribute__((ext_vector_type(2))); const f32x2_c v = {lo, hi}; const bf16x2_c b = __builtin_convertvector(v, bf16x2_c); return __builtin_bit_cast(unsigned, b); }
__device__ __forceinline__ void load_alpha(Frame& F, LAS unsigned char* lds, int l, int tid) {
    LAS float* wa = (LAS float*)(lds + G_WA); LAS float* ba = (LAS float*)(lds + G_BA);
    const float* wal = F.inp(8) + (size_t)l * 16 * 256; const float* bal = F.inp(9) + l * 256;
    for (int i = tid; i < 4096; i += 512) { const int h = i >> 10, rr = (i >> 6) & 15, dd = i & 63; wa[i] = wal[rr * 256 + h * 64 + dd]; }
    if (tid < 256) ba[tid] = bal[tid];
}
__device__ __forceinline__ float gates(LAS unsigned char* lds, int hp, int tid, float (&bc)[16]) {
    const LAS float* zs = (const LAS float*)(lds + G_ZS); const LAS float* wa = (const LAS float*)(lds + G_WA) + (2 * hp) * 1024; const LAS float* ba = (const LAS float*)(lds + G_BA) + (2 * hp) * 64; LAS float* gs = (LAS float*)(lds + G_GS);
    const int hh = tid >> 8, jg = (tid >> 6) & 3, d = tid & 63;
    float run = 0.f;
#pragma unroll
    for (int jj = 0; jj < 16; ++jj) { const int j = 16 * jg + jj; float x = ba[hh * 64 + d];
#pragma unroll
        for (int rr = 0; rr < 16; ++rr) x += zs[j * 16 + rr] * wa[(hh * 16 + rr) * 64 + d];
        const float ls = fminf(x, 0.f) - __logf(1.f + __expf(-fabsf(x)));
        run += ls * (1.f / 16.f); bc[jj] = run; }
    gs[(hh * 4 + jg) * 64 + d] = run;
    __syncthreads();
    float off = 0.f, tot = 0.f;
#pragma unroll
    for (int g = 0; g < 4; ++g) { const float v = gs[(hh * 4 + g) * 64 + d]; tot += v; off += (g < jg) ? v : 0.f; }
#pragma unroll
    for (int jj = 0; jj < 16; ++jj) bc[jj] += off;
    return tot;
}
__device__ __forceinline__ void load_v(const bf16* Pg, int r0, int hp, int tid, u32x4 (&vw)[4]) {
#pragma unroll
    for (int i = 0; i < 4; ++i) { const int id = tid + 512 * i, j = id >> 5, vc = id & 31; vw[i] = *(const u32x4*)(Pg + (size_t)(r0 + j) * NPG + 512 + hp * 256 + vc * 8); }
}
__device__ __forceinline__ void store_vt(LAS unsigned char* lds, int tid, const u32x4 (&vw)[4]) {
#pragma unroll
    for (int i = 0; i < 4; ++i) { const int id = tid + 512 * i, j = id >> 5, vc = id & 31;
        LAS bf16* vt = (LAS bf16*)(lds + G_VT) + (vc * 8) * (PB / 2) + j;
        vt[0 * (PB / 2)] = (bf16)(vw[i].x & 0xffffu); vt[1 * (PB / 2)] = (bf16)(vw[i].x >> 16); vt[2 * (PB / 2)] = (bf16)(vw[i].y & 0xffffu); vt[3 * (PB / 2)] = (bf16)(vw[i].y >> 16);
        vt[4 * (PB / 2)] = (bf16)(vw[i].z & 0xffffu); vt[5 * (PB / 2)] = (bf16)(vw[i].z >> 16); vt[6 * (PB / 2)] = (bf16)(vw[i].w & 0xffffu); vt[7 * (PB / 2)] = (bf16)(vw[i].w >> 16); }
}
}

__device__ __forceinline__ void ph_gla_kv(Frame& F, int l) {
    using namespace gla;
    const int tid = tid_now(), lane = tid & 63, wave = __builtin_amdgcn_readfirstlane(tid >> 6); (void)lane; (void)wave;
    unsigned char* const wsl = opaque(F.ws);
    const bf16* Pg = (const bf16*)(wsl + WS_PG); bf16* GK = (bf16*)(wsl + WS_GLA); float* DEC = (float*)(wsl + WS_DEC);
    LAS unsigned char* lds = F.lds;
    const int c = lane & 31, hi = lane >> 5;
    const int hh = tid >> 8, jg = (tid >> 6) & 3, d = tid & 63;
    load_alpha(F, lds, l, tid);
    for (int unit = blockIdx.x; unit < 1024; unit += F.G) {
        const int hp = unit & 1, cg = unit >> 1, b = cg >> 7, ch = cg & 127, r0 = b * SEQ + ch * 64;
        float zr[2]; bf16 kr[16]; u32x4 vw[4];
#pragma unroll
        for (int i = 0; i < 2; ++i) zr[i] = ((const float*)(wsl + WS_ZB))[(size_t)r0 * 16 + tid + 512 * i];
#pragma unroll
        for (int jj = 0; jj < 16; ++jj) kr[jj] = Pg[(size_t)(r0 + 16 * jg + jj) * NPG + 256 + (2 * hp + hh) * 64 + d];
        load_v(Pg, r0, hp, tid, vw);
        __syncthreads();
#pragma unroll
        for (int i = 0; i < 2; ++i) ((LAS float*)(lds + G_ZS))[tid + 512 * i] = zr[i];
        __syncthreads();
        float bc[16];
        const float bt = gates(lds, hp, tid, bc);
        { float kd[16];
#pragma unroll
          for (int jj = 0; jj < 16; ++jj) kd[jj] = bf1(kr[jj]) * __expf(bt - bc[jj]);
          LAS unsigned char* dst = lds + G_QE + (hh * 64 + d) * PB + jg * 32;
          u32x4 w0, w1; w0.x = pk2(kd[0], kd[1]); w0.y = pk2(kd[2], kd[3]); w0.z = pk2(kd[4], kd[5]); w0.w = pk2(kd[6], kd[7]);
          w1.x = pk2(kd[8], kd[9]); w1.y = pk2(kd[10], kd[11]); w1.z = pk2(kd[12], kd[13]); w1.w = pk2(kd[14], kd[15]);
          *(LAS u32x4*)dst = w0; *(LAS u32x4*)(dst + 16) = w1; }
        if (jg == 0) DEC[((size_t)((b * 4 + 2 * hp + hh) * 128 + ch)) * 64 + d] = __expf(bt);
        store_vt(lds, tid, vw);
        __syncthreads();
        { const int h2 = wave >> 2, vt = wave & 3;
          f32x16 acc[2];
#pragma unroll
          for (int dt = 0; dt < 2; ++dt)
#pragma unroll
              for (int r = 0; r < 16; ++r) acc[dt][r] = 0.f;
#pragma unroll
          for (int ks = 0; ks < 4; ++ks) {
              const bf16x8 af = *(const LAS bf16x8*)(lds + G_VT + (h2 * 128 + 32 * vt + c) * PB + ks * 32 + hi * 16);
#pragma unroll
              for (int dt = 0; dt < 2; ++dt) { const bf16x8 bfv = *(const LAS bf16x8*)(lds + G_QE + (h2 * 64 + 32 * dt + c) * PB + ks * 32 + hi * 16);
                  acc[dt] = __builtin_amdgcn_mfma_f32_32x32x16_bf16(af, bfv, acc[dt], 0, 0, 0); } }
          bf16* o = GK + ((size_t)((b * 4 + 2 * hp + h2) * 128 + ch)) * 8192;
#pragma unroll
          for (int dt = 0; dt < 2; ++dt)
#pragma unroll
              for (int r = 0; r < 16; ++r) o[(32 * vt + crow(r, hi)) * 64 + 32 * dt + c] = (bf16)f2bf(acc[dt][r]); }
    }
}
__device__ __forceinline__ void ph_gla_out(Frame& F, int l) {
    using namespace gla;
    const int tid = tid_now(), lane = tid & 63, wave = __builtin_amdgcn_readfirstlane(tid >> 6); (void)lane; (void)wave;
    unsigned char* const wsl = opaque(F.ws);
    const bf16* Pg = (const bf16*)(wsl + WS_PG); const bf16* GK = (const bf16*)(wsl + WS_GLA); bf16* Y = (bf16*)(wsl + WS_Y);
    LAS unsigned char* lds = F.lds;
    const int c = lane & 31, hi = lane >> 5;
    const int hh = tid >> 8, jg = (tid >> 6) & 3, d = tid & 63;
    const int h2 = wave >> 2, it = (wave >> 1) & 1, vh = wave & 1;
    const float* gnp = F.inp(10) + l * 128;
    load_alpha(F, lds, l, tid);
    for (int unit = blockIdx.x; unit < 1024; unit += F.G) {
        const int hp = unit & 1, cg = unit >> 1, b = cg >> 7, ch = cg & 127, r0 = b * SEQ + ch * 64, h = 2 * hp + h2;
        const size_t row = (size_t)(r0 + 32 * it + c);
        float zr[2]; bf16 qr[16], kr[16]; u32x4 vw[4]; bf16x8 spf[2][4]; u32x2 rw[2][4];
#pragma unroll
        for (int i = 0; i < 2; ++i) zr[i] = ((const float*)(wsl + WS_ZB))[(size_t)r0 * 16 + tid + 512 * i];
#pragma unroll
        for (int jj = 0; jj < 16; ++jj) { const bf16* p = Pg + (size_t)(r0 + 16 * jg + jj) * NPG + (2 * hp + hh) * 64 + d; qr[jj] = p[0]; kr[jj] = p[256]; }
        load_v(Pg, r0, hp, tid, vw);
        { const bf16* sp = GK + ((size_t)((b * 4 + h) * 128 + ch)) * 8192;
#pragma unroll
          for (int v2 = 0; v2 < 2; ++v2)
#pragma unroll
              for (int ks = 0; ks < 4; ++ks) spf[v2][ks] = *(const bf16x8*)(sp + (size_t)(32 * (2 * vh + v2) + c) * 64 + ks * 16 + hi * 8); }
#pragma unroll
        for (int v2 = 0; v2 < 2; ++v2)
#pragma unroll
            for (int g = 0; g < 4; ++g) rw[v2][g] = *(const u32x2*)(Pg + row * NPG + 1024 + h * 128 + 32 * (2 * vh + v2) + 8 * g + 4 * hi);
        __syncthreads();
#pragma unroll
        for (int i = 0; i < 2; ++i) ((LAS float*)(lds + G_ZS))[tid + 512 * i] = zr[i];
        __syncthreads();
        float bc[16];
        (void)gates(lds, hp, tid, bc);
#pragma unroll
        for (int jj = 0; jj < 16; ++jj) { const int j = 16 * jg + jj;
            ((LAS bf16*)(lds + G_QE))[(hh * 64 + j) * (PB / 2) + d] = (bf16)f2bf(bf1(qr[jj]) * 0.125f * __expf(bc[jj]));
            ((LAS bf16*)(lds + G_KE))[(hh * 64 + j) * (PB / 2) + d] = (bf16)f2bf(bf1(kr[jj]) * __expf(-bc[jj])); }
        store_vt(lds, tid, vw);
        __syncthreads();
        f32x16 X[2];
#pragma unroll
        for (int jt = 0; jt < 2; ++jt) {
#pragma unroll
            for (int r = 0; r < 16; ++r) X[jt][r] = 0.f;
            if (jt <= it) {
#pragma unroll
                for (int ks = 0; ks < 4; ++ks) {
                    const bf16x8 af = *(const LAS bf16x8*)(lds + G_KE + (h2 * 64 + 32 * jt + c) * PB + ks * 32 + hi * 16);
                    const bf16x8 bfv = *(const LAS bf16x8*)(lds + G_QE + (h2 * 64 + 32 * it + c) * PB + ks * 32 + hi * 16);
                    X[jt] = __builtin_amdgcn_mfma_f32_32x32x16_bf16(af, bfv, X[jt], 0, 0, 0); }
                if (jt == it) {
#pragma unroll
                    for (int r = 0; r < 16; ++r) X[jt][r] = (crow(r, hi) > c) ? 0.f : X[jt][r]; }
            }
        }
        f32x16 acc[2];
#pragma unroll
        for (int v2 = 0; v2 < 2; ++v2) {
            const int vrow = h2 * 128 + 32 * (2 * vh + v2) + c;
#pragma unroll
            for (int r = 0; r < 16; ++r) acc[v2][r] = 0.f;
#pragma unroll
            for (int ks = 0; ks < 4; ++ks) {
                const bf16x8 bfv = *(const LAS bf16x8*)(lds + G_QE + (h2 * 64 + 32 * it + c) * PB + ks * 32 + hi * 16);
                acc[v2] = __builtin_amdgcn_mfma_f32_32x32x16_bf16(spf[v2][ks], bfv, acc[v2], 0, 0, 0); }
#pragma unroll
            for (int jt = 0; jt < 2; ++jt) if (jt <= it) {
#pragma unroll
                for (int s2 = 0; s2 < 2; ++s2) {
                    u32x4 xw; xw.x = cvtpk(X[jt][8 * s2 + 0], X[jt][8 * s2 + 1]); xw.y = cvtpk(X[jt][8 * s2 + 2], X[jt][8 * s2 + 3]); xw.z = cvtpk(X[jt][8 * s2 + 4], X[jt][8 * s2 + 5]); xw.w = cvtpk(X[jt][8 * s2 + 6], X[jt][8 * s2 + 7]);
                    const LAS unsigned char* vp = lds + G_VT + vrow * PB + (32 * jt + 16 * s2 + 4 * hi) * 2;
                    const u32x2 a0 = *(const LAS u32x2*)vp, a1 = *(const LAS u32x2*)(vp + 16);
                    u32x4 aw; aw.x = a0.x; aw.y = a0.y; aw.z = a1.x; aw.w = a1.y;
                    acc[v2] = __builtin_amdgcn_mfma_f32_32x32x16_bf16(__builtin_bit_cast(bf16x8, aw), __builtin_bit_cast(bf16x8, xw), acc[v2], 0, 0, 0); } }
        }
        f32x4 gnv[2][4];
#pragma unroll
        for (int v2 = 0; v2 < 2; ++v2)
#pragma unroll
            for (int g = 0; g < 4; ++g) gnv[v2][g] = *(const f32x4*)(gnp + 32 * (2 * vh + v2) + 8 * g + 4 * hi);
        float ss = 0.f;
#pragma unroll
        for (int v2 = 0; v2 < 2; ++v2)
#pragma unroll
            for (int r = 0; r < 16; ++r) ss += acc[v2][r] * acc[v2][r];
        ss += __shfl_xor(ss, 32);
        LAS float* red = (LAS float*)(lds + G_RED);
        if (hi == 0) red[wave * 32 + c] = ss;
        __syncthreads();
        const float rs = rsqrtf((ss + red[(wave ^ 1) * 32 + c]) * (1.f / 128.f) + RMS_EPS);
#pragma unroll
        for (int v2 = 0; v2 < 2; ++v2)
#pragma unroll
            for (int g = 0; g < 4; ++g) { const int v0 = 32 * (2 * vh + v2) + 8 * g + 4 * hi;
                const f32x4 gn = gnv[v2][g];
                const float r0f = bflo(rw[v2][g].x), r1f = bfhi(rw[v2][g].x), r2f = bflo(rw[v2][g].y), r3f = bfhi(rw[v2][g].y);
                u32x2 ow; ow.x = pk2(acc[v2][4 * g + 0] * rs * gn.x * (r0f * sigmoidf_(r0f)), acc[v2][4 * g + 1] * rs * gn.y * (r1f * sigmoidf_(r1f)));
                ow.y = pk2(acc[v2][4 * g + 2] * rs * gn.z * (r2f * sigmoidf_(r2f)), acc[v2][4 * g + 3] * rs * gn.w * (r3f * sigmoidf_(r3f)));
                *(u32x2*)(Y + row * NYC + 1024 + h * 128 + v0) = ow; }
    }
}
__device__ __forceinline__ void ph_norm_router(Frame& F, int l, bool probe = false) {
    const int tid = tid_now(), lane = tid & 63, wave = __builtin_amdgcn_readfirstlane(tid >> 6); (void)lane; (void)wave;
    unsigned char* const wsl = opaque(F.ws);
    const float* gain = F.inp(14) + (size_t)l * 1024; bf16* H = (bf16*)(wsl + WS_H);
    const float* brg = F.inp(16) + l * 4; const float* bre = F.inp(18) + l * 32;
    const bf16* WRh = (const bf16*)(wsl + WS_WR) + (size_t)(l * 2) * 48 * 1024; const bf16* WRl = WRh + 48 * 1024;
    int* toke = (int*)(wsl + WS_TOKE); float* tokw = (float*)(wsl + WS_TOKW);
    LAS unsigned* hist = (LAS unsigned*)(F.lds + LTAB_OFF);
    if (tid < 32) hist[tid] = 0u;
    __syncthreads();
    const int t = lane & 15, kg = lane >> 4;
    for (int tile = blockIdx.x * 8 + wave; tile < T_ / 16; tile += F.G * 8) {
        const int m = tile * 16 + t;
        const float* xr = F.out + (size_t)m * 1024 + kg * 8;
        float ss = 0.f;
        f32x4 acc[3];
#pragma unroll
        for (int nt = 0; nt < 3; ++nt) acc[nt] = (f32x4){0.f, 0.f, 0.f, 0.f};
        bf16* hr = H + (size_t)m * 1024 + kg * 8;
        const bf16* wh = WRh + (size_t)t * 1024 + kg * 8; const bf16* wl = WRl + (size_t)t * 1024 + kg * 8;
        for (int k0 = 0; k0 < 32; k0 += 8) {
            f32x4 xa[8], xb[8];
#pragma unroll
            for (int q = 0; q < 8; ++q) { xa[q] = *(const f32x4*)(xr + 32 * (k0 + q)); xb[q] = *(const f32x4*)(xr + 32 * (k0 + q) + 4); }
            u32x4 hws[8];
#pragma unroll
            for (int q = 0; q < 8; ++q) { const int ks = k0 + q;
                const f32x4 a = xa[q], b = xb[q];
                const f32x4 ga = *(const f32x4*)(gain + 32 * ks + kg * 8), gb = *(const f32x4*)(gain + 32 * ks + kg * 8 + 4);
                ss += (a.x * a.x + a.y * a.y) + (a.z * a.z + a.w * a.w) + (b.x * b.x + b.y * b.y) + (b.z * b.z + b.w * b.w);
                float xn[8] = {a.x * ga.x, a.y * ga.y, a.z * ga.z, a.w * ga.w, b.x * gb.x, b.y * gb.y, b.z * gb.z, b.w * gb.w};
                u32x4 hw, lw;
                hw.x = pk2(xn[0], xn[1]); hw.y = pk2(xn[2], xn[3]); hw.z = pk2(xn[4], xn[5]); hw.w = pk2(xn[6], xn[7]);
                lw.x = pk2(xn[0] - bflo(hw.x), xn[1] - bfhi(hw.x)); lw.y = pk2(xn[2] - bflo(hw.y), xn[3] - bfhi(hw.y)); lw.z = pk2(xn[4] - bflo(hw.z), xn[5] - bfhi(hw.z)); lw.w = pk2(xn[6] - bflo(hw.w), xn[7] - bfhi(hw.w));
                hws[q] = hw;
                const bf16x8 xh = __builtin_bit_cast(bf16x8, hw), xl = __builtin_bit_cast(bf16x8, lw);
#pragma unroll
                for (int nt = 0; nt < 3; ++nt) {
                    const bf16x8 ah = *(const bf16x8*)(wh + (size_t)nt * 16 * 1024 + 32 * ks), al = *(const bf16x8*)(wl + (size_t)nt * 16 * 1024 + 32 * ks);
                    acc[nt] = __builtin_amdgcn_mfma_f32_16x16x32_bf16(ah, xh, acc[nt], 0, 0, 0);
                    acc[nt] = __builtin_amdgcn_mfma_f32_16x16x32_bf16(ah, xl, acc[nt], 0, 0, 0);
                    acc[nt] = __builtin_amdgcn_mfma_f32_16x16x32_bf16(al, xh, acc[nt], 0, 0, 0); }
            }
#pragma unroll
            for (int q = 0; q < 8; ++q) *(u32x4*)(hr + 32 * (k0 + q)) = hws[q];
        }
        ss += __shfl_xor(ss, 16); ss += __shfl_xor(ss, 32);
        const float rs = rsqrtf(ss * (1.f / 1024.f) + RMS_EPS);
#pragma unroll
        for (int nt = 0; nt < 3; ++nt) acc[nt] = acc[nt] * rs;
        if (kg == 0) ((float*)(wsl + WS_TOKRS))[m] = rs;
        float lg[4];
#pragma unroll
        for (int i = 0; i < 4; ++i) lg[i] = __shfl(acc[2][i], t) + brg[i];
        int grp = 0; float gm = lg[0];
#pragma unroll
        for (int i = 1; i < 4; ++i) if (lg[i] > gm) { gm = lg[i]; grp = i; }
        float gs = 0.f;
#pragma unroll
        for (int i = 0; i < 4; ++i) gs += __expf(lg[i] - gm);
        const float pgt = 1.f / gs;
        const int src0 = t + 32 * (grp & 1), src1 = src0 + 16;
        float le[8];
#pragma unroll
        for (int i = 0; i < 4; ++i) { const float a0 = __shfl(acc[0][i], src0), a1 = __shfl(acc[0][i], src1), b0 = __shfl(acc[1][i], src0), b1 = __shfl(acc[1][i], src1);
            le[i] = ((grp >> 1) ? b0 : a0) + bre[grp * 8 + i]; le[4 + i] = ((grp >> 1) ? b1 : a1) + bre[grp * 8 + 4 + i]; }
        int e0 = 0; float t0 = le[0];
#pragma unroll
        for (int i = 1; i < 8; ++i) if (le[i] > t0) { t0 = le[i]; e0 = i; }
        int e1 = -1; float t1 = -INFINITY;
#pragma unroll
        for (int i = 0; i < 8; ++i) if (i != e0 && le[i] > t1) { t1 = le[i]; e1 = i; }
        const float tt = __expf(t1 - t0), w0 = pgt / (1.f + tt), w1 = pgt * tt / (1.f + tt);
        if (kg == 0) { toke[2 * m] = grp * 8 + e0; toke[2 * m + 1] = grp * 8 + e1; tokw[2 * m] = w0; tokw[2 * m + 1] = w1;
            (void)__hip_atomic_fetch_add(&hist[grp * 8 + e0], 1u, __ATOMIC_RELAXED, __HIP_MEMORY_SCOPE_WORKGROUP); (void)__hip_atomic_fetch_add(&hist[grp * 8 + e1], 1u, __ATOMIC_RELAXED, __HIP_MEMORY_SCOPE_WORKGROUP); }
    }
    __syncthreads();
    if (tid < 32) ((int*)(wsl + WS_HIST))[blockIdx.x * 32 + tid] = (int)hist[tid];
    __syncthreads();
}
__device__ __forceinline__ void ph_dispatch(Frame& F, int l, bool probe = false) {
    const int tid = tid_now(), lane = tid & 63, wave = __builtin_amdgcn_readfirstlane(tid >> 6); (void)lane; (void)wave;
    unsigned char* const wsl = opaque(F.ws);
    LAS int* pstart = (LAS int*)(F.lds + LTAB_OFF); LAS int* cnt = pstart + 32; LAS unsigned* lhist = (LAS unsigned*)(cnt + 32); LAS int* lbase = (LAS int*)(lhist + 32);
    LAS int* rowof = lbase + 32;
        const int* toke = (const int*)(wsl + WS_TOKE); const float* tokw = (const float*)(wsl + WS_TOKW);
    int* toks = (int*)(wsl + WS_TOKS); float* roww = (float*)(wsl + WS_ROWW); int* blke = (int*)(wsl + WS_BLKE);
    const bf16* H = (const bf16*)(wsl + WS_H); bf16* xs = (bf16*)(wsl + WS_XS);
    LAS int* part = rowof + 260;
    LAS int* wcnt = part + 1024;
    { const int e = tid & 31, g = tid >> 5; const int* hs = (const int*)(wsl + WS_HIST); int sa = 0, sb = 0; int hv[16];
#pragma unroll
      for (int q = 0; q < 16; ++q) hv[q] = hs[(g * 16 + q) * 32 + e];
#pragma unroll
      for (int q = 0; q < 16; ++q) { sa += hv[q]; sb += (g * 16 + q < (int)blockIdx.x) ? hv[q] : 0; }
      part[g * 32 + e] = sa; part[512 + g * 32 + e] = sb; }
    __syncthreads();
    if (tid < 32) { int sa = 0, sb = 0;
#pragma unroll
        for (int g = 0; g < 16; ++g) { sa += part[g * 32 + tid]; sb += part[512 + g * 32 + tid]; }
        cnt[tid] = sa; lbase[tid] = sb; lhist[tid] = 0u; }
    __syncthreads();
    if (tid == 0) { int a = 0; for (int e = 0; e < 32; ++e) { pstart[e] = a; a += ((cnt[e] + 255) >> 8) << 8; } pstart[32 + 32 + 32 + 32 + 256] = a; }
    __syncthreads();
    const int total = pstart[32 + 32 + 32 + 32 + 256];
    if (blockIdx.x == 0) {
        for (int rb = tid; rb < 288; rb += 512) { int e = 31; for (int k = 31; k >= 0; --k) if (rb * 256 < pstart[k] + (((cnt[k] + 255) >> 8) << 8)) e = k; blke[rb] = e; }
        if (tid == 0) blke[300] = total >> 8;
    }
    int* rowtok = (int*)(wsl + WS_ROWTOK);
    for (int e = blockIdx.x; e < 32; e += F.G) {
        const int p0 = pstart[e] + cnt[e], p1 = pstart[e] + (((cnt[e] + 255) >> 8) << 8);
        for (int rr = p0 + tid; rr < p1; rr += 512) { roww[rr] = 0.f; rowtok[rr] = 0; }
    }
    const int tpw = T_ / F.G, t0 = blockIdx.x * tpw;
    int myexp = -1, myrank = 0;
    if (tid < 2 * tpw) myexp = toke[2 * t0 + tid];
    if (wave < 4) {
        for (int e = 0; e < 32; ++e) { const unsigned long long bal = __ballot(myexp == e);
            if (myexp == e) myrank = __popcll(bal & ((1ull << lane) - 1ull));
            if (lane == 0) wcnt[wave * 32 + e] = __popcll(bal); } }
    __syncthreads();
    if (tid < 2 * tpw) { for (int w2 = 0; w2 < wave; ++w2) myrank += wcnt[w2 * 32 + myexp]; }
    if (tid < 2 * tpw) { const int row = pstart[myexp] + lbase[myexp] + myrank; rowof[tid] = row; toks[2 * t0 + tid] = row; roww[row] = ((const float*)(wsl + WS_TOKRS))[t0 + (tid >> 1)]; rowtok[row] = t0 + (tid >> 1); }
    __syncthreads();
    __syncthreads();
}

struct Args { const float* in[22]; float* out; unsigned char* ws; int ph_lo, ph_hi; };
constexpr int NPH = 13;

__global__ void __launch_bounds__(512, 2) fwd_kernel(Args args) {
    extern __shared__ __attribute__((aligned(16))) unsigned char lds_raw[];
    Frame F;
    (void)lds_raw;
    F.lds = (LAS unsigned char*)(unsigned)LDS_BASE;
    F.MISC = (volatile LAS unsigned*)(F.lds + MISC_OFF);
    F.tid = threadIdx.x; F.lane = F.tid & 63; F.wave = __builtin_amdgcn_readfirstlane(F.tid >> 6);
    F.out = args.out; F.ws = args.ws; F.ctl = (unsigned*)(args.ws + WS_CTL);
    for (int u = F.tid; u < (LDS_BYTES - LDSCTL_OFF) / 4; u += 512) ((LAS unsigned*)(F.lds + LDSCTL_OFF))[u] = 0u;
    __syncthreads();
    if (F.tid < 22) ((LAS unsigned long long*)(F.lds + PTAB_OFF))[F.tid] = (unsigned long long)args.in[F.tid];
    __syncthreads();
    constexpr int lo = 0, hi = 2 * NPH + 1;
    const bool use_bar = (hi - lo) > 1;
    XcdBarrier bar; bar.bar = F.ctl + CW_BAR; bar.x = 0; bar.st = nullptr;
    if (use_bar) bar = xcd_barrier_post(F.ctl + CW_BAR, F.MISC + 8);
#define IN(k) (lo <= (k) && (k) < hi)
#define SEAM(k) do { if ((PROBE_A >= 0 || PROBE_B >= 0) && tid_now() == 0) { const unsigned long long now_ = __builtin_amdgcn_s_memrealtime(); if (blockIdx.x == PROBE_BLK) ((LAS unsigned long long*)(F.lds + LTAB_OFF + 4096 + 256))[n_stamp] = now_; (void)__hip_atomic_fetch_max((unsigned long long*)(F.ctl + CW_ARR) + n_stamp, now_, __ATOMIC_RELAXED, __HIP_MEMORY_SCOPE_AGENT); } if (IN(k) && IN((k) + 1)) xcd_barrier(bar); if ((PROBE_A >= 0 || PROBE_B >= 0) && blockIdx.x == PROBE_BLK && tid_now() == 0) { ((LAS unsigned long long*)(F.lds + LTAB_OFF + 4096))[n_stamp] = __builtin_amdgcn_s_memrealtime(); } ++n_stamp; } while (0)
    int n_stamp = 1;
    if ((PROBE_A >= 0 || PROBE_B >= 0) && blockIdx.x == PROBE_BLK && tid_now() == 0) ((LAS unsigned long long*)(F.lds + LTAB_OFF + 4096))[0] = __builtin_amdgcn_s_memrealtime();
    for (int l = 0; l < DEPTH; ++l) {
        const int pb = l * NPH;
#define WSL unsigned char* const ws = opaque(F.ws); unsigned char* const wmix = ws + WS_WMIX + (size_t)l * WMIX_LAYER; (void)wmix
        if (IN(pb + 0)) { WSL;
            if (l == 0) { RUN(0, ph_convert_mixer(F)); __syncthreads(); PM(11) ph_norm<false, true>(F, F.inp(0), F.inp(2), (bf16*)(ws + WS_H)); }
            else PM(12) ph_norm<true, true>(F, F.out, F.inp(2) + 1024, (bf16*)(ws + WS_H));
            ph_gla_z(F, l);
        }
        SEAM(pb + 0);
        if (IN(pb + 1)) { WSL;
            LAS float* gtab = (LAS float*)(F.lds + LTAB_OFF);
            if (tid_now() < 128) gtab[tid_now()] = (tid_now() < 64) ? F.inp(6)[l * 64 + tid_now()] * QSCALE : F.inp(7)[l * 64 + tid_now() - 64];
            __syncthreads();
            pg8::SchedPlain S{(const char*)(ws + WS_H), (const char*)(wmix + WO_WIN), 128, 18, F.G, (int)blockIdx.x, (size_t)256 * 1024 * 2, (size_t)256 * 1024 * 2};
            pg8::EpiInProj E{(bf16*)(ws + WS_PC), (bf16*)(ws + WS_PA), (bf16*)(ws + WS_PG), (float*)(ws + WS_KM2), gtab, gtab + 64};
            RUN(16, pg8::gemm_phase(F.lds, 1024, 1024, S, E));
        }
        SEAM(pb + 1);
        if (IN(pb + 2)) { RUN(1, ph_conv(F, l)); RUN(4, ph_moba_gate(F)); __syncthreads(); RUN(3, ph_gla_kv(F, l)); }
        SEAM(pb + 2);
        if (IN(pb + 3)) { PM(5) { if ((REP_MASK >> 5) & 1u) ph_gla_scan(F, true); ph_gla_scan(F); } __syncthreads(); PM(6) ph_moba_routed(F, l); }
        SEAM(pb + 3);
        if (IN(pb + 12)) { RUN(7, ph_gla_out(F, l)); __syncthreads(); RUN(14, ph_moba_own(F, l)); }
        SEAM(pb + 12);
        if (IN(pb + 5)) { WSL;
            pg8::SchedBranch S{(const char*)(ws + WS_Y), (const char*)(wmix + WO_WB), F.G, (int)blockIdx.x};
            pg8::EpiBranch E{(bf16*)(ws + WS_BB)};
            RUN(17, pg8::gemm_phase(F.lds, 512, NYC, S, E));
        }
        ++n_stamp;
        if (IN(pb + 6)) { WSL;
            pg8::SchedGate S{(const char*)(ws + WS_H), (const char*)(wmix + WO_WG), F.G, (int)blockIdx.x};
            pg8::EpiGateMerge E{(const bf16*)(ws + WS_BB), (bf16*)(ws + WS_MRG)};
            RUN(18, pg8::gemm_phase(F.lds, 1024, 1024, S, E));
        }
        SEAM(pb + 6);
        if (IN(pb + 7)) { WSL;
            pg8::SchedPlain S{(const char*)(ws + WS_MRG), (const char*)(wmix + WO_WO), 128, 4, F.G, (int)blockIdx.x, (size_t)256 * 1024 * 2, (size_t)256 * 1024 * 2};
            pg8::EpiOut E{l == 0 ? F.inp(0) : (const float*)F.out, F.out};
            RUN(19, pg8::gemm_phase(F.lds, 1024, 1024, S, E));
        }
        SEAM(pb + 7);
        if (IN(pb + 8)) { const int tid = tid_now(); SP_T0(); PM(8) { if ((REP_MASK >> 8) & 1u) ph_norm_router(F, l, true); ph_norm_router(F, l); } SP_ADD(4); RUN(9, ph_convert_experts(F, l)); SP_ADD(5); }
        SEAM(pb + 8);
        if (IN(pb + 9)) PM(10) { if ((REP_MASK >> 10) & 1u) { ph_dispatch(F, l, true); __syncthreads(); } ph_dispatch(F, l); }
        SEAM(pb + 9);
        if (IN(pb + 10) || IN(pb + 11)) { WSL;
            LAS int* tab = (LAS int*)(F.lds + LTAB_OFF + 2048);
            const int* blke = (const int*)(ws + WS_BLKE);
            for (int i = tid_now(); i < 304; i += 512) tab[i] = blke[i];
            __syncthreads();
            const int nblk = tab[300];
            if (IN(pb + 10)) {
                pg8::SchedMoeG S{(const char*)(ws + WS_H), (const int*)(ws + WS_ROWTOK), (const char*)(ws + WS_W1T), tab, nblk * 4, F.G, (int)blockIdx.x, (size_t)1024 * 1024 * 2, (size_t)256 * 1024 * 2};
                pg8::EpiSwiGLU E{(bf16*)(ws + WS_ACT), (const float*)(ws + WS_ROWW)};
                RUN(20, pg8::gemm_phase_gather(F.lds, 1024, S, E));
            }
            SEAM(pb + 10);
            if (IN(pb + 11)) {
                pg8::SchedMoe S{(const char*)(ws + WS_ACT), (const char*)(ws + WS_WDT), tab, nblk * 4, F.G, (int)blockIdx.x, (size_t)256 * 512 * 2, (size_t)1024 * 512 * 2, (size_t)256 * 512 * 2};
                pg8::EpiMoeDown E{(bf16*)(ws + WS_YS)};
                RUN(21, pg8::gemm_phase(F.lds, 512, 512, S, E));
            }
        }
        SEAM(pb + 11);
    }
    if (IN(2 * NPH)) PM(13) ph_norm<true, false>(F, F.out, nullptr, nullptr);
    if ((PROBE_A >= 0 || PROBE_B >= 0) && blockIdx.x == PROBE_BLK && tid_now() == 0) {
        LAS unsigned long long* ts = (LAS unsigned long long*)(F.lds + LTAB_OFF + 4096);
        LAS unsigned long long* ta = ts + 32;
        constexpr int NSEAM = 12;
        ts[2 * NSEAM + 1] = __builtin_amdgcn_s_memrealtime(); ta[2 * NSEAM + 1] = ts[2 * NSEAM + 1];
        unsigned long long spin = 0ull;
#define PROBE_LAST(i) __hip_atomic_load((unsigned long long*)(F.ctl + CW_ARR) + (i), __ATOMIC_RELAXED, __HIP_MEMORY_SCOPE_AGENT)
#define PROBE_SPAN(P, K, i) ((K) == 0 ? ts[(i) + 1] - ts[(i)] : (K) == 1 ? ta[(i) + 1] - ts[(i)] : (K) == 2 ? ts[(i) + 1] - ta[(i) + 1] : (K) == 3 ? PROBE_LAST((i) + 1) - ts[(i)] : ts[(i) + 1] - PROBE_LAST((i) + 1))
        LAS unsigned long long* spacc = (LAS unsigned long long*)(F.lds + LTAB_OFF + 4096 + 512);
        if (PROBE_A >= 0) { unsigned long long d = (PROBE_A >= 100) ? spacc[PROBE_A >= 100 ? PROBE_A - 100 : 0] : (PROBE_A == NSEAM) ? PROBE_SPAN(PROBE_A, PROBE_KA, 2 * NSEAM) : PROBE_SPAN(PROBE_A, PROBE_KA, PROBE_A) + PROBE_SPAN(PROBE_A, PROBE_KA, PROBE_A + NSEAM);
            unsigned long long q = (d + 50ull * PROBE_QA) / (100ull * PROBE_QA); if (q > 63ull) q = 63ull; spin += q * 10000ull; }
        if (PROBE_B >= 0) { unsigned long long d = (PROBE_B >= 100) ? spacc[PROBE_B >= 100 ? PROBE_B - 100 : 0] : (PROBE_B == NSEAM) ? PROBE_SPAN(PROBE_B, PROBE_KB, 2 * NSEAM) : PROBE_SPAN(PROBE_B, PROBE_KB, PROBE_B) + PROBE_SPAN(PROBE_B, PROBE_KB, PROBE_B + NSEAM);
            unsigned long long q = (d + 50ull * PROBE_QB) / (100ull * PROBE_QB); if (q > 63ull) q = 63ull; spin += q * 640000ull; }
        const unsigned long long t0 = __builtin_amdgcn_s_memrealtime();
        while (__builtin_amdgcn_s_memrealtime() - t0 < spin) __builtin_amdgcn_s_sleep(16);
    }
#undef IN
#undef SEAM
#undef WSL
}

extern "C" void kernel_launch(void* const* d_in, const int* in_sizes, int n_in, void* d_out, int out_size, void* d_ws, size_t ws_size, hipStream_t stream) {
    static int grid = 0;
    if (grid == 0) {
        if (n_in != 22 || out_size != T_ * DM || ws_size < WS_END) { fprintf(stderr, "kernel_launch: unexpected shapes (n_in %d out %d ws %zu)\n", n_in, out_size, ws_size); grid = -1; return; }
        if (hipFuncSetAttribute((const void*)fwd_kernel, hipFuncAttributeMaxDynamicSharedMemorySize, LDS_BASE + LDS_BYTES) != hipSuccess) { fprintf(stderr, "kernel_launch: hipFuncSetAttribute failed\n"); grid = -1; return; }
        int dev = 0, cus = 0, per_cu = 0;
        hipGetDevice(&dev); hipDeviceGetAttribute(&cus, hipDeviceAttributeMultiprocessorCount, dev);
        if (hipOccupancyMaxActiveBlocksPerMultiprocessor(&per_cu, (const void*)fwd_kernel, 512, LDS_BASE + LDS_BYTES) != hipSuccess || per_cu < 1) fprintf(stderr, "kernel_launch: occupancy query reports %d\n", per_cu);
        (void)hipGetLastError();
        grid = 256;
        if (cus < 256) { fprintf(stderr, "kernel_launch: needs a 256-CU device (found %d)\n", cus); grid = -1; return; }
    }
    if (grid < 0) return;
    (void)hipMemsetAsync((char*)d_ws + WS_CTL, 0, CTL_ZERO_BYTES, stream);
    Args a{};
    for (int i = 0; i < 22; ++i) a.in[i] = (const float*)d_in[i];
    a.out = (float*)d_out; a.ws = (unsigned char*)d_ws; a.ph_lo = 0; a.ph_hi = 2 * NPH + 1;
    hipLaunchKernelGGL(fwd_kernel, dim3(grid), dim3(512), LDS_BASE + LDS_BYTES, stream, a);
}
```

```cpp
#include <hip/hip_runtime.h>
#include <cstdio>
#include <cstdint>

#define LAS __attribute__((address_space(3)))
#ifndef PHASE_MASK
#define PHASE_MASK 0xffffffffu
#endif
#define PM(k) if ((PHASE_MASK >> (k)) & 1u)
#ifndef REP_MASK
#define REP_MASK 0u
#endif
#define PROBE_A (-1)
#define PROBE_B (-1)
#define PROBE_QA 5
#define PROBE_QB 5
#define PROBE_KA 0
#define PROBE_KB 0
#define PROBE_BLK 0
#define PROBE_ON (PROBE_A >= 0 || PROBE_B >= 0)
#define SP_T0() unsigned long long sp_t_ = PROBE_ON ? __builtin_amdgcn_s_memrealtime() : 0ull
#define SP_ADD(i) do { if (PROBE_ON && blockIdx.x == PROBE_BLK && tid == 0) { const unsigned long long n_ = __builtin_amdgcn_s_memrealtime(); ((LAS unsigned long long*)(F.lds + LTAB_OFF + 4096 + 512))[i] += n_ - sp_t_; sp_t_ = n_; } else if (PROBE_ON) sp_t_ = __builtin_amdgcn_s_memrealtime(); } while (0)
#define RUN(k, ...) do { if ((PHASE_MASK >> (k)) & 1u) { __VA_ARGS__; if ((REP_MASK >> (k)) & 1u) { __syncthreads(); __VA_ARGS__; } } } while (0)
#define GAS __attribute__((address_space(1)))
typedef unsigned short bf16;
typedef short bf16x8 __attribute__((ext_vector_type(8)));
typedef float f32x4 __attribute__((ext_vector_type(4)));
typedef float f32x2 __attribute__((ext_vector_type(2)));
typedef unsigned u32x4 __attribute__((ext_vector_type(4)));
typedef unsigned u32x2 __attribute__((ext_vector_type(2)));
typedef GAS unsigned gu32;

constexpr int T_ = 32768, SEQ = 8192, DM = 1024, DEPTH = 2;
constexpr int NPC = 1536, NPA = 1536, NPG = 1792, NIN = 4864;
constexpr int NYC = 1536;
constexpr int MAXROWS = 73728;
constexpr float RMS_EPS = 1e-6f;
constexpr float LOG2E = 1.4426950408889634f;
constexpr float QSCALE = 0.125f * LOG2E;

constexpr size_t MiB = 1u << 20;
constexpr size_t WS_CTL = 0, CTL_ZERO_BYTES = 1 * MiB;
constexpr size_t WS_MISC = 1 * MiB;
constexpr size_t WS_KMEAN = WS_MISC;
constexpr size_t WS_SEL = WS_MISC + 256 * 1024;
constexpr size_t WS_DEC = WS_SEL + 1 * MiB;
constexpr size_t WS_TOKE = WS_DEC + 512 * 1024;
constexpr size_t WS_TOKW = WS_TOKE + 256 * 1024;
constexpr size_t WS_TOKS = WS_TOKW + 256 * 1024;
constexpr size_t WS_ROWW = WS_TOKS + 256 * 1024;
constexpr size_t WS_BLKE = WS_ROWW + 288 * 1024;
constexpr size_t WS_TOKRS = 4 * MiB;
constexpr size_t WS_KM2 = 4 * MiB + 512 * 1024;
constexpr size_t WS_HIST = 4 * MiB + 256 * 1024;
constexpr size_t WS_WR = 5 * MiB;
constexpr size_t WS_ROWTOK = 5 * MiB + 512 * 1024;
constexpr size_t WS_ZB = 6 * MiB;
constexpr size_t WS_WMIX = 8 * MiB;
constexpr size_t WMIX_LAYER = 22 * MiB;
constexpr size_t WO_WIN = 0, WO_WG = (size_t)NIN * 1024 * 2, WO_WB = WO_WG + (size_t)3072 * 1024 * 2, WO_WO = WO_WB + (size_t)3 * 1024 * 512 * 2;
constexpr size_t WS_H = 52 * MiB;
constexpr size_t WS_PC = 116 * MiB;
constexpr size_t WS_PA = 212 * MiB;
constexpr size_t WS_PG = 308 * MiB;
constexpr size_t WS_Y = 420 * MiB;
constexpr size_t WS_GLA = 516 * MiB;
constexpr size_t WS_ML = 548 * MiB;
constexpr size_t WS_END = 556 * MiB;
constexpr size_t WS_OP = WS_PC;
constexpr size_t WS_BB = WS_PC;
constexpr size_t WS_MRG = WS_PG;
constexpr size_t WS_W1T = WS_Y;
constexpr size_t WS_WDT = WS_Y + 64 * MiB;
constexpr size_t WS_XS = WS_PC;
constexpr size_t WS_ACT = WS_PG;
constexpr size_t WS_YS = WS_PC;
static_assert(WMIX_LAYER >= WO_WO + (size_t)1024 * 1024 * 2, "mixer weights fit");
static_assert(WS_WMIX + 2 * WMIX_LAYER <= WS_H && WS_BLKE + 2048 <= WS_WMIX, "map");
static_assert((size_t)MAXROWS * 1024 * 2 <= WS_PG - WS_PC && (size_t)MAXROWS * 512 * 2 <= WS_Y - WS_PG, "moe aliases fit");

constexpr int CW_BAR = 4096;
constexpr int CW_CNT = 16384;
constexpr int CW_CUR = 16384 + 256;
constexpr int CW_Q = 16384 + 512;
constexpr int CW_ARR = 32768;

constexpr int RING_BYTES = 131072;
constexpr int LDSCTL_OFF = RING_BYTES;
constexpr int MISC_OFF = LDSCTL_OFF + 320;
constexpr int PTAB_OFF = LDSCTL_OFF + 512;
constexpr int LTAB_OFF = LDSCTL_OFF + 1024;
constexpr int LDS_BYTES = 147456;
constexpr int LDS_BASE = 16;

#define RLX_AGENT __ATOMIC_RELAXED, __HIP_MEMORY_SCOPE_AGENT
__device__ __forceinline__ float bflo(unsigned w) { return __uint_as_float(w << 16); }
__device__ __forceinline__ float bfhi(unsigned w) { return __uint_as_float(w & 0xffff0000u); }
__device__ __forceinline__ float bf1(bf16 b) { return __uint_as_float((unsigned)b << 16); }
__device__ __forceinline__ unsigned f2bf(float f) { unsigned u = __float_as_uint(f); return (u + 0x7fffu + ((u >> 16) & 1u)) >> 16; }
__device__ __forceinline__ unsigned pk2(float lo, float hi) { return f2bf(lo) | (f2bf(hi) << 16); }
__device__ __forceinline__ void unpack8(const u32x4 w, float (&v)[8]) {
    v[0] = bflo(w.x); v[1] = bfhi(w.x); v[2] = bflo(w.y); v[3] = bfhi(w.y); v[4] = bflo(w.z); v[5] = bfhi(w.z); v[6] = bflo(w.w); v[7] = bfhi(w.w);
}
__device__ __forceinline__ u32x4 pack8(const float (&v)[8]) { u32x4 w; w.x = pk2(v[0], v[1]); w.y = pk2(v[2], v[3]); w.z = pk2(v[4], v[5]); w.w = pk2(v[6], v[7]); return w; }
__device__ __forceinline__ float wave_sum(float v) {
#pragma unroll
    for (int o = 1; o < 64; o <<= 1) v += __shfl_xor(v, o);
    return v;
}
__device__ __forceinline__ float wave_max(float v) {
#pragma unroll
    for (int o = 1; o < 64; o <<= 1) v = fmaxf(v, __shfl_xor(v, o));
    return v;
}
__device__ __forceinline__ float sigmoidf_(float x) { return __builtin_amdgcn_rcpf(1.0f + __builtin_amdgcn_exp2f(-x * LOG2E)); }

__device__ __forceinline__ int tid_now_() { int t = threadIdx.x; asm volatile("" : "+v"(t)); return t; }
namespace pg8 {
constexpr int BM = 256, BK = 64, HALF = 128, HTB = HALF * BK * 2, STAGE_BYTES = 8 * HTB;
__host__ __device__ __forceinline__ int lds_byte(int r, int c) { const int st = (r >> 4) * 2 + (c >> 5), rr = r & 15, cc = c & 31, ob = rr * 64 + cc * 2; return st * 1024 + (ob ^ (((ob >> 9) & 1) << 5)); }
__host__ __device__ __forceinline__ void stage_rc(int b, int& R, int& C) { const int st = b / 1024, sb = b % 1024, swz = sb ^ (((sb >> 9) & 1) << 5); R = (st >> 1) * 16 + swz / 64; C = (st & 1) * 32 + (swz % 64) / 2; }
__host__ __device__ __forceinline__ int perm32(int rho) { const int n = rho >> 4, i = rho & 15; return 8 * (i >> 2) + 4 * n + (i & 3); }
struct Unit { int pm, pn, z; };
__device__ __forceinline__ void tile_map(int w, int nM, int nN, int& pm, int& pn) {
    const int nwg = nM * nN, q = nwg / 8, r = nwg % 8, xcd = w % 8, off = w / 8;
    const int wg = (xcd < r ? xcd * (q + 1) : r * (q + 1) + (xcd - r) * q) + off;
    const int nig = 8 * nN, gid = wg / nig, fm = gid * 8, gsz = (nM - fm) < 8 ? (nM - fm) : 8;
    pm = fm + ((wg % nig) % gsz); pn = (wg % nig) / gsz;
}
__device__ __forceinline__ unsigned cvt_pk_bf16(float lo, float hi) { typedef float f32x2_c __attribute__((ext_vector_type(2))); typedef __bf16 bf16x2_c __attribute__((ext_vector_type(2))); const f32x2_c v = {lo, hi}; const bf16x2_c b = __builtin_convertvector(v, bf16x2_c); return __builtin_bit_cast(unsigned, b); }

__device__ __forceinline__ unsigned xsrc_bytes(int fr, int fq) { const int lane = fq * 16 + fr; return (unsigned)(((lane & 3) * 16 + (lane >> 2)) * 4); }
__device__ __forceinline__ u32x4 to_rows(const u32x4 v, unsigned sb) { u32x4 o; o.x = (unsigned)__builtin_amdgcn_ds_bpermute((int)sb, (int)v.x); o.y = (unsigned)__builtin_amdgcn_ds_bpermute((int)sb, (int)v.y);
    o.z = (unsigned)__builtin_amdgcn_ds_bpermute((int)sb, (int)v.z); o.w = (unsigned)__builtin_amdgcn_ds_bpermute((int)sb, (int)v.w); return o; }
__device__ __forceinline__ f32x4 to_rows(const f32x4 v, unsigned sb) { return __builtin_bit_cast(f32x4, to_rows(__builtin_bit_cast(u32x4, v), sb)); }
template <class Epi, class Sched>
__device__ __forceinline__ void gemm_phase(LAS unsigned char* lds, const int K, const int lda, const Sched& S, const Epi& E) {
    const int tid = tid_now_(), wid = __builtin_amdgcn_readfirstlane(tid >> 6), lane = tid & 63, wr = wid >> 2, wc = wid & 3, fr = lane & 15, fq = lane >> 4;
    const int nt = K / BK;
    unsigned voffA[2], voffB[2];
#pragma unroll
    for (int i = 0; i < 2; ++i) { int R, C; stage_rc(tid * 16 + i * 8192, R, C); const int Rb = Epi::PERM ? ((R & ~31) + perm32(R & 31)) : R;
        voffA[i] = (unsigned)(R * lda + C) * 2u; voffB[i] = (unsigned)(Rb * K + C) * 2u; }
    const size_t kstep = (size_t)(BK * 2);
    const size_t hstepA = (size_t)HALF * lda * 2, hstepB = (size_t)HALF * K * 2;
    const unsigned ldsw = (unsigned)wid * 1024u;
    const int aoff = lds_byte(wr * 64 + fr, fq * 8), boff = lds_byte(wc * 32 + fr, fq * 8);
#define PG8_SA(b, h) (((b) * 2 + (h)) * HTB)
#define PG8_SB(b, h) ((4 + (b) * 2 + (h)) * HTB)
#define PG8_STAGE(bufoff, gbase, voff) do { _Pragma("unroll") for (int _i = 0; _i < 2; ++_i) \
        __builtin_amdgcn_global_load_lds((const unsigned*)((const char*)(gbase) + (voff)[_i]), (LAS unsigned*)(lds + (bufoff) + ldsw + _i * 8192), 16, 0, 0); } while (0)
#define PG8_LDA(dst, b, h) do { _Pragma("unroll") for (int m = 0; m < 4; ++m) _Pragma("unroll") for (int k = 0; k < 2; ++k) dst[m][k] = *(const LAS bf16x8*)(lds + PG8_SA(b, h) + aoff + m * 2048 + k * 1024); } while (0)
#define PG8_LDB(dst, b, h) do { _Pragma("unroll") for (int n = 0; n < 2; ++n) _Pragma("unroll") for (int k = 0; k < 2; ++k) dst[n][k] = *(const LAS bf16x8*)(lds + PG8_SB(b, h) + boff + n * 2048 + k * 1024); } while (0)
#define PG8_MMA(ai, bj, At, Bt) do { __builtin_amdgcn_s_setprio(1); _Pragma("unroll") for (int m = 0; m < 4; ++m) _Pragma("unroll") for (int n = 0; n < 2; ++n) _Pragma("unroll") for (int k = 0; k < 2; ++k) \
        acc[ai][bj][m][n] = __builtin_amdgcn_mfma_f32_16x16x32_bf16(Bt[n][k], At[m][k], acc[ai][bj][m][n], 0, 0, 0); __builtin_amdgcn_s_setprio(0); } while (0)
#define PG8_WAIT_V(n) asm volatile("s_waitcnt vmcnt(" #n ")" ::: "memory")
#define PG8_WAIT_L(n) asm volatile("s_waitcnt lgkmcnt(" #n ")" ::: "memory")
#define PG8_BAR __builtin_amdgcn_s_barrier()
#define PG8_SCHED __builtin_amdgcn_sched_barrier(0)
    Unit cur, nxt; int ui = 0;
    if (!S.next(0, cur)) return;
    f32x4 acc[2][2][4][2];
#pragma unroll
    for (int a = 0; a < 2; ++a)
#pragma unroll
        for (int b = 0; b < 2; ++b)
#pragma unroll
            for (int m = 0; m < 4; ++m)
#pragma unroll
                for (int n = 0; n < 2; ++n) acc[a][b][m][n] = (f32x4){0.f, 0.f, 0.f, 0.f};
    bf16x8 At[4][2], B0[2][2], B1[2][2];
    const char* cA = S.a_ptr(cur); const char* cB = S.b_ptr(cur);
    PG8_STAGE(PG8_SB(0, 0), cB, voffB); PG8_STAGE(PG8_SB(0, 1), cB + hstepB, voffB); PG8_STAGE(PG8_SA(0, 0), cA, voffA); PG8_STAGE(PG8_SA(0, 1), cA + hstepA, voffA);
    if (wr == 1) PG8_BAR;
    PG8_WAIT_V(2); PG8_BAR;
    PG8_STAGE(PG8_SB(1, 0), cB + kstep, voffB); PG8_STAGE(PG8_SA(1, 0), cA + kstep, voffA); PG8_STAGE(PG8_SB(1, 1), cB + hstepB + kstep, voffB);
    PG8_WAIT_V(6); PG8_BAR;
    for (;;) {
        const bool has_next = S.next(ui + 1, nxt);
        const char* nA = has_next ? S.a_ptr(nxt) : cA; const char* nB = has_next ? S.b_ptr(nxt) : cB;
        for (int t = 0; t < nt; t += 2) {
            const bool last = (t == nt - 2);
            const char* a1 = cA + (size_t)(t + 1) * kstep;
            const char* a2 = last ? nA : cA + (size_t)(t + 2) * kstep; const char* b2 = last ? nB : cB + (size_t)(t + 2) * kstep;
            const char* a3 = a2 + kstep; const char* b3 = b2 + kstep;
            PG8_LDB(B0, 0, 0); PG8_LDB(B1, 0, 1); PG8_SCHED; PG8_LDA(At, 0, 0); PG8_STAGE(PG8_SA(1, 1), a1 + hstepA, voffA);
            PG8_WAIT_V(8); PG8_WAIT_L(0); PG8_BAR; PG8_MMA(0, 0, At, B0); PG8_MMA(0, 1, At, B1); PG8_BAR; PG8_SCHED;
            PG8_LDA(At, 0, 1); PG8_STAGE(PG8_SB(0, 0), b2, voffB); PG8_STAGE(PG8_SB(0, 1), b2 + hstepB, voffB); PG8_STAGE(PG8_SA(0, 0), a2, voffA);
            PG8_WAIT_V(8); PG8_WAIT_L(0); PG8_BAR; PG8_MMA(1, 0, At, B0); PG8_MMA(1, 1, At, B1); PG8_BAR; PG8_SCHED;
            PG8_LDB(B0, 1, 0); PG8_LDB(B1, 1, 1); PG8_SCHED; PG8_LDA(At, 1, 0); PG8_STAGE(PG8_SA(0, 1), a2 + hstepA, voffA);
            PG8_WAIT_V(8); PG8_WAIT_L(0); PG8_BAR; PG8_MMA(0, 0, At, B0); PG8_MMA(0, 1, At, B1); PG8_BAR; PG8_SCHED;
            PG8_LDA(At, 1, 1); PG8_STAGE(PG8_SB(1, 0), b3, voffB); PG8_STAGE(PG8_SB(1, 1), b3 + hstepB, voffB); PG8_STAGE(PG8_SA(1, 0), a3, voffA);
            PG8_WAIT_V(8); PG8_WAIT_L(0); PG8_BAR; PG8_MMA(1, 0, At, B0); PG8_MMA(1, 1, At, B1); PG8_BAR; PG8_SCHED;
        }
        if (wr == 0) PG8_BAR;
        E(acc, cur, wr, wc, fr, fq);
        if (!has_next) break;
#pragma unroll
        for (int a = 0; a < 2; ++a)
#pragma unroll
            for (int b = 0; b < 2; ++b)
#pragma unroll
                for (int m = 0; m < 4; ++m)
#pragma unroll
                    for (int n = 0; n < 2; ++n) acc[a][b][m][n] = (f32x4){0.f, 0.f, 0.f, 0.f};
        cur = nxt; cA = nA; cB = nB; ++ui;
        if (wr == 1) PG8_BAR;
    }
    PG8_WAIT_V(0);
    PG8_BAR;
#undef PG8_SA
#undef PG8_SB
#undef PG8_STAGE
#undef PG8_LDA
#undef PG8_LDB
#undef PG8_MMA
#undef PG8_WAIT_V
#undef PG8_WAIT_L
#undef PG8_BAR
#undef PG8_SCHED
}

template <class Epi, class Sched>
__device__ __forceinline__ void gemm_phase_gather(LAS unsigned char* lds, const int K, const Sched& S, const Epi& E) {
    const int tid = tid_now_(), wid = __builtin_amdgcn_readfirstlane(tid >> 6), lane = tid & 63, wr = wid >> 2, wc = wid & 3, fr = lane & 15, fq = lane >> 4;
    const int nt = K / BK;
    unsigned voffA[2], voffB[2]; int rowA[2];
#pragma unroll
    for (int i = 0; i < 2; ++i) { int R, C; stage_rc(tid * 16 + i * 8192, R, C); const int Rb = Epi::PERM ? ((R & ~31) + perm32(R & 31)) : R;
        voffA[i] = (unsigned)C * 2u; voffB[i] = (unsigned)(Rb * K + C) * 2u; rowA[i] = R; }
    const size_t kstep = (size_t)(BK * 2);
    const size_t hstepB = (size_t)HALF * K * 2;
    const unsigned rowbytes = (unsigned)K * 2u;
    const unsigned ldsw = (unsigned)wid * 1024u;
    const int aoff = lds_byte(wr * 64 + fr, fq * 8), boff = lds_byte(wc * 32 + fr, fq * 8);
#define PG8_SA(b, h) (((b) * 2 + (h)) * HTB)
#define PG8_SB(b, h) ((4 + (b) * 2 + (h)) * HTB)
#define PG8_STAGE(bufoff, gbase, voff) do { _Pragma("unroll") for (int _i = 0; _i < 2; ++_i) \
        __builtin_amdgcn_global_load_lds((const unsigned*)((const char*)(gbase) + (voff)[_i]), (LAS unsigned*)(lds + (bufoff) + ldsw + _i * 8192), 16, 0, 0); } while (0)
#define PG8_LDA(dst, b, h) do { _Pragma("unroll") for (int m = 0; m < 4; ++m) _Pragma("unroll") for (int k = 0; k < 2; ++k) dst[m][k] = *(const LAS bf16x8*)(lds + PG8_SA(b, h) + aoff + m * 2048 + k * 1024); } while (0)
#define PG8_LDB(dst, b, h) do { _Pragma("unroll") for (int n = 0; n < 2; ++n) _Pragma("unroll") for (int k = 0; k < 2; ++k) dst[n][k] = *(const LAS bf16x8*)(lds + PG8_SB(b, h) + boff + n * 2048 + k * 1024); } while (0)
#define PG8_MMA(ai, bj, At, Bt) do { __builtin_amdgcn_s_setprio(1); _Pragma("unroll") for (int m = 0; m < 4; ++m) _Pragma("unroll") for (int n = 0; n < 2; ++n) _Pragma("unroll") for (int k = 0; k < 2; ++k) \
        acc[ai][bj][m][n] = __builtin_amdgcn_mfma_f32_16x16x32_bf16(Bt[n][k], At[m][k], acc[ai][bj][m][n], 0, 0, 0); __builtin_amdgcn_s_setprio(0); } while (0)
#define PG8_WAIT_V(n) asm volatile("s_waitcnt vmcnt(" #n ")" ::: "memory")
#define PG8_WAIT_L(n) asm volatile("s_waitcnt lgkmcnt(" #n ")" ::: "memory")
#define PG8_BAR __builtin_amdgcn_s_barrier()
#define PG8_SCHED __builtin_amdgcn_sched_barrier(0)
    Unit cur, nxt; int ui = 0;
    if (!S.next(0, cur)) return;
    f32x4 acc[2][2][4][2];
#pragma unroll
    for (int a = 0; a < 2; ++a)
#pragma unroll
        for (int b = 0; b < 2; ++b)
#pragma unroll
            for (int m = 0; m < 4; ++m)
#pragma unroll
                for (int n = 0; n < 2; ++n) acc[a][b][m][n] = (f32x4){0.f, 0.f, 0.f, 0.f};
    bf16x8 At[4][2], B0[2][2], B1[2][2];
    const char* const gA = S.a_base(); const char* cB = S.b_ptr(cur);
    unsigned offC[2][2], offN[2][2];
#define PG8_GOFF(dst, u) do { _Pragma("unroll") for (int _h = 0; _h < 2; ++_h) _Pragma("unroll") for (int _i = 0; _i < 2; ++_i) dst[_h][_i] = (unsigned)S.tok(u, _h * HALF + rowA[_i]) * rowbytes + voffA[_i]; } while (0)
    PG8_GOFF(offC, cur);
    PG8_STAGE(PG8_SB(0, 0), cB, voffB); PG8_STAGE(PG8_SB(0, 1), cB + hstepB, voffB); PG8_STAGE(PG8_SA(0, 0), gA, offC[0]); PG8_STAGE(PG8_SA(0, 1), gA, offC[1]);
    if (wr == 1) PG8_BAR;
    PG8_WAIT_V(2); PG8_BAR;
    PG8_STAGE(PG8_SB(1, 0), cB + kstep, voffB); PG8_STAGE(PG8_SA(1, 0), gA + kstep, offC[0]); PG8_STAGE(PG8_SB(1, 1), cB + hstepB + kstep, voffB);
    PG8_WAIT_V(6); PG8_BAR;
    for (;;) {
        const bool has_next = S.next(ui + 1, nxt);
        const char* nB = has_next ? S.b_ptr(nxt) : cB;
        if (has_next) PG8_GOFF(offN, nxt); else { _Pragma("unroll") for (int _h = 0; _h < 2; ++_h) _Pragma("unroll") for (int _i = 0; _i < 2; ++_i) offN[_h][_i] = offC[_h][_i]; }
        for (int t = 0; t < nt; t += 2) {
            const bool last = (t == nt - 2);
            const char* a1 = gA + (size_t)(t + 1) * kstep;
            const char* a2 = last ? gA : gA + (size_t)(t + 2) * kstep; const char* b2 = last ? nB : cB + (size_t)(t + 2) * kstep;
            const char* a3 = a2 + kstep; const char* b3 = b2 + kstep;
            unsigned s0[2], s1[2];
            _Pragma("unroll") for (int _i = 0; _i < 2; ++_i) { s0[_i] = last ? offN[0][_i] : offC[0][_i]; s1[_i] = last ? offN[1][_i] : offC[1][_i]; }
            PG8_LDB(B0, 0, 0); PG8_LDB(B1, 0, 1); PG8_SCHED; PG8_LDA(At, 0, 0); PG8_STAGE(PG8_SA(1, 1), a1, offC[1]);
            PG8_WAIT_V(8); PG8_WAIT_L(0); PG8_BAR; PG8_MMA(0, 0, At, B0); PG8_MMA(0, 1, At, B1); PG8_BAR; PG8_SCHED;
            PG8_LDA(At, 0, 1); PG8_STAGE(PG8_SB(0, 0), b2, voffB); PG8_STAGE(PG8_SB(0, 1), b2 + hstepB, voffB); PG8_STAGE(PG8_SA(0, 0), a2, s0);
            PG8_WAIT_V(8); PG8_WAIT_L(0); PG8_BAR; PG8_MMA(1, 0, At, B0); PG8_MMA(1, 1, At, B1); PG8_BAR; PG8_SCHED;
            PG8_LDB(B0, 1, 0); PG8_LDB(B1, 1, 1); PG8_SCHED; PG8_LDA(At, 1, 0); PG8_STAGE(PG8_SA(0, 1), a2, s1);
            PG8_WAIT_V(8); PG8_WAIT_L(0); PG8_BAR; PG8_MMA(0, 0, At, B0); PG8_MMA(0, 1, At, B1); PG8_BAR; PG8_SCHED;
            PG8_LDA(At, 1, 1); PG8_STAGE(PG8_SB(1, 0), b3, voffB); PG8_STAGE(PG8_SB(1, 1), b3 + hstepB, voffB); PG8_STAGE(PG8_SA(1, 0), a3, s0);
            PG8_WAIT_V(8); PG8_WAIT_L(0); PG8_BAR; PG8_MMA(1, 0, At, B0); PG8_MMA(1, 1, At, B1); PG8_BAR; PG8_SCHED;
        }
        if (wr == 0) PG8_BAR;
        E(acc, cur, wr, wc, fr, fq);
        if (!has_next) break;
#pragma unroll
        for (int a = 0; a < 2; ++a)
#pragma unroll
            for (int b = 0; b < 2; ++b)
#pragma unroll
                for (int m = 0; m < 4; ++m)
#pragma unroll
                    for (int n = 0; n < 2; ++n) acc[a][b][m][n] = (f32x4){0.f, 0.f, 0.f, 0.f};
        cur = nxt; cB = nB; ++ui;
        _Pragma("unroll") for (int _h = 0; _h < 2; ++_h) _Pragma("unroll") for (int _i = 0; _i < 2; ++_i) offC[_h][_i] = offN[_h][_i];
        if (wr == 1) PG8_BAR;
    }
    PG8_WAIT_V(0);
    PG8_BAR;
#undef PG8_GOFF
#undef PG8_SA
#undef PG8_SB
#undef PG8_STAGE
#undef PG8_LDA
#undef PG8_LDB
#undef PG8_MMA
#undef PG8_WAIT_V
#undef PG8_WAIT_L
#undef PG8_BAR
#undef PG8_SCHED
}

struct SchedPlain {
    const char* A; const char* Bt; int nM, nN, G, c; size_t astep, bstep;
    __device__ __forceinline__ bool next(int i, Unit& u) const { const int L = i * G + c; if (L >= nM * nN) return false; tile_map(L, nM, nN, u.pm, u.pn); u.z = 0; return true; }
    __device__ __forceinline__ const char* a_ptr(const Unit& u) const { return A + (size_t)u.pm * astep; }
    __device__ __forceinline__ const char* b_ptr(const Unit& u) const { return Bt + (size_t)u.pn * bstep; }
};
struct SchedBranch {
    const char* Y; const char* Wb; int G, c;
    __device__ __forceinline__ bool next(int i, Unit& u) const { const int L = i * G + c; if (L >= 1536) return false; u.z = L / 512; tile_map(L % 512, 128, 4, u.pm, u.pn); return true; }
    __device__ __forceinline__ const char* a_ptr(const Unit& u) const { return Y + (size_t)u.pm * (256 * NYC * 2) + (size_t)u.z * 1024; }
    __device__ __forceinline__ const char* b_ptr(const Unit& u) const { return Wb + (size_t)u.z * (1024 * 512 * 2) + (size_t)u.pn * (256 * 512 * 2); }
};
struct SchedGate {
    const char* H; const char* Wg; int G, c;
    __device__ __forceinline__ bool next(int i, Unit& u) const { const int L = (i / 3) * G + c; if (L >= 512) return false; u.z = i % 3; tile_map(L, 128, 4, u.pm, u.pn); return true; }
    __device__ __forceinline__ const char* a_ptr(const Unit& u) const { return H + (size_t)u.pm * (256 * 1024 * 2); }
    __device__ __forceinline__ const char* b_ptr(const Unit& u) const { return Wg + (size_t)(u.z * 4 + u.pn) * (256 * 1024 * 2); }
};
struct SchedMoe {
    const char* A; const char* W; const LAS int* blk_e; int nU, G, c; size_t astep, estep, bstep;
    __device__ __forceinline__ bool next(int i, Unit& u) const { const int L = i * G + (c & 7) * (G >> 3) + (c >> 3); if (L >= nU) return false; u.pm = L >> 2; u.pn = L & 3; u.z = blk_e[u.pm]; return true; }
    __device__ __forceinline__ const char* a_ptr(const Unit& u) const { return A + (size_t)u.pm * astep; }
    __device__ __forceinline__ const char* b_ptr(const Unit& u) const { return W + (size_t)u.z * estep + (size_t)u.pn * bstep; }
};

struct SchedMoeG {
    const char* Hb; const int* rowtok; const char* W; const LAS int* blk_e; int nU, G, c; size_t estep, bstep;
    __device__ __forceinline__ bool next(int i, Unit& u) const { const int L = i * G + (c & 7) * (G >> 3) + (c >> 3); if (L >= nU) return false; u.pm = L >> 2; u.pn = L & 3; u.z = blk_e[u.pm]; return true; }
    __device__ __forceinline__ const char* a_base() const { return Hb; }
    __device__ __forceinline__ int tok(const Unit& u, int r) const { return rowtok[u.pm * 256 + r]; }
    __device__ __forceinline__ const char* b_ptr(const Unit& u) const { return W + (size_t)u.z * estep + (size_t)u.pn * bstep; }
};
#define EPI_ROWS_BEGIN _Pragma("unroll") for (int ai = 0; ai < 2; ++ai) _Pragma("unroll") for (int m = 0; m < 4; ++m)
struct EpiInProj {
    static constexpr bool PERM = true;
    bf16* Pc; bf16* Pa; bf16* Pg; float* kmean; const LAS float* gq; const LAS float* gk;
    __device__ __forceinline__ void operator()(const f32x4 (&acc)[2][2][4][2], const Unit& u, int wr, int wc, int fr, int fq) const {
        if (u.pn >= 6 && u.pn < 10) {
            const int isk = (u.pn - 6) >> 1, head = 4 * (u.pn & 1) + wc;
            const LAS float* gt = isk ? gk : gq;
            float ks[2][8];
#pragma unroll
            for (int bj = 0; bj < 2; ++bj)
#pragma unroll
                for (int e = 0; e < 8; ++e) ks[bj][e] = 0.f;
            const int ln = fq * 16 + fr, sr = ln >> 2, sc = ln & 3; const unsigned sb = xsrc_bytes(fr, fq);
            const int row0 = u.pm * BM + wr * 64 + sr;
            EPI_ROWS_BEGIN {
                float ss = 0.f;
#pragma unroll
                for (int bj = 0; bj < 2; ++bj)
#pragma unroll
                    for (int n = 0; n < 2; ++n) { const f32x4 v = acc[ai][bj][m][n]; ss += (v[0] * v[0] + v[1] * v[1]) + (v[2] * v[2] + v[3] * v[3]); }
                ss += __shfl_xor(ss, 16); ss += __shfl_xor(ss, 32);
                const float rs = rsqrtf(ss * (1.f / 64.f) + RMS_EPS);
                bf16* rowp = Pa + (size_t)(row0 + ai * HALF + m * 16) * NPA + isk * 512 + head * 64 + 8 * sc;
#pragma unroll
                for (int bj = 0; bj < 2; ++bj) { float o[8];
                    const f32x4 g0 = *(const LAS f32x4*)(gt + 32 * bj + 8 * fq), g1 = *(const LAS f32x4*)(gt + 32 * bj + 8 * fq + 4);
#pragma unroll
                    for (int e = 0; e < 8; ++e) { o[e] = acc[ai][bj][m][e >> 2][e & 3] * rs * (e < 4 ? g0[e & 3] : g1[e & 3]); ks[bj][e] += o[e]; }
                    u32x4 w; w.x = cvt_pk_bf16(o[0], o[1]); w.y = cvt_pk_bf16(o[2], o[3]); w.z = cvt_pk_bf16(o[4], o[5]); w.w = cvt_pk_bf16(o[6], o[7]);
                    *(u32x4*)(rowp + 32 * bj) = to_rows(w, sb); }
            }
            if (isk) {
#pragma unroll
                for (int bj = 0; bj < 2; ++bj)
#pragma unroll
                    for (int e = 0; e < 8; ++e) { float v = ks[bj][e]; v += __shfl_xor(v, 1); v += __shfl_xor(v, 2); v += __shfl_xor(v, 4); v += __shfl_xor(v, 8); ks[bj][e] = v; }
                if (fr == 0) { float* kp = kmean + (size_t)wr * (4 * 8 * 32 * 64) + ((size_t)(((u.pm >> 5) * 8 + head) * 32 + (u.pm & 31))) * 64 + 8 * fq;
#pragma unroll
                    for (int bj = 0; bj < 2; ++bj) { *(f32x4*)(kp + 32 * bj) = (f32x4){ks[bj][0], ks[bj][1], ks[bj][2], ks[bj][3]} * (1.f / 256.f); *(f32x4*)(kp + 32 * bj + 4) = (f32x4){ks[bj][4], ks[bj][5], ks[bj][6], ks[bj][7]} * (1.f / 256.f); } }
            }
            return;
        }
        bf16* base; int ld, colt;
        if (u.pn < 6) { base = Pc; ld = NPC; colt = u.pn * 256; } else if (u.pn < 12) { base = Pa; ld = NPA; colt = (u.pn - 6) * 256; } else { base = Pg; ld = NPG; colt = (u.pn - 12) * 256; }
        const int ln = fq * 16 + fr, sr = ln >> 2, sc = ln & 3; const unsigned sb = xsrc_bytes(fr, fq);
        const int row0 = u.pm * BM + wr * 64 + sr, col0 = colt + wc * 32 + 8 * sc;
        EPI_ROWS_BEGIN { bf16* rowp = base + (size_t)(row0 + ai * HALF + m * 16) * ld + col0;
#pragma unroll
            for (int bj = 0; bj < 2; ++bj) { const f32x4 v0 = acc[ai][bj][m][0], v1 = acc[ai][bj][m][1];
                u32x4 w; w.x = cvt_pk_bf16(v0[0], v0[1]); w.y = cvt_pk_bf16(v0[2], v0[3]); w.z = cvt_pk_bf16(v1[0], v1[1]); w.w = cvt_pk_bf16(v1[2], v1[3]);
                *(u32x4*)(rowp + bj * HALF) = to_rows(w, sb); } }
    }
};
struct EpiBranch {
    static constexpr bool PERM = true;
    bf16* Bb;
    __device__ __forceinline__ void operator()(const f32x4 (&acc)[2][2][4][2], const Unit& u, int wr, int wc, int fr, int fq) const {
        unsigned char* base = (unsigned char*)Bb + (size_t)(u.z * 512 + u.pm * 4 + u.pn) * 131072 + (size_t)(wr * 4 + wc) * 16384 + (fq * 16 + fr) * 16;
        EPI_ROWS_BEGIN {
#pragma unroll
            for (int bj = 0; bj < 2; ++bj) { const f32x4 v0 = acc[ai][bj][m][0], v1 = acc[ai][bj][m][1];
                u32x4 w; w.x = cvt_pk_bf16(v0[0], v0[1]); w.y = cvt_pk_bf16(v0[2], v0[3]); w.z = cvt_pk_bf16(v1[0], v1[1]); w.w = cvt_pk_bf16(v1[2], v1[3]);
                __builtin_nontemporal_store(w, (u32x4*)(base + ((ai * 4 + m) * 2 + bj) * 1024)); } }
    }
};
struct EpiGateMerge {
    static constexpr bool PERM = true;
    const bf16* Bb; bf16* Mg;
    __device__ __forceinline__ void operator()(const f32x4 (&acc)[2][2][4][2], const Unit& u, int wr, int wc, int fr, int fq) const {
        const int ln = fq * 16 + fr, sr = ln >> 2, sc = ln & 3; const unsigned sb = xsrc_bytes(fr, fq);
        const int row0 = u.pm * BM + wr * 64 + sr, col0 = u.pn * 256 + wc * 32 + 8 * sc;
        const size_t toff = (size_t)(u.pm * 4 + u.pn) * 131072 + (size_t)(wr * 4 + wc) * 16384 + ln * 16;
        unsigned char* const pz = (unsigned char*)Bb + (size_t)u.z * 512 * 131072 + toff;
        unsigned char* const p0 = (unsigned char*)Bb + toff;
        const bool last = (u.z == 2);
        u32x4 bw[2][2][2], mw[2][2][2];
#define GM_PIECE(q, mm, bj) (((((q) >> 1) * 4 + 2 * ((q) & 1) + (mm)) * 2 + (bj)) * 1024)
#define GM_LOAD(q, buf) do { _Pragma("unroll") for (int mm = 0; mm < 2; ++mm) _Pragma("unroll") for (int bj = 0; bj < 2; ++bj) { \
            bw[buf][mm][bj] = *(const u32x4*)(pz + GM_PIECE(q, mm, bj)); \
            mw[buf][mm][bj] = (u.z != 0) ? *(const u32x4*)(p0 + GM_PIECE(q, mm, bj)) : (u32x4){0u, 0u, 0u, 0u}; } } while (0)
#define GM_PROC(q, buf) do { _Pragma("unroll") for (int mm = 0; mm < 2; ++mm) _Pragma("unroll") for (int bj = 0; bj < 2; ++bj) { const int ai = (q) >> 1, m = 2 * ((q) & 1) + mm; \
            float b[8], pm_[8], o[8]; unpack8(bw[buf][mm][bj], b); unpack8(mw[buf][mm][bj], pm_); \
            _Pragma("unroll") for (int e = 0; e < 8; ++e) o[e] = sigmoidf_(acc[ai][bj][m][e >> 2][e & 3]) * b[e] + pm_[e]; \
            u32x4 w; w.x = cvt_pk_bf16(o[0], o[1]); w.y = cvt_pk_bf16(o[2], o[3]); w.z = cvt_pk_bf16(o[4], o[5]); w.w = cvt_pk_bf16(o[6], o[7]); \
            if (last) *(u32x4*)(Mg + (size_t)(row0 + ai * HALF + m * 16) * 1024 + col0 + bj * HALF) = to_rows(w, sb); \
            else __builtin_nontemporal_store(w, (u32x4*)(p0 + GM_PIECE(q, mm, bj))); } } while (0)
        GM_LOAD(0, 0); GM_LOAD(1, 1); __builtin_amdgcn_sched_barrier(0);
        GM_PROC(0, 0); __builtin_amdgcn_sched_barrier(0); GM_LOAD(2, 0); __builtin_amdgcn_sched_barrier(0);
        GM_PROC(1, 1); __builtin_amdgcn_sched_barrier(0); GM_LOAD(3, 1); __builtin_amdgcn_sched_barrier(0);
        GM_PROC(2, 0); __builtin_amdgcn_sched_barrier(0);
        GM_PROC(3, 1);
#undef GM_LOAD
#undef GM_PROC
#undef GM_PIECE
    }
};
struct EpiOut {
    static constexpr bool PERM = false;
    const float* xin; float* out;
    __device__ __forceinline__ void operator()(const f32x4 (&acc)[2][2][4][2], const Unit& u, int wr, int wc, int fr, int fq) const {
        const int ln = fq * 16 + fr, sr = ln >> 2, sc = ln & 3; const unsigned sb = xsrc_bytes(fr, fq);
        const int row0 = u.pm * BM + wr * 64 + sr, col0 = u.pn * BM + wc * 32 + 4 * sc;
        f32x4 xv[2][2][2][2];
#define EO_LOAD(q, buf) do { _Pragma("unroll") for (int mm = 0; mm < 2; ++mm) { const size_t off = (size_t)(row0 + ((q) >> 1) * HALF + (2 * ((q) & 1) + mm) * 16) * 1024 + col0; \
            _Pragma("unroll") for (int bj = 0; bj < 2; ++bj) _Pragma("unroll") for (int n = 0; n < 2; ++n) xv[buf][mm][bj][n] = *(const f32x4*)(xin + off + bj * HALF + n * 16); } } while (0)
#define EO_PROC(q, buf) do { _Pragma("unroll") for (int mm = 0; mm < 2; ++mm) { const int ai = (q) >> 1, m = 2 * ((q) & 1) + mm; const size_t off = (size_t)(row0 + ai * HALF + m * 16) * 1024 + col0; \
            _Pragma("unroll") for (int bj = 0; bj < 2; ++bj) _Pragma("unroll") for (int n = 0; n < 2; ++n) *(f32x4*)(out + off + bj * HALF + n * 16) = xv[buf][mm][bj][n] + to_rows(acc[ai][bj][m][n], sb); } } while (0)
        EO_LOAD(0, 0); EO_LOAD(1, 1); __builtin_amdgcn_sched_barrier(0);
        EO_PROC(0, 0); __builtin_amdgcn_sched_barrier(0); EO_LOAD(2, 0); __builtin_amdgcn_sched_barrier(0);
        EO_PROC(1, 1); __builtin_amdgcn_sched_barrier(0); EO_LOAD(3, 1); __builtin_amdgcn_sched_barrier(0);
        EO_PROC(2, 0); __builtin_amdgcn_sched_barrier(0);
        EO_PROC(3, 1);
#undef EO_LOAD
#undef EO_PROC
    }
};
struct EpiSwiGLU {
    static constexpr bool PERM = true;
    bf16* act; const float* rowrs;
    __device__ __forceinline__ void operator()(const f32x4 (&acc)[2][2][4][2], const Unit& u, int wr, int wc, int fr, int fq) const {
        const int ln = fq * 16 + fr, sr = ln >> 2, sc = ln & 3; const unsigned sb = xsrc_bytes(fr, fq);
        const int row0 = u.pm * BM + wr * 64 + fr, col0 = u.pn * 128 + wc * 32 + 8 * sc;
        float rsv[2][4];
#pragma unroll
        for (int ai = 0; ai < 2; ++ai)
#pragma unroll
            for (int m = 0; m < 4; ++m) rsv[ai][m] = rowrs[row0 + ai * HALF + m * 16];
        EPI_ROWS_BEGIN { bf16* rowp = act + (size_t)(row0 - fr + sr + ai * HALF + m * 16) * 512 + col0; const float rs = rsv[ai][m];
            float o[8];
#pragma unroll
            for (int e = 0; e < 8; ++e) { const float g = acc[ai][0][m][e >> 2][e & 3] * rs, up = acc[ai][1][m][e >> 2][e & 3] * rs; o[e] = g * sigmoidf_(g) * up; }
            u32x4 w; w.x = cvt_pk_bf16(o[0], o[1]); w.y = cvt_pk_bf16(o[2], o[3]); w.z = cvt_pk_bf16(o[4], o[5]); w.w = cvt_pk_bf16(o[6], o[7]);
            *(u32x4*)rowp = to_rows(w, sb); }
    }
};
struct EpiMoeDown {
    static constexpr bool PERM = true;
    bf16* ys;
    __device__ __forceinline__ void operator()(const f32x4 (&acc)[2][2][4][2], const Unit& u, int wr, int wc, int fr, int fq) const {
        const int ln = fq * 16 + fr, sr = ln >> 2, sc = ln & 3; const unsigned sb = xsrc_bytes(fr, fq);
        const int row0 = u.pm * BM + wr * 64 + sr, col0 = u.pn * 256 + wc * 32 + 8 * sc;
        EPI_ROWS_BEGIN { const int r = row0 + ai * HALF + m * 16; bf16* rowp = ys + (size_t)r * 1024 + col0;
#pragma unroll
            for (int bj = 0; bj < 2; ++bj) { const f32x4 v0 = acc[ai][bj][m][0], v1 = acc[ai][bj][m][1];
                u32x4 w; w.x = cvt_pk_bf16(v0[0], v0[1]); w.y = cvt_pk_bf16(v0[2], v0[3]); w.z = cvt_pk_bf16(v1[0], v1[1]); w.w = cvt_pk_bf16(v1[2], v1[3]);
                *(u32x4*)(rowp + bj * HALF) = to_rows(w, sb); } }
    }
};
}

#define XB_TMO      128
#define XB_XCNT(j)  (256  + 64 * (j))
#define XB_XSUB(j)  (1280 + 64 * (j))
#define XB_XGEN(j)  (2304 + 64 * (j))
#define XB_TOP      3328
#define XB_TOPGEN   3392
#define XCD_BAR_WORDS 3456
#define XB_SPIN_CAP (1u << 18)
__device__ __forceinline__ unsigned xb_ld(unsigned* p)              { return __hip_atomic_load(p, __ATOMIC_RELAXED, __HIP_MEMORY_SCOPE_AGENT); }
__device__ __forceinline__ unsigned xb_add(unsigned* p, unsigned v) { return __hip_atomic_fetch_add(p, v, __ATOMIC_RELAXED, __HIP_MEMORY_SCOPE_AGENT); }
__device__ __forceinline__ unsigned xb_xcc_id() { return (unsigned)__builtin_amdgcn_s_getreg((3 << 11) | 20) & 0xFu; }
#define XB_SPIN(cond, bar) do { unsigned _sp = 0; while (cond) { __builtin_amdgcn_s_sleep(1); \
    if ((++_sp & 255u) == 0u) { if (xb_ld(&(bar)[XB_TMO])) break; if (_sp > XB_SPIN_CAP) { atomicAdd(&(bar)[XB_TMO], 1u); break; } } } } while (0)
struct XcdBarrier { unsigned* bar; unsigned x; volatile LAS unsigned* st; };
__device__ __forceinline__ XcdBarrier xcd_barrier_post(unsigned* bar, volatile LAS unsigned* st) {
    XcdBarrier b; b.bar = bar; b.x = xb_xcc_id(); b.st = st;
    if (threadIdx.x == 0) (void)xb_add(&bar[XB_XCNT(b.x)], 1u);
    return b;
}
__device__ __forceinline__ void xcd_barrier_complete(unsigned* bar, unsigned x, unsigned& nloc, unsigned& nx) {
    const unsigned G = gridDim.x * gridDim.y * gridDim.z;
    unsigned sum, cnt, mine, sp = 0u;
    for (;;) {
        sum = 0u; cnt = 0u; mine = 0u;
#pragma unroll
        for (unsigned j = 0; j < 16; ++j) { const unsigned c = xb_ld(&bar[XB_XCNT(j)]); sum += c; cnt += (c > 0u) ? 1u : 0u; mine = (j == x) ? c : mine; }
        if (sum == G) break;
        __builtin_amdgcn_s_sleep(1);
        if ((++sp & 255u) == 0u) { if (xb_ld(&bar[XB_TMO])) break; if (sp > XB_SPIN_CAP) { atomicAdd(&bar[XB_TMO], 1u); break; } }
    }
    nloc = mine > 0u ? mine : 1u; nx = cnt > 0u ? cnt : 1u;
}
__device__ __forceinline__ void xcd_barrier(const XcdBarrier& b) {
    asm volatile("s_waitcnt vmcnt(0)" ::: "memory");
    __syncthreads();
    if (threadIdx.x == 0) {
        unsigned* bar = b.bar;
        __builtin_amdgcn_s_waitcnt(0);
        unsigned nloc = b.st[0], nx = b.st[1];
        if (nloc == 0u) { xcd_barrier_complete(bar, b.x, nloc, nx); b.st[0] = nloc; b.st[1] = nx; }
        const unsigned old = xb_add(&bar[XB_XSUB(b.x)], 1u);
        const unsigned gen = old / nloc;
        if (old + 1u == (gen + 1u) * nloc) {
            __builtin_amdgcn_fence(__ATOMIC_RELEASE, "agent");
            asm volatile("s_waitcnt vmcnt(0)" ::: "memory");
            const unsigned og = xb_add(&bar[XB_TOP], 1u);
            const unsigned tg = og / nx;
            if (og + 1u == (tg + 1u) * nx) xb_add(&bar[XB_TOPGEN], 1u);
            else XB_SPIN(xb_ld(&bar[XB_TOPGEN]) == tg, bar);
            __builtin_amdgcn_fence(__ATOMIC_ACQUIRE, "agent");
            xb_add(&bar[XB_XGEN(b.x)], 1u);
            asm volatile("s_waitcnt vmcnt(0)" ::: "memory");
        } else {
            XB_SPIN(xb_ld(&bar[XB_XGEN(b.x)]) == gen, bar);
            __builtin_amdgcn_fence(__ATOMIC_ACQUIRE, "agent");
            asm volatile("s_waitcnt vmcnt(0)" ::: "memory");
        }
    }
    __syncthreads();
}

struct Frame {
    LAS unsigned char* lds;
    volatile LAS unsigned* MISC;
    unsigned* ctl;
    int tid, lane, wave;
    static constexpr int G = 256;
    float* out;
    unsigned char* ws;
    __device__ __forceinline__ const float* inp(int k) const {
        const LAS unsigned* p = (const LAS unsigned*)(lds + PTAB_OFF) + 2 * k; const unsigned lo = __builtin_amdgcn_readfirstlane(p[0]), hi = __builtin_amdgcn_readfirstlane(p[1]);
        return (const float*)(const GAS float*)(((unsigned long long)hi << 32) | lo); }
};
__device__ __forceinline__ int tid_now() { int t = threadIdx.x; asm volatile("" : "+v"(t)); return t; }
__device__ __forceinline__ unsigned char* opaque(unsigned char* p) { unsigned z = 0u; asm volatile("" : "+s"(z)); return p + z; }
#define LDS_WAIT() asm volatile("s_waitcnt lgkmcnt(0)" ::: "memory")

__device__ __forceinline__ void transpose_item(const float* W, int ldw, int nvalid, bf16* WT, int Kd, int k0, int n0, int drow0, LAS float* scr, int lane) {
    const int cn = n0 + (lane & 31); const bool ok = cn < nvalid;
    float tv[32];
#pragma unroll
    for (int i = 0; i < 32; ++i) { const int kk = 2 * i + (lane >> 5); tv[i] = ok ? W[(size_t)(k0 + kk) * ldw + cn] : 0.f; }
#pragma unroll
    for (int i = 0; i < 32; ++i) { const int kk = 2 * i + (lane >> 5); scr[kk * 33 + (lane & 31)] = tv[i]; }
    LDS_WAIT(); asm volatile("" ::: "memory");
    const int c = lane & 7;
#pragma unroll
    for (int j = 0; j < 4; ++j) { const int n = (lane >> 3) + 8 * j; const LAS float* s = scr + (8 * c) * 33 + n;
        u32x4 o; o.x = pk2(s[0 * 33], s[1 * 33]); o.y = pk2(s[2 * 33], s[3 * 33]); o.z = pk2(s[4 * 33], s[5 * 33]); o.w = pk2(s[6 * 33], s[7 * 33]);
        *(u32x4*)(WT + (size_t)(drow0 + n) * Kd + k0 + 8 * c) = o; }
    LDS_WAIT(); asm volatile("" ::: "memory");
}

__device__ __forceinline__ void ph_convert_mixer(Frame& F) {
    const int tid = tid_now(), lane = tid & 63, wave = __builtin_amdgcn_readfirstlane(tid >> 6); (void)lane; (void)wave;
    unsigned char* const wsl = opaque(F.ws);
    LAS float* scr = (LAS float*)(F.lds + wave * 16384);
    const int gw = blockIdx.x * 8 + wave, NGW = F.G * 8;
    constexpr int I_IN = 16 * 152, I_G = 3 * 16 * 32, I_B = 3 * 8 * 32, I_O = 16 * 32, I_L = I_IN + I_G + I_B + I_O;
    for (int it = gw; it < 2 * I_L; it += NGW) {
        const int l = it / I_L; int r = it % I_L;
        unsigned char* wb = wsl + WS_WMIX + (size_t)l * WMIX_LAYER;
        if (r < I_IN) { const int kb = r / 152, nb = r % 152;
            int drow = nb * 32;
            if (nb >= 48 && nb < 80) { const int rel = nb - 48, isk = rel >> 4, head = (rel & 15) >> 1, bjj = rel & 1;
                drow = (6 + 2 * isk + (head >> 2)) * 256 + 128 * bjj + 32 * (head & 3); }
            transpose_item(F.inp(3) + (size_t)l * 1024 * 4624, 4624, 4624, (bf16*)(wb + WO_WIN), 1024, kb * 64, nb * 32, drow, scr, lane); continue; }
        r -= I_IN;
        if (r < I_G) { const int z = r / 512, q = r % 512, kb = q / 32, nb = q % 32;
            transpose_item(F.inp(11) + ((size_t)l * 3 + z) * 1024 * 1024, 1024, 1024, (bf16*)(wb + WO_WG), 1024, kb * 64, nb * 32, z * 1024 + nb * 32, scr, lane); continue; }
        r -= I_G;
        if (r < I_B) { const int z = r / 256, q = r % 256, kb = q / 32, nb = q % 32;
            transpose_item(F.inp(12) + ((size_t)l * 3 + z) * 512 * 1024, 1024, 1024, (bf16*)(wb + WO_WB) + (size_t)z * 1024 * 512, 512, kb * 64, nb * 32, nb * 32, scr, lane); continue; }
        r -= I_B;
        { const int kb = r / 32, nb = r % 32;
            transpose_item(F.inp(13) + (size_t)l * 1024 * 1024, 1024, 1024, (bf16*)(wb + WO_WO), 1024, kb * 64, nb * 32, nb * 32, scr, lane); }
    }
    { bf16* WR = (bf16*)(wsl + WS_WR);
      for (int i = blockIdx.x * 512 + tid; i < 2 * 3 * 32 * 64; i += F.G * 512) { const int l = i / (3 * 32 * 64), r = i % (3 * 32 * 64), nt = r >> 11, ks = (r >> 6) & 31, ln = r & 63, n = 16 * nt + (ln & 15), kb = 32 * ks + 8 * (ln >> 4);
          float w[8];
#pragma unroll
          for (int e = 0; e < 8; ++e) { w[e] = 0.f; if (n < 32) w[e] = F.inp(17)[((size_t)l * 1024 + kb + e) * 32 + n]; else if (n < 36) w[e] = F.inp(15)[((size_t)l * 1024 + kb + e) * 4 + (n - 32)]; }
          unsigned hi[8], lo[8];
#pragma unroll
          for (int e = 0; e < 8; ++e) { hi[e] = f2bf(w[e]); lo[e] = f2bf(w[e] - __uint_as_float(hi[e] << 16)); }
          u32x4 hv, lv; hv.x = hi[0] | (hi[1] << 16); hv.y = hi[2] | (hi[3] << 16); hv.z = hi[4] | (hi[5] << 16); hv.w = hi[6] | (hi[7] << 16);
          lv.x = lo[0] | (lo[1] << 16); lv.y = lo[2] | (lo[3] << 16); lv.z = lo[4] | (lo[5] << 16); lv.w = lo[6] | (lo[7] << 16);
          *(u32x4*)(WR + (size_t)(l * 2 + 0) * 48 * 1024 + (size_t)r * 8) = hv; *(u32x4*)(WR + (size_t)(l * 2 + 1) * 48 * 1024 + (size_t)r * 8) = lv; } }
}
__device__ __forceinline__ void ph_convert_experts(Frame& F, int l) {
    const int tid = tid_now(), lane = tid & 63, wave = __builtin_amdgcn_readfirstlane(tid >> 6); (void)lane; (void)wave;
    unsigned char* const wsl = opaque(F.ws);
    LAS float* scr = (LAS float*)(F.lds + wave * 16384);
    const int gw = blockIdx.x * 8 + wave, NGW = F.G * 8;
    constexpr int I_1 = 32 * 16 * 32, I_2 = 32 * 8 * 32;
    bf16* W1T = (bf16*)(wsl + WS_W1T); bf16* WdT = (bf16*)(wsl + WS_WDT);
    for (int it = gw; it < I_1 + I_2; it += NGW) {
        if (it < I_1) { const int e = it / 512, q = it % 512, kb = q / 32, j = q % 32, half = j >> 4, nb = j & 15;
            const float* src = (half ? F.inp(20) : F.inp(19)) + ((size_t)l * 32 + e) * 1024 * 512;
            const int t = nb >> 2, drow = t * 256 + half * 128 + (nb & 3) * 32;
            transpose_item(src, 512, 512, W1T + (size_t)e * 1024 * 1024, 1024, kb * 64, nb * 32, drow, scr, lane);
        } else { const int r = it - I_1, e = r / 256, q = r % 256, kb = q / 32, nb = q % 32;
            transpose_item(F.inp(21) + ((size_t)l * 32 + e) * 512 * 1024, 1024, 1024, WdT + (size_t)e * 1024 * 512, 512, kb * 64, nb * 32, nb * 32, scr, lane); }
    }
}
template <bool COMBINE, bool NORM>
__device__ __forceinline__ void ph_norm(Frame& F, const float* xin, const float* gain, bf16* H) {
    const int tid = tid_now(), lane = tid & 63, wave = __builtin_amdgcn_readfirstlane(tid >> 6); (void)lane; (void)wave;
    unsigned char* const wsl = opaque(F.ws);
    const int gw = blockIdx.x * 8 + wave, NGW = F.G * 8;
    const int* toks = (const int*)(wsl + WS_TOKS); const bf16* ys = (const bf16*)(wsl + WS_YS); const float* tokw = (const float*)(wsl + WS_TOKW);
    constexpr int R = 4;
    f32x4 g[4];
#pragma unroll
    for (int j = 0; j < 4; ++j) g[j] = NORM ? *((const f32x4*)gain + 64 * j + lane) : (f32x4){0.f, 0.f, 0.f, 0.f};
    int sl[R][2], sln[R][2]; float sw[R][2], swn[R][2];
#define NORM_LOAD_SLOTS(M0, SL, SW) do { _Pragma("unroll") for (int rr = 0; rr < R; ++rr) { SL[rr][0] = toks[2 * ((M0) + rr)]; SL[rr][1] = toks[2 * ((M0) + rr) + 1]; SW[rr][0] = tokw[2 * ((M0) + rr)]; SW[rr][1] = tokw[2 * ((M0) + rr) + 1]; } } while (0)
    if (COMBINE) NORM_LOAD_SLOTS((blockIdx.x * (T_ / F.G)) + wave * R, sl, sw);
    for (int it_ = 0; it_ < T_ / (NGW * R); ++it_) { const int m0 = (blockIdx.x * (T_ / F.G)) + (it_ * 8 + wave) * R;
        f32x4 v[R][4];
#pragma unroll
        for (int rr = 0; rr < R; ++rr) { const f32x4* xr = (const f32x4*)(xin + (size_t)(m0 + rr) * 1024) + lane;
#pragma unroll
            for (int j = 0; j < 4; ++j) v[rr][j] = xr[64 * j]; }
        if (COMBINE) {
            u32x2 ya[R][4], yb[R][4];
#pragma unroll
            for (int rr = 0; rr < R; ++rr) { const u32x2* y0 = (const u32x2*)(ys + (size_t)sl[rr][0] * 1024) + lane; const u32x2* y1 = (const u32x2*)(ys + (size_t)sl[rr][1] * 1024) + lane;
#pragma unroll
                for (int j = 0; j < 4; ++j) { ya[rr][j] = y0[64 * j]; yb[rr][j] = y1[64 * j]; } }
            if (it_ + 1 < T_ / (NGW * R)) NORM_LOAD_SLOTS((blockIdx.x * (T_ / F.G)) + ((it_ + 1) * 8 + wave) * R, sln, swn);
#pragma unroll
            for (int rr = 0; rr < R; ++rr) { f32x4* xo = (f32x4*)(F.out + (size_t)(m0 + rr) * 1024) + lane;
#pragma unroll
                for (int j = 0; j < 4; ++j) { const u32x2 a = ya[rr][j], b = yb[rr][j];
                    const float w0 = sw[rr][0], w1 = sw[rr][1];
                    v[rr][j].x += w0 * bflo(a.x) + w1 * bflo(b.x); v[rr][j].y += w0 * bfhi(a.x) + w1 * bfhi(b.x); v[rr][j].z += w0 * bflo(a.y) + w1 * bflo(b.y); v[rr][j].w += w0 * bfhi(a.y) + w1 * bfhi(b.y);
                    xo[64 * j] = v[rr][j]; } }
#pragma unroll
            for (int rr = 0; rr < R; ++rr) { sl[rr][0] = sln[rr][0]; sl[rr][1] = sln[rr][1]; sw[rr][0] = swn[rr][0]; sw[rr][1] = swn[rr][1]; }
        }
        if (NORM) {
#pragma unroll
            for (int rr = 0; rr < R; ++rr) {
                float ss = 0.f;
#pragma unroll
                for (int j = 0; j < 4; ++j) ss += (v[rr][j].x * v[rr][j].x + v[rr][j].y * v[rr][j].y) + (v[rr][j].z * v[rr][j].z + v[rr][j].w * v[rr][j].w);
                const float rs = rsqrtf(wave_sum(ss) * (1.f / 1024.f) + RMS_EPS);
                u32x2* o8 = (u32x2*)(H + (size_t)(m0 + rr) * 1024) + lane;
#pragma unroll
                for (int j = 0; j < 4; ++j) { u32x2 w; w.x = pk2(v[rr][j].x * rs * g[j].x, v[rr][j].y * rs * g[j].y); w.y = pk2(v[rr][j].z * rs * g[j].z, v[rr][j].w * rs * g[j].w); o8[64 * j] = w; }
            }
        }
    }
}

#undef NORM_LOAD_SLOTS
__device__ __forceinline__ void ph_gla_z(Frame& F, int l) {
    const int tid = tid_now(), lane = tid & 63, wave = __builtin_amdgcn_readfirstlane(tid >> 6); (void)lane; (void)wave;
    unsigned char* const wsl = opaque(F.ws);
    const bf16* H = (const bf16*)(wsl + WS_H); float* ZB = (float*)(wsl + WS_ZB);
    const float* wz = F.inp(3) + (size_t)l * 1024 * 4624 + 4608;
    LAS bf16* wl = (LAS bf16*)F.lds;
    constexpr int WP = 1032;
    asm volatile("s_waitcnt vmcnt(0)" ::: "memory");
    __syncthreads();
    { f32x4 wv[8];
#pragma unroll
      for (int i = 0; i < 8; ++i) { const int idx = tid + 512 * i; wv[i] = *(const f32x4*)(wz + (size_t)(idx >> 2) * 4624 + (idx & 3) * 4); }
#pragma unroll
      for (int i = 0; i < 8; ++i) { const int idx = tid + 512 * i, k = idx >> 2, n0 = (idx & 3) * 4;
          wl[(n0 + 0) * WP + k] = (bf16)f2bf(wv[i].x); wl[(n0 + 1) * WP + k] = (bf16)f2bf(wv[i].y); wl[(n0 + 2) * WP + k] = (bf16)f2bf(wv[i].z); wl[(n0 + 3) * WP + k] = (bf16)f2bf(wv[i].w); } }
    __syncthreads();
    const int t = lane & 15, kg = lane >> 4;
    const int row = blockIdx.x * (T_ / F.G) + wave * 16 + t;
    const bf16* hr = H + (size_t)row * 1024 + kg * 8;
    f32x4 acc = {0.f, 0.f, 0.f, 0.f};
    bf16x8 hv[32];
#pragma unroll
    for (int ks = 0; ks < 32; ++ks) hv[ks] = *(const bf16x8*)(hr + 32 * ks);
#pragma unroll
    for (int ks = 0; ks < 32; ++ks) { const bf16x8 af = *(const LAS bf16x8*)(wl + t * WP + 32 * ks + kg * 8);
        acc = __builtin_amdgcn_mfma_f32_16x16x32_bf16(af, hv[ks], acc, 0, 0, 0); }
    *(f32x4*)(ZB + (size_t)row * 16 + 4 * kg) = acc;
    __syncthreads();
}
__device__ __forceinline__ void ph_conv(Frame& F, int l) {
    const int tid = tid_now(), lane = tid & 63, wave = __builtin_amdgcn_readfirstlane(tid >> 6); (void)lane; (void)wave;
    unsigned char* const wsl = opaque(F.ws);
    const bf16* Pc = (const bf16*)(wsl + WS_PC); bf16* Y = (bf16*)(wsl + WS_Y);
    const float* cw = F.inp(4) + (size_t)l * 3 * 512; const float* cbias = F.inp(5) + (size_t)l * 512;
    const int gt = blockIdx.x * 512 + tid, NT = F.G * 512;
    (void)gt; (void)NT;
    float w0[8], w1[8], w2[8], bb[8];
#pragma unroll
    for (int e = 0; e < 8; ++e) { w0[e] = cw[lane * 8 + e]; w1[e] = cw[512 + lane * 8 + e]; w2[e] = cw[1024 + lane * 8 + e]; bb[e] = cbias[lane * 8 + e]; }
    for (int it_ = 0; it_ < (T_ / F.G) / 8; it_ += 4) {
        const int r0 = blockIdx.x * (T_ / F.G) + (it_ / 4) * 32 + wave * 4, c8 = lane * 8, s0 = r0 & (SEQ - 1);
        const bf16* p = Pc + (size_t)r0 * NPC + c8;
        u32x4 wcb[4], wcc[6], wcx[6];
#pragma unroll
        for (int q = 0; q < 6; ++q) { const bool okr = (s0 + q - 2) >= 0; const bf16* pr = p + (long)(q - 2) * NPC;
            wcc[q] = okr ? *(const u32x4*)(pr + 512) : (u32x4){0u, 0u, 0u, 0u}; wcx[q] = okr ? *(const u32x4*)(pr + 1024) : (u32x4){0u, 0u, 0u, 0u}; }
#pragma unroll
        for (int q = 0; q < 4; ++q) wcb[q] = *(const u32x4*)(p + (size_t)q * NPC);
        float u[6][8];
#pragma unroll
        for (int q = 0; q < 6; ++q) { float a[8], b[8]; unpack8(wcc[q], a); unpack8(wcx[q], b);
#pragma unroll
            for (int e = 0; e < 8; ++e) u[q][e] = a[e] * b[e]; }
#pragma unroll
        for (int q = 0; q < 4; ++q) { float cb[8], o[8]; unpack8(wcb[q], cb);
#pragma unroll
            for (int e = 0; e < 8; ++e) o[e] = cb[e] * (bb[e] + w0[e] * u[q][e] + w1[e] * u[q + 1][e] + w2[e] * u[q + 2][e]);
            *(u32x4*)(Y + (size_t)(r0 + q) * NYC + c8) = pack8(o); }
    }
}
__device__ __forceinline__ void ph_qknorm(Frame& F, int l, bool probe = false) {
    const int tid = tid_now(), lane = tid & 63, wave = __builtin_amdgcn_readfirstlane(tid >> 6); (void)lane; (void)wave;
    unsigned char* const wsl = opaque(F.ws);
    bf16* Pa = (bf16*)(wsl + WS_PA); float* kmean = (float*)(wsl + WS_KMEAN);
    LAS float* red = (LAS float*)F.lds;
    for (int unit = blockIdx.x; unit < 256; unit += F.G) {
        const int blk = unit >> 1, isk = unit & 1;
        const float* gn = (isk ? F.inp(7) : F.inp(6)) + l * 64 + (lane & 7) * 8;
        float g[8], ksum[8];
#pragma unroll
        for (int e = 0; e < 8; ++e) { g[e] = gn[e] * (isk ? 1.f : QSCALE); ksum[e] = 0.f; }
        for (int rr0 = 0; rr0 < 32; rr0 += 8) {
            u32x4 raw[8];
#pragma unroll
            for (int q8 = 0; q8 < 8; ++q8) raw[q8] = *(const u32x4*)(Pa + (size_t)(blk * 256 + wave * 32 + rr0 + q8) * NPA + isk * 512 + lane * 8);
#pragma unroll
            for (int q8 = 0; q8 < 8; ++q8) {
                bf16* p = Pa + (size_t)(blk * 256 + wave * 32 + rr0 + q8) * NPA + isk * 512 + lane * 8;
                float v[8]; unpack8(raw[q8], v);
                float ss = 0.f;
#pragma unroll
                for (int e = 0; e < 8; ++e) ss += v[e] * v[e];
                ss += __shfl_xor(ss, 1); ss += __shfl_xor(ss, 2); ss += __shfl_xor(ss, 4);
                const float rs = rsqrtf(ss * (1.f / 64.f) + RMS_EPS);
#pragma unroll
                for (int e = 0; e < 8; ++e) { v[e] = v[e] * rs * g[e]; ksum[e] += v[e]; }
                *(u32x4*)(probe ? (bf16*)(wsl + WS_END) + ((p - Pa) & (8 * 1024 * 1024 - 1)) : p) = pack8(v);
            }
        }
        if (isk) {
#pragma unroll
            for (int e = 0; e < 8; ++e) red[wave * 512 + lane * 8 + e] = ksum[e];
            __syncthreads();
            { const int col = tid; float s = 0.f;
#pragma unroll
              for (int w = 0; w < 8; ++w) s += red[w * 512 + col];
              const int b = blk >> 5, n = blk & 31, h = col >> 6, d = col & 63;
              kmean[((size_t)((b * 8 + h) * 32 + n)) * 64 + d] = s * (1.f / 256.f); }
            __syncthreads();
        }
    }
}
__device__ __forceinline__ void ph_moba_gate(Frame& F) {
    const int tid = tid_now(), lane = tid & 63, wave = __builtin_amdgcn_readfirstlane(tid >> 6); (void)lane; (void)wave;
    unsigned char* const wsl = opaque(F.ws);
    const bf16* Pa = (const bf16*)(wsl + WS_PA); const float* kmean = (const float*)(wsl + WS_KM2); unsigned* sel = (unsigned*)(wsl + WS_SEL);
    const int gw = blockIdx.x * 8 + wave, NGW = F.G * 8;
    const int c = lane & 31, hi = lane >> 5;
    typedef float f32x16g __attribute__((ext_vector_type(16)));
    for (int it = gw; it < 512 * 8; it += NGW) {
        int rb = it >> 3; const int h = it & 7;
        if (it >= 2048) rb = (rb & ~127) | (127 - (rb & 127));
        const int b = rb >> 7, qb = (rb & 127) >> 2;
        const float* k0 = kmean + ((size_t)((b * 8 + h) * 32 + c)) * 64 + hi * 8; const float* k1 = k0 + 4 * 8 * 32 * 64;
        f32x4 ka[4][2], kb[4][2]; bf16x8 qf[2][4];
#pragma unroll
        for (int ks = 0; ks < 4; ++ks) { ka[ks][0] = *(const f32x4*)(k0 + 16 * ks); ka[ks][1] = *(const f32x4*)(k0 + 16 * ks + 4); kb[ks][0] = *(const f32x4*)(k1 + 16 * ks); kb[ks][1] = *(const f32x4*)(k1 + 16 * ks + 4); }
#pragma unroll
        for (int t = 0; t < 2; ++t)
#pragma unroll
            for (int ks = 0; ks < 4; ++ks) qf[t][ks] = *(const bf16x8*)(Pa + (size_t)(rb * 64 + 32 * t + c) * NPA + h * 64 + 16 * ks + 8 * hi);
        bf16x8 ah[4], al[4];
#pragma unroll
        for (int ks = 0; ks < 4; ++ks) { const f32x4 s0 = ka[ks][0] + kb[ks][0], s1 = ka[ks][1] + kb[ks][1];
            u32x4 hw, lw; hw.x = pk2(s0.x, s0.y); hw.y = pk2(s0.z, s0.w); hw.z = pk2(s1.x, s1.y); hw.w = pk2(s1.z, s1.w);
            lw.x = pk2(s0.x - bflo(hw.x), s0.y - bfhi(hw.x)); lw.y = pk2(s0.z - bflo(hw.y), s0.w - bfhi(hw.y)); lw.z = pk2(s1.x - bflo(hw.z), s1.y - bfhi(hw.z)); lw.w = pk2(s1.z - bflo(hw.w), s1.w - bfhi(hw.w));
            ah[ks] = __builtin_bit_cast(bf16x8, hw); al[ks] = __builtin_bit_cast(bf16x8, lw); }
#pragma unroll
        for (int t = 0; t < 2; ++t) {
            f32x16g acc = {0.f, 0.f, 0.f, 0.f, 0.f, 0.f, 0.f, 0.f, 0.f, 0.f, 0.f, 0.f, 0.f, 0.f, 0.f, 0.f};
#pragma unroll
            for (int ks = 0; ks < 4; ++ks) { acc = __builtin_amdgcn_mfma_f32_32x32x16_bf16(ah[ks], qf[t][ks], acc, 0, 0, 0); acc = __builtin_amdgcn_mfma_f32_32x32x16_bf16(al[ks], qf[t][ks], acc, 0, 0, 0); }
            float v0 = -INFINITY, v1 = -INFINITY, v2 = -INFINITY; int i0 = 255, i1 = 255, i2 = 255;
#define GATE_INS(vv, ii) do { const float v_ = (vv); const int i_ = (ii); \
                if (v_ > v0 || (v_ == v0 && i_ < i0)) { v2 = v1; i2 = i1; v1 = v0; i1 = i0; v0 = v_; i0 = i_; } \
                else if (v_ > v1 || (v_ == v1 && i_ < i1)) { v2 = v1; i2 = i1; v1 = v_; i1 = i_; } \
                else if (v_ > v2 || (v_ == v2 && i_ < i2)) { v2 = v_; i2 = i_; } } while (0)
#pragma unroll
            for (int r = 0; r < 16; ++r) { const int n = (r & 3) + 8 * (r >> 2) + 4 * hi; GATE_INS(n < qb ? acc[r] : -INFINITY, n); }
            { const float p0 = __shfl_xor(v0, 32), p1 = __shfl_xor(v1, 32), p2 = __shfl_xor(v2, 32); const int j0 = __shfl_xor(i0, 32), j1 = __shfl_xor(i1, 32), j2 = __shfl_xor(i2, 32);
              GATE_INS(p0, j0); GATE_INS(p1, j1); GATE_INS(p2, j2); }
#undef GATE_INS
            const int nv = qb < 3 ? qb : 3;
            if (hi == 0) sel[(size_t)(b * 8 + h) * SEQ + ((rb * 64 + 32 * t + c) & (SEQ - 1))] = (unsigned)(i0 & 255) | ((unsigned)(i1 & 255) << 8) | ((unsigned)(i2 & 255) << 16) | ((unsigned)nv << 24);
        }
        asm volatile("" ::: "memory");
    }
}
__device__ __forceinline__ void ph_gla_scan(Frame& F, bool probe = false) {
    const int tid = tid_now(), lane = tid & 63, wave = __builtin_amdgcn_readfirstlane(tid >> 6); (void)lane; (void)wave;
    unsigned char* const wsl = opaque(F.ws);
    bf16* GK = (bf16*)(wsl + WS_GLA); const float* DEC = (const float*)(wsl + WS_DEC);
    const int e = blockIdx.x * 512 + tid;
    const int bh = e >> 13, dv = e & 8191, d = dv & 63;
    LAS float* dl = (LAS float*)F.lds;
    { const f32x4* src = (const f32x4*)(DEC + (size_t)bh * 128 * 64);
#pragma unroll
      for (int i = 0; i < 4; ++i) ((LAS f32x4*)dl)[tid + 512 * i] = src[tid + 512 * i]; }
    bf16* p = GK + (size_t)bh * 128 * 8192 + dv;
    float kv[64], kn[64];
#pragma unroll
    for (int i = 0; i < 64; ++i) kv[i] = bf1(p[(size_t)i * 8192]);
    __syncthreads();
    float st = 0.f;
#pragma unroll 1
    for (int n0 = 0; n0 < 128; n0 += 64) {
        const int nn = (n0 + 64 < 128) ? n0 + 64 : n0;
#pragma unroll
        for (int i = 0; i < 64; ++i) kn[i] = bf1(p[(size_t)(nn + i) * 8192]);
#pragma unroll
        for (int i = 0; i < 64; ++i) { (probe ? (bf16*)(wsl + WS_PC) + (p - GK) : p)[(size_t)(n0 + i) * 8192] = (bf16)f2bf(st); st = dl[(n0 + i) * 64 + d] * st + kv[i]; }
#pragma unroll
        for (int i = 0; i < 64; ++i) kv[i] = kn[i];
    }
    __syncthreads();
}
__device__ __forceinline__ void ph_moba_attn(Frame& F) {
    const int tid = tid_now(), lane = tid & 63, wave = __builtin_amdgcn_readfirstlane(tid >> 6); (void)lane; (void)wave;
    unsigned char* const wsl = opaque(F.ws);
    const bf16* Pa = (const bf16*)(wsl + WS_PA); const unsigned* sel = (const unsigned*)(wsl + WS_SEL); bf16* Y = (bf16*)(wsl + WS_Y);
    LAS float* pl = (LAS float*)(F.lds + wave * 8192);
    const LAS float* bias2 = (const LAS float*)(F.lds + LTAB_OFF);
    const LAS int* bucket = (const LAS int*)(F.lds + LTAB_OFF + 1024);
    const int gw = blockIdx.x * 8 + wave, NGW = F.G * 8;
    for (int it = gw; it < T_ * 8; it += NGW) {
        const int r = it >> 3, h = it & 7, b = r >> 13, s = r & (SEQ - 1), qb = s >> 8;
        const unsigned sw = sel[(size_t)(b * 8 + h) * SEQ + s]; const int nv = (int)(sw >> 24);
        float q[64];
#pragma unroll
        for (int c = 0; c < 8; ++c) { float t8[8]; unpack8(*(const u32x4*)(Pa + (size_t)r * NPA + h * 64 + c * 8), t8);
#pragma unroll
            for (int e = 0; e < 8; ++e) q[c * 8 + e] = t8[e]; }
        float sc[4][4]; float mx = -INFINITY;
#pragma unroll
        for (int i = 0; i < 4; ++i) {
            const bool valid = (i < 3) ? (i < nv) : true;
            const int blk = (i < 3) ? (int)((sw >> (8 * i)) & 0xffu) : qb;
            if (valid) {
#pragma unroll
                for (int kk = 0; kk < 4; ++kk) {
                    const int kpos = blk * 256 + lane + 64 * kk;
                    const bf16* kp = Pa + (size_t)(b * SEQ + kpos) * NPA + 512 + h * 64;
                    float d = 0.f;
#pragma unroll
                    for (int c = 0; c < 8; ++c) { float t8[8]; unpack8(*(const u32x4*)(kp + c * 8), t8);
#pragma unroll
                        for (int e = 0; e < 8; ++e) d += q[c * 8 + e] * t8[e]; }
                    const int rel = s - kpos;
                    const float v = (rel < 0) ? -INFINITY : d + bias2[h * 32 + bucket[rel > 255 ? 255 : rel]];
                    sc[i][kk] = v; mx = fmaxf(mx, v);
                    asm volatile("" ::: "memory");
                }
            } else {
#pragma unroll
                for (int kk = 0; kk < 4; ++kk) sc[i][kk] = -INFINITY;
            }
        }
        mx = wave_max(mx);
        float ls = 0.f;
#pragma unroll
        for (int i = 0; i < 4; ++i)
#pragma unroll
            for (int kk = 0; kk < 4; ++kk) { const float p = __builtin_amdgcn_exp2f(sc[i][kk] - mx); ls += p; pl[i * 256 + lane + 64 * kk] = p; }
        ls = wave_sum(ls);
        LDS_WAIT(); asm volatile("" ::: "memory");
        float acc[8];
#pragma unroll
        for (int e = 0; e < 8; ++e) acc[e] = 0.f;
#pragma unroll
        for (int i = 0; i < 4; ++i) {
            const bool valid = (i < 3) ? (i < nv) : true;
            const int blk = (i < 3) ? (int)((sw >> (8 * i)) & 0xffu) : qb;
            if (valid) {
                const bf16* vp = Pa + (size_t)(b * SEQ + blk * 256 + (lane >> 3)) * NPA + 1024 + h * 64 + (lane & 7) * 8;
#pragma unroll 4
                for (int k0 = 0; k0 < 256; k0 += 8) {
                    const float p = pl[i * 256 + k0 + (lane >> 3)];
                    float t8[8]; unpack8(*(const u32x4*)(vp + (size_t)k0 * NPA), t8);
#pragma unroll
                    for (int e = 0; e < 8; ++e) acc[e] += p * t8[e];
                }
            }
        }
#pragma unroll
        for (int e = 0; e < 8; ++e) { acc[e] += __shfl_xor(acc[e], 8); acc[e] += __shfl_xor(acc[e], 16); acc[e] += __shfl_xor(acc[e], 32); }
        const float inv = 1.f / ls;
        if (lane < 8) { float o[8];
#pragma unroll
            for (int e = 0; e < 8; ++e) o[e] = acc[e] * inv;
            *(u32x4*)(Y + (size_t)r * NYC + 512 + h * 64 + lane * 8) = pack8(o); }
        asm volatile("" ::: "memory");
    }
}

namespace moba {
typedef float f32x16 __attribute__((ext_vector_type(16)));
constexpr int KPB = 144;
typedef short s16x4 __attribute__((ext_vector_type(4)));
constexpr int L_K = 0, L_V = 36864, L_TB = 73728, L_LIST = 75776, L_OST = 92160, L_WS = LTAB_OFF, L_CNT = LTAB_OFF + 4096;
constexpr int OSP = 72;
constexpr int OFP = 68;
__device__ __forceinline__ int crow(int r, int hi) { return (r & 3) + 8 * (r >> 2) + 4 * hi; }
__device__ __forceinline__ unsigned cvtpk(float lo, float hi) { typedef float f32x2_c __attribute__((ext_vector_type(2))); typedef __bf16 bf16x2_c __attribute__((ext_vector_type(2))); const f32x2_c v = {lo, hi}; const bf16x2_c b = __builtin_convertvector(v, bf16x2_c); return __builtin_bit_cast(unsigned, b); }

__device__ __forceinline__ bf16x8 v_frag(const LAS unsigned char* lds, int k0, int dc, int lane) {
    const int li = lane & 15, q = li >> 2, p = li & 3, g1 = (lane >> 4) & 1, hi = lane >> 5;
    const LAS unsigned char* a = lds + L_V + (k0 + 4 * hi + q) * KPB + (32 * dc + 16 * g1 + 4 * p) * 2;
    const s16x4 b0 = __builtin_amdgcn_ds_read_tr16_b64_v4i16((LAS s16x4*)a), b1 = __builtin_amdgcn_ds_read_tr16_b64_v4i16((LAS s16x4*)(a + 8 * KPB));
    return __builtin_shufflevector(b0, b1, 0, 1, 2, 3, 4, 5, 6, 7);
}
__device__ __forceinline__ void stage_kv(LAS unsigned char* lds, const bf16* Pa, int krow0, int h, const float* relb, int tid) {
#pragma unroll
    for (int i = 0; i < 4; ++i) { const int id = tid + 512 * i, kv = id >> 3, dc = id & 7;
        const bf16* src = Pa + (size_t)(krow0 + kv) * NPA + h * 64 + dc * 8;
        const u32x4 kw = *(const u32x4*)(src + 512), vw = *(const u32x4*)(src + 1024);
        *(LAS u32x4*)(lds + L_K + kv * KPB + dc * 16) = kw;
        *(LAS u32x4*)(lds + L_V + kv * KPB + dc * 16) = vw; }
    if (tid < 256) { const int n = tid; int bq; if (n < 16) bq = n; else { const float sc = logf((float)n / 16.0f) / 2.0794415416798357f; bq = 16 + (int)(sc * 16.0f); if (bq > 31) bq = 31; }
        ((LAS float*)(lds + L_TB))[256 + n] = relb[bq * 8 + h] * LOG2E; ((LAS float*)(lds + L_TB))[n] = -INFINITY; }
}

template <bool OWN>
__device__ __forceinline__ void tile_attn(const LAS unsigned char* lds, const bf16x8 (&qf)[4], int c, int hi, int w, int relbase, bool nearb, float negmb, float& l_out, f32x16 (&o)[2]) {
    const LAS float* tb = (const LAS float*)(lds + L_TB);
    const float c31 = tb[511];
    f32x16 negm;
#pragma unroll
    for (int r = 0; r < 16; ++r) negm[r] = negmb;
#pragma unroll
    for (int dc = 0; dc < 2; ++dc)
#pragma unroll
        for (int r = 0; r < 16; ++r) o[dc][r] = 0.f;
    float l = 0.f;
    const bool anynear = OWN ? true : (__any(nearb) != 0);
    const int tend = OWN ? w + 1 : 8;
#pragma unroll 1
    for (int t = 0; t < tend; ++t) {
        {
            f32x16 p = negm;
#pragma unroll
            for (int st = 0; st < 4; ++st) { const bf16x8 kf = *(const LAS bf16x8*)(lds + L_K + (32 * t + c) * KPB + st * 32 + hi * 16); p = __builtin_amdgcn_mfma_f32_32x32x16_bf16(kf, qf[st], p, 0, 0, 0); }
            if (OWN) {
                if (t >= w - 4) {
                    int rb = relbase; asm volatile("" : "+v"(rb));
#pragma unroll
                    for (int r = 0; r < 16; ++r) { int idx = rb - (32 * t + crow(r, hi)) + 256; idx = idx > 511 ? 511 : idx; p[r] += tb[idx]; }
                } else {
#pragma unroll
                    for (int r = 0; r < 16; ++r) p[r] += c31;
                }
            } else if (t >= 4 && anynear) {
                int rb = relbase; asm volatile("" : "+v"(rb));
#pragma unroll
                for (int r = 0; r < 16; ++r) { int idx = rb - (32 * t + crow(r, hi)) + 256; idx = idx > 511 ? 511 : idx; p[r] += tb[idx] - c31; }
            }
#pragma unroll
            for (int r = 0; r < 16; ++r) { const float e = __builtin_amdgcn_exp2f(p[r]); l += e; p[r] = e; }
#pragma unroll
            for (int s2 = 0; s2 < 2; ++s2) {
                u32x4 aw; aw.x = cvtpk(p[8 * s2 + 0], p[8 * s2 + 1]); aw.y = cvtpk(p[8 * s2 + 2], p[8 * s2 + 3]); aw.z = cvtpk(p[8 * s2 + 4], p[8 * s2 + 5]); aw.w = cvtpk(p[8 * s2 + 6], p[8 * s2 + 7]);
                const bf16x8 af = __builtin_bit_cast(bf16x8, aw);
#pragma unroll
                for (int dc = 0; dc < 2; ++dc) {
                    o[dc] = __builtin_amdgcn_mfma_f32_32x32x16_bf16(af, v_frag(lds, 32 * t + 16 * s2, dc, 32 * hi + c), o[dc], 0, 0, 0);
                }
            }
            __builtin_amdgcn_sched_barrier(0);
        }
    }
    l += __shfl_xor(l, 32);
    l_out = l;
}
__device__ __forceinline__ void tile_attn2(const LAS unsigned char* lds, const bf16x8 (&qa)[4], const bf16x8 (&qb)[4], int c, int hi, int relA, int relB, bool anynear, float negA, float negB,
                                           float& lA_out, float& lB_out, f32x16 (&oa)[2], f32x16 (&ob)[2]) {
    const LAS float* tb = (const LAS float*)(lds + L_TB);
    const float c31 = tb[511];
#pragma unroll
    for (int dc = 0; dc < 2; ++dc)
#pragma unroll
        for (int r = 0; r < 16; ++r) { oa[dc][r] = 0.f; ob[dc][r] = 0.f; }
    float lA = 0.f, lB = 0.f;
#pragma unroll 1
    for (int t = 0; t < 8; ++t) {
        f32x16 pa, pb;
#pragma unroll
        for (int r = 0; r < 16; ++r) { pa[r] = negA; pb[r] = negB; }
#pragma unroll
        for (int st = 0; st < 4; ++st) { const bf16x8 kf = *(const LAS bf16x8*)(lds + L_K + (32 * t + c) * KPB + st * 32 + hi * 16);
            pa = __builtin_amdgcn_mfma_f32_32x32x16_bf16(kf, qa[st], pa, 0, 0, 0); pb = __builtin_amdgcn_mfma_f32_32x32x16_bf16(kf, qb[st], pb, 0, 0, 0); }
        if (t >= 4 && anynear) {
            int ra = relA, rb = relB; asm volatile("" : "+v"(ra), "+v"(rb));
#pragma unroll
            for (int r = 0; r < 16; ++r) { int ia = ra - (32 * t + crow(r, hi)) + 256; ia = ia > 511 ? 511 : ia; pa[r] += tb[ia] - c31; if ((r & 7) == 7) __builtin_amdgcn_sched_barrier(0); }
#pragma unroll
            for (int r = 0; r < 16; ++r) { int ib = rb - (32 * t + crow(r, hi)) + 256; ib = ib > 511 ? 511 : ib; pb[r] += tb[ib] - c31; if ((r & 7) == 7) __builtin_amdgcn_sched_barrier(0); }
        }
#pragma unroll
        for (int r = 0; r < 16; ++r) { const float ea = __builtin_amdgcn_exp2f(pa[r]); lA += ea; pa[r] = ea; const float eb = __builtin_amdgcn_exp2f(pb[r]); lB += eb; pb[r] = eb; }
#pragma unroll
        for (int s2 = 0; s2 < 2; ++s2) {
            u32x4 aw; aw.x = cvtpk(pa[8 * s2 + 0], pa[8 * s2 + 1]); aw.y = cvtpk(pa[8 * s2 + 2], pa[8 * s2 + 3]); aw.z = cvtpk(pa[8 * s2 + 4], pa[8 * s2 + 5]); aw.w = cvtpk(pa[8 * s2 + 6], pa[8 * s2 + 7]);
            u32x4 bw2; bw2.x = cvtpk(pb[8 * s2 + 0], pb[8 * s2 + 1]); bw2.y = cvtpk(pb[8 * s2 + 2], pb[8 * s2 + 3]); bw2.z = cvtpk(pb[8 * s2 + 4], pb[8 * s2 + 5]); bw2.w = cvtpk(pb[8 * s2 + 6], pb[8 * s2 + 7]);
            const bf16x8 afa = __builtin_bit_cast(bf16x8, aw), afb = __builtin_bit_cast(bf16x8, bw2);
#pragma unroll
            for (int dc = 0; dc < 2; ++dc) {
                const bf16x8 vf = v_frag(lds, 32 * t + 16 * s2, dc, 32 * hi + c);
                oa[dc] = __builtin_amdgcn_mfma_f32_32x32x16_bf16(afa, vf, oa[dc], 0, 0, 0); ob[dc] = __builtin_amdgcn_mfma_f32_32x32x16_bf16(afb, vf, ob[dc], 0, 0, 0);
            }
        }
    }
    lA += __shfl_xor(lA, 32); lB += __shfl_xor(lB, 32);
    lA_out = lA; lB_out = lB;
}
__device__ __forceinline__ float shift_bound(const bf16x8 (&qf)[4], float kb) {
    float n2 = 0.f;
#pragma unroll
    for (int st = 0; st < 4; ++st) { const u32x4 w = __builtin_bit_cast(u32x4, qf[st]);
        const float a0 = bflo(w.x), a1 = bfhi(w.x), a2 = bflo(w.y), a3 = bfhi(w.y), a4 = bflo(w.z), a5 = bfhi(w.z), a6 = bflo(w.w), a7 = bfhi(w.w);
        n2 += (a0 * a0 + a1 * a1) + (a2 * a2 + a3 * a3) + (a4 * a4 + a5 * a5) + (a6 * a6 + a7 * a7); }
    n2 += __shfl_xor(n2, 32);
    return sqrtf(n2) * kb;
}
__device__ __forceinline__ float key_norm_bound(const float* kgain, int lane) {
    float g = fabsf(kgain[lane]);
#pragma unroll
    for (int off = 1; off < 64; off <<= 1) g = fmaxf(g, __shfl_xor(g, off));
    return 8.16f * g;
}
}

__device__ __forceinline__ void ph_moba_routed(Frame& F, int l) {
    const int tid = tid_now(), lane = tid & 63, wave = __builtin_amdgcn_readfirstlane(tid >> 6); (void)lane; (void)wave;
    unsigned char* const wsl = opaque(F.ws);
    using namespace moba;
    const bf16* Pa = (const bf16*)(wsl + WS_PA); const unsigned* sel = (const unsigned*)(wsl + WS_SEL);
    bf16* OP = (bf16*)(wsl + WS_OP); float* ML = (float*)(wsl + WS_ML);
    const float* relb = F.inp(1);
    LAS unsigned char* lds = F.lds;
    LAS unsigned short* list = (LAS unsigned short*)(lds + L_LIST);
    LAS unsigned* cnt = (LAS unsigned*)(lds + L_CNT);
    const int c = lane & 31, hi = lane >> 5;
    const float kb = key_norm_bound(F.inp(7) + l * 64, lane);
    SP_T0();
    for (;;) {
        __syncthreads();
        SP_ADD(3);
        if (tid == 0) { cnt[0] = 0u; cnt[1] = __hip_atomic_fetch_add(F.ctl + CW_Q + l, 1u, RLX_AGENT); }
        __syncthreads();
        SP_ADD(0);
        int u = (int)cnt[1];
        if (u >= 31 * 32 * (((REP_MASK >> 6) & 1u) ? 2 : 1)) break;
        u %= 31 * 32;
        const int n = u >> 5, bh = u & 31, b = bh >> 3, h = bh & 7;
        int tl = tid; asm volatile("" : "+v"(tl));
        const unsigned* sp = sel + (size_t)bh * SEQ;
        __builtin_amdgcn_sched_barrier(0);
        unsigned wvs[16];
#pragma unroll
        for (int k = 0; k < 16; ++k) { const int s = (n + 1) * 256 + 512 * k + tid; wvs[k] = (s < SEQ) ? sp[s] : 0u; }
        __builtin_amdgcn_sched_barrier(0);
        stage_kv(lds, Pa, b * SEQ + n * 256, h, relb, tl);
        __builtin_amdgcn_sched_barrier(0);
        { int slots[16]; unsigned tot = 0u;
#pragma unroll
          for (int k = 0; k < 16; ++k) { const unsigned wv = wvs[k]; const int nv = (int)(wv >> 24); int slot = -1;
              if (nv > 0 && (int)(wv & 0xffu) == n) slot = 0; else if (nv > 1 && (int)((wv >> 8) & 0xffu) == n) slot = 1; else if (nv > 2 && (int)((wv >> 16) & 0xffu) == n) slot = 2;
              slots[k] = slot; tot += (unsigned)__popcll(__ballot(slot >= 0)); }
          unsigned base = 0u;
          if (lane == 0 && tot) base = __hip_atomic_fetch_add(&cnt[0], tot, __ATOMIC_RELAXED, __HIP_MEMORY_SCOPE_WORKGROUP);
          base = __shfl(base, 0);
#pragma unroll
          for (int k = 0; k < 16; ++k) { const unsigned long long bal = __ballot(slots[k] >= 0);
              if (slots[k] >= 0) list[base + __popcll(bal & ((1ull << lane) - 1ull))] = (unsigned short)((((n + 1) * 256 + 512 * k + tid) << 2) | slots[k]);
              base += (unsigned)__popcll(bal); } }
        __syncthreads();
        SP_ADD(1);
        const int L = (int)cnt[0];
        const float c31 = ((const LAS float*)(lds + L_TB))[511];
        LAS bf16* ost = (LAS bf16*)(lds + L_OST + wave * 4608);
        bf16x8 qna[4], qnb[4]; unsigned ena = 0u, enb = 0u;
#define LOAD_PAIR(pr) do { int qa_ = (pr) * 64 + c, qb_ = qa_ + 32; qa_ = qa_ < L ? qa_ : L - 1; qb_ = qb_ < L ? qb_ : L - 1; ena = list[qa_]; enb = list[qb_]; \
            const bf16* pa_ = Pa + (size_t)(b * SEQ + (int)(ena >> 2)) * NPA + h * 64 + hi * 8; const bf16* pb_ = Pa + (size_t)(b * SEQ + (int)(enb >> 2)) * NPA + h * 64 + hi * 8; \
            _Pragma("unroll") for (int st = 0; st < 4; ++st) { qna[st] = *(const bf16x8*)(pa_ + st * 16); qnb[st] = *(const bf16x8*)(pb_ + st * 16); } } while (0)
        if (wave * 64 < L) LOAD_PAIR(wave);
        for (int pr = wave; pr * 64 < L; pr += 8) {
            const unsigned entA = ena, entB = enb;
            bf16x8 qfa[4], qfb[4];
#pragma unroll
            for (int st = 0; st < 4; ++st) { qfa[st] = qna[st]; qfb[st] = qnb[st]; }
            const int sA = (int)(entA >> 2), sB = (int)(entB >> 2);
            const bool anynear = __any(((sA >> 8) == n + 1) || ((sB >> 8) == n + 1)) != 0;
            float lsA, lsB; f32x16 oa[2], ob[2];
            const float mA = shift_bound(qfa, kb), mB = shift_bound(qfb, kb);
            tile_attn2(lds, qfa, qfb, c, hi, sA - n * 256, sB - n * 256, anynear, -mA, -mB, lsA, lsB, oa, ob);
#define ROUTED_EPI(half, ENT, MM, LL, OO) do { const int tile = 2 * pr + (half); const unsigned ent = (ENT); const int s = (int)(ent >> 2), slot = (int)(ent & 3u); \
                const bool valid = tile * 32 + c < L; \
                if (valid && hi == 0) { float* mp = ML + ((size_t)((b * SEQ + s) * 8 + h) * 3 + slot) * 2; mp[0] = (MM) + c31; mp[1] = (LL); } \
                _Pragma("unroll") for (int dc = 0; dc < 2; ++dc) _Pragma("unroll") for (int r = 0; r < 16; ++r) ost[crow(r, hi) * OSP + 32 * dc + c] = (bf16)f2bf(OO[dc][r]); \
                asm volatile("s_waitcnt lgkmcnt(0)" ::: "memory"); \
                { const int q = lane >> 1, hf = lane & 1; int qj = tile * 32 + q; const bool vq = qj < L; qj = vq ? qj : L - 1; \
                  const unsigned e2 = list[qj]; const int s2 = (int)(e2 >> 2), sl2 = (int)(e2 & 3u); \
                  bf16* dst = OP + ((size_t)((b * SEQ + s2) * 8 + h) * 3 + sl2) * 64 + hf * 32; \
                  if (vq) { _Pragma("unroll") for (int i = 0; i < 4; ++i) *(u32x4*)(dst + i * 8) = *(const LAS u32x4*)(ost + q * OSP + hf * 32 + i * 8); } } \
                asm volatile("s_waitcnt lgkmcnt(0)" ::: "memory"); } while (0)
            __builtin_amdgcn_sched_barrier(0);
            if ((pr + 8) * 64 < L) LOAD_PAIR(pr + 8);
            __builtin_amdgcn_sched_barrier(0);
            ROUTED_EPI(0, entA, mA, lsA, oa);
            __builtin_amdgcn_sched_barrier(0);
            ROUTED_EPI(1, entB, mB, lsB, ob);
#undef ROUTED_EPI
        }
#undef LOAD_PAIR
        SP_ADD(2);
    }
}
__device__ __forceinline__ void ph_moba_own(Frame& F, int l) {
    const int tid = tid_now(), lane = tid & 63, wave = __builtin_amdgcn_readfirstlane(tid >> 6); (void)lane; (void)wave;
    unsigned char* const wsl = opaque(F.ws);
    using namespace moba;
    const bf16* Pa = (const bf16*)(wsl + WS_PA); const unsigned* sel = (const unsigned*)(wsl + WS_SEL);
    const bf16* OP = (const bf16*)(wsl + WS_OP); const float* ML = (const float*)(wsl + WS_ML); bf16* Y = (bf16*)(wsl + WS_Y);
    const float* relb = F.inp(1);
    LAS unsigned char* lds = F.lds;
    const int c = lane & 31, hi = lane >> 5;
    const float kb = key_norm_bound(F.inp(7) + l * 64, lane);
    bf16x8 qf[4], qfn[4]; unsigned wv, wvn; float msr[3], lsr[3], msrn[3], lsrn[3];
    u32x4 kwv[4], vwv[4]; float tbv = 0.f;
#define OWN_LOAD_Q(U, QF, WV, MSR, LSR) do { const int bh_ = (U) >> 5, qb_ = (U) & 31, b_ = bh_ >> 3, h_ = bh_ & 7, s_ = qb_ * 256 + wave * 32 + c; \
        const bf16* qp_ = Pa + (size_t)(b_ * SEQ + s_) * NPA + h_ * 64 + hi * 8; \
        _Pragma("unroll") for (int st = 0; st < 4; ++st) QF[st] = *(const bf16x8*)(qp_ + st * 16); \
        WV = sel[(size_t)bh_ * SEQ + s_]; \
        _Pragma("unroll") for (int j = 0; j < 3; ++j) { const float* mp = ML + ((size_t)((b_ * SEQ + s_) * 8 + h_) * 3 + j) * 2; MSR[j] = mp[0]; LSR[j] = mp[1]; } } while (0)
#define OWN_LOAD_KV(U) do { const int bh_ = (U) >> 5, qb_ = (U) & 31, b_ = bh_ >> 3, h_ = bh_ & 7; \
        _Pragma("unroll") for (int i = 0; i < 4; ++i) { const int id = tid + 512 * i, kv = id >> 3, dc = id & 7; const bf16* src = Pa + (size_t)(b_ * SEQ + qb_ * 256 + kv) * NPA + h_ * 64 + dc * 8; \
            kwv[i] = *(const u32x4*)(src + 512); vwv[i] = *(const u32x4*)(src + 1024); } \
        if (tid < 256) { const int n = tid; int bq; if (n < 16) bq = n; else { const float sc = logf((float)n / 16.0f) / 2.0794415416798357f; bq = 16 + (int)(sc * 16.0f); if (bq > 31) bq = 31; } tbv = relb[bq * 8 + h_] * LOG2E; } } while (0)
    OWN_LOAD_Q((int)blockIdx.x, qf, wv, msr, lsr); OWN_LOAD_KV((int)blockIdx.x);
    for (int u = blockIdx.x; u < 1024; u += F.G) {
        const int bh = u >> 5, qb = u & 31, b = bh >> 3, h = bh & 7;
        const int nv = (int)(wv >> 24);
        __syncthreads();
#pragma unroll
        for (int i = 0; i < 4; ++i) { const int id = tid + 512 * i, kv = id >> 3, dc = id & 7;
            *(LAS u32x4*)(lds + L_K + kv * KPB + dc * 16) = kwv[i]; *(LAS u32x4*)(lds + L_V + kv * KPB + dc * 16) = vwv[i]; }
        if (tid < 256) { ((LAS float*)(lds + L_TB))[256 + tid] = tbv; ((LAS float*)(lds + L_TB))[tid] = -INFINITY; }
        __syncthreads();
        u32x4 opw[2][3];
#pragma unroll
        for (int it = 0; it < 2; ++it) { const int q = it * 8 + (lane >> 3), ch = lane & 7, sq = qb * 256 + wave * 32 + q;
            const bf16* pp = OP + ((size_t)((b * SEQ + sq) * 8 + h) * 3) * 64 + ch * 8;
#pragma unroll
            for (int j = 0; j < 3; ++j) opw[it][j] = *(const u32x4*)(pp + j * 64); }
        __builtin_amdgcn_sched_barrier(0);
        if (u + F.G < 1024) { OWN_LOAD_Q(u + F.G, qfn, wvn, msrn, lsrn); OWN_LOAD_KV(u + F.G); }
        __builtin_amdgcn_sched_barrier(0);
        float ls; f32x16 o[2];
        int relb_own = wave * 32 + c; asm volatile("" : "+v"(relb_own));
        const float m = shift_bound(qf, kb);
        tile_attn<true>(lds, qf, c, hi, wave, relb_own, true, -m, ls, o);
        asm volatile("" ::: "memory");
        float ms[3], lsv[3]; float M = m;
#pragma unroll
        for (int j = 0; j < 3; ++j) { ms[j] = (j < nv) ? msr[j] : -INFINITY; lsv[j] = (j < nv) ? lsr[j] : 0.f; M = fmaxf(M, ms[j]); }
        u32x4 opw2[2][3];
#pragma unroll
        for (int it = 2; it < 4; ++it) { const int q = it * 8 + (lane >> 3), ch = lane & 7, sq = qb * 256 + wave * 32 + q;
            const bf16* pp = OP + ((size_t)((b * SEQ + sq) * 8 + h) * 3) * 64 + ch * 8;
#pragma unroll
            for (int j = 0; j < 3; ++j) opw2[it - 2][j] = *(const u32x4*)(pp + j * 64); }
        const float a_own = __builtin_amdgcn_exp2f(m - M); float a[3]; float Ls = a_own * ls;
#pragma unroll
        for (int j = 0; j < 3; ++j) { a[j] = (j < nv) ? __builtin_amdgcn_exp2f(ms[j] - M) : 0.f; Ls += a[j] * lsv[j]; }
        const float inv = Ls > 0.f ? 1.f / Ls : 0.f;
        __syncthreads();
        LAS float* fsc = (LAS float*)(lds + L_WS + wave * 512);
        if (hi == 0) { *(LAS f32x4*)(fsc + c * 4) = (f32x4){a_own * inv, a[0] * inv, a[1] * inv, a[2] * inv}; }
        LAS float* of = (LAS float*)(lds + wave * (32 * OFP * 4));
#pragma unroll
        for (int dc = 0; dc < 2; ++dc)
#pragma unroll
            for (int r = 0; r < 16; ++r) of[crow(r, hi) * OFP + 32 * dc + c] = o[dc][r];
        asm volatile("s_waitcnt lgkmcnt(0)" ::: "memory");
#pragma unroll
        for (int it = 0; it < 4; ++it) {
            const int q = it * 8 + (lane >> 3), ch = lane & 7, sq = qb * 256 + wave * 32 + q;
            const f32x4 f = *(const LAS f32x4*)(fsc + q * 4);
            const f32x4 o0 = *(const LAS f32x4*)(of + q * OFP + ch * 8), o1 = *(const LAS f32x4*)(of + q * OFP + ch * 8 + 4);
            float v[8] = {o0.x * f.x, o0.y * f.x, o0.z * f.x, o0.w * f.x, o1.x * f.x, o1.y * f.x, o1.z * f.x, o1.w * f.x};
#pragma unroll
            for (int j = 0; j < 3; ++j) { const float fj = f[1 + j]; float t8[8]; unpack8(it < 2 ? opw[it & 1][j] : opw2[it & 1][j], t8);
#pragma unroll
                for (int e = 0; e < 8; ++e) v[e] += (fj != 0.f) ? fj * t8[e] : 0.f; }
            *(u32x4*)(Y + (size_t)(b * SEQ + sq) * NYC + 512 + h * 64 + ch * 8) = pack8(v);
        }
#pragma unroll
        for (int st = 0; st < 4; ++st) qf[st] = qfn[st];
        wv = wvn;
#pragma unroll
        for (int j = 0; j < 3; ++j) { msr[j] = msrn[j]; lsr[j] = lsrn[j]; }
    }
#undef OWN_LOAD_Q
#undef OWN_LOAD_KV
}

namespace gla {
typedef float f32x16 __attribute__((ext_vector_type(16)));
constexpr int G_ZS = 0, G_WA = 4096, G_BA = 20480, G_GS = 21504, G_QE = 24576, G_KE = 43008, G_VT = 61440, G_RED = 98304, G_GN = 99328;
constexpr int PB = 144;
__device__ __forceinline__ int crow(int r, int hi) { return (r & 3) + 8 * (r >> 2) + 4 * hi; }
__device__ __forceinline__ unsigned cvtpk(float lo, float hi) { typedef float f32x2_c __attribute__((ext_vector_type(2))); typedef __bf16 bf16x2_c __attribute__((ext_vector_type(2))); const f32x2_c v = {lo, hi}; const bf16x2_c b = __builtin_convertvector(v, bf16x2_c); return __builtin_bit_cast(unsigned, b); }
__device__ __forceinline__ void load_alpha(Frame& F, LAS unsigned char* lds, int l, int tid) {
    LAS float* wa = (LAS float*)(lds + G_WA); LAS float* ba = (LAS float*)(lds + G_BA);
    const float* wal = F.inp(8) + (size_t)l * 16 * 256; const float* bal = F.inp(9) + l * 256;
    for (int i = tid; i < 4096; i += 512) { const int h = i >> 10, rr = (i >> 6) & 15, dd = i & 63; wa[i] = wal[rr * 256 + h * 64 + dd]; }
    if (tid < 256) ba[tid] = bal[tid];
}
__device__ __forceinline__ float gates(LAS unsigned char* lds, int hp, int tid, float (&bc)[16]) {
    const LAS float* zs = (const LAS float*)(lds + G_ZS); const LAS float* wa = (const LAS float*)(lds + G_WA) + (2 * hp) * 1024; const LAS float* ba = (const LAS float*)(lds + G_BA) + (2 * hp) * 64; LAS float* gs = (LAS float*)(lds + G_GS);
    const int hh = tid >> 8, jg = (tid >> 6) & 3, d = tid & 63;
    float run = 0.f;
#pragma unroll
    for (int jj = 0; jj < 16; ++jj) { const int j = 16 * jg + jj; float x = ba[hh * 64 + d];
#pragma unroll
        for (int rr = 0; rr < 16; ++rr) x += zs[j * 16 + rr] * wa[(hh * 16 + rr) * 64 + d];
        const float ls = fminf(x, 0.f) - __logf(1.f + __expf(-fabsf(x)));
        run += ls * (1.f / 16.f); bc[jj] = run; }
    gs[(hh * 4 + jg) * 64 + d] = run;
    __syncthreads();
    float off = 0.f, tot = 0.f;
#pragma unroll
    for (int g = 0; g < 4; ++g) { const float v = gs[(hh * 4 + g) * 64 + d]; tot += v; off += (g < jg) ? v : 0.f; }
#pragma unroll
    for (int jj = 0; jj < 16; ++jj) bc[jj] += off;
    return tot;
}
__device__ __forceinline__ void load_v(const bf16* Pg, int r0, int hp, int tid, u32x4 (&vw)[4]) {
#pragma unroll
    for (int i = 0; i < 4; ++i) { const int id = tid + 512 * i, j = id >> 5, vc = id & 31; vw[i] = *(const u32x4*)(Pg + (size_t)(r0 + j) * NPG + 512 + hp * 256 + vc * 8); }
}
constexpr int VP = 576;
typedef short s16x4 __attribute__((ext_vector_type(4)));
__device__ __forceinline__ void store_vt(LAS unsigned char* lds, int tid, const u32x4 (&vw)[4]) {
#pragma unroll
    for (int i = 0; i < 4; ++i) { const int id = tid + 512 * i, j = id >> 5, vc = id & 31; *(LAS u32x4*)(lds + G_VT + j * VP + vc * 16) = vw[i]; }
}
__device__ __forceinline__ s16x4 v_tr4(const LAS unsigned char* lds, int j0, int vbase, int lane) {
    const int li = lane & 15, q = li >> 2, p = li & 3, g1 = (lane >> 4) & 1;
    return __builtin_amdgcn_ds_read_tr16_b64_v4i16((LAS s16x4*)(lds + G_VT + (j0 + q) * VP + (vbase + 16 * g1 + 4 * p) * 2));
}
__device__ __forceinline__ bf16x8 v_tr8(const LAS unsigned char* lds, int j0, int j1, int vbase, int lane) {
    const s16x4 a = v_tr4(lds, j0, vbase, lane), b = v_tr4(lds, j1, vbase, lane);
    return __builtin_shufflevector(a, b, 0, 1, 2, 3, 4, 5, 6, 7);
}
}

__device__ __forceinline__ void ph_gla_kv(Frame& F, int l) {
    using namespace gla;
    const int tid = tid_now(), lane = tid & 63, wave = __builtin_amdgcn_readfirstlane(tid >> 6); (void)lane; (void)wave;
    unsigned char* const wsl = opaque(F.ws);
    const bf16* Pg = (const bf16*)(wsl + WS_PG); bf16* GK = (bf16*)(wsl + WS_GLA); float* DEC = (float*)(wsl + WS_DEC);
    LAS unsigned char* lds = F.lds;
    const int c = lane & 31, hi = lane >> 5;
    const int hh = tid >> 8, jg = (tid >> 6) & 3, d = tid & 63;
    load_alpha(F, lds, l, tid);
    float zr[2]; bf16 kr[16]; u32x4 vw[4];
#define KV_LOADS(U) do { const int hp_ = (U) & 1, cg_ = (U) >> 1, r0_ = (cg_ >> 7) * SEQ + (cg_ & 127) * 64; \
        _Pragma("unroll") for (int i = 0; i < 2; ++i) zr[i] = ((const float*)(wsl + WS_ZB))[(size_t)r0_ * 16 + tid + 512 * i]; \
        _Pragma("unroll") for (int jj = 0; jj < 16; ++jj) kr[jj] = Pg[(size_t)(r0_ + 16 * jg + jj) * NPG + 256 + (2 * hp_ + hh) * 64 + d]; \
        load_v(Pg, r0_, hp_, tid, vw); } while (0)
    KV_LOADS((int)blockIdx.x);
    for (int unit = blockIdx.x; unit < 1024; unit += F.G) {
        const int hp = unit & 1, cg = unit >> 1, b = cg >> 7, ch = cg & 127;
        __syncthreads();
#pragma unroll
        for (int i = 0; i < 2; ++i) ((LAS float*)(lds + G_ZS))[tid + 512 * i] = zr[i];
        __syncthreads();
        float bc[16];
        const float bt = gates(lds, hp, tid, bc);
        { float kd[16];
#pragma unroll
          for (int jj = 0; jj < 16; ++jj) kd[jj] = bf1(kr[jj]) * __expf(bt - bc[jj]);
          LAS unsigned char* dst = lds + G_QE + (hh * 64 + d) * PB + jg * 32;
          u32x4 w0, w1; w0.x = pk2(kd[0], kd[1]); w0.y = pk2(kd[2], kd[3]); w0.z = pk2(kd[4], kd[5]); w0.w = pk2(kd[6], kd[7]);
          w1.x = pk2(kd[8], kd[9]); w1.y = pk2(kd[10], kd[11]); w1.z = pk2(kd[12], kd[13]); w1.w = pk2(kd[14], kd[15]);
          *(LAS u32x4*)dst = w0; *(LAS u32x4*)(dst + 16) = w1; }
        if (jg == 0) DEC[((size_t)((b * 4 + 2 * hp + hh) * 128 + ch)) * 64 + d] = __expf(bt);
        store_vt(lds, tid, vw);
        __builtin_amdgcn_sched_barrier(0);
        if (unit + F.G < 1024) KV_LOADS(unit + F.G);
        __builtin_amdgcn_sched_barrier(0);
        __syncthreads();
        { const int h2 = wave >> 2, vt = wave & 3;
          f32x16 acc[2];
#pragma unroll
          for (int dt = 0; dt < 2; ++dt)
#pragma unroll
              for (int r = 0; r < 16; ++r) acc[dt][r] = 0.f;
#pragma unroll
          for (int ks = 0; ks < 4; ++ks) {
              const bf16x8 af = v_tr8(lds, ks * 16 + 8 * hi, ks * 16 + 8 * hi + 4, h2 * 128 + 32 * vt, lane);
#pragma unroll
              for (int dt = 0; dt < 2; ++dt) { const bf16x8 bfv = *(const LAS bf16x8*)(lds + G_QE + (h2 * 64 + 32 * dt + c) * PB + ks * 32 + hi * 16);
                  acc[dt] = __builtin_amdgcn_mfma_f32_32x32x16_bf16(af, bfv, acc[dt], 0, 0, 0); } }
          bf16* o = GK + ((size_t)((b * 4 + 2 * hp + h2) * 128 + ch)) * 8192;
#pragma unroll
          for (int dt = 0; dt < 2; ++dt)
#pragma unroll
              for (int r = 0; r < 16; ++r) o[(32 * vt + crow(r, hi)) * 64 + 32 * dt + c] = (bf16)f2bf(acc[dt][r]); }
    }
}
#undef KV_LOADS
__device__ __forceinline__ void ph_gla_out(Frame& F, int l) {
    using namespace gla;
    const int tid = tid_now(), lane = tid & 63, wave = __builtin_amdgcn_readfirstlane(tid >> 6); (void)lane; (void)wave;
    unsigned char* const wsl = opaque(F.ws);
    const bf16* Pg = (const bf16*)(wsl + WS_PG); const bf16* GK = (const bf16*)(wsl + WS_GLA); bf16* Y = (bf16*)(wsl + WS_Y);
    LAS unsigned char* lds = F.lds;
    const int c = lane & 31, hi = lane >> 5;
    const int hh = tid >> 8, jg = (tid >> 6) & 3, d = tid & 63;
    const int h2 = wave >> 2, it = (wave >> 1) & 1, vh = wave & 1;
    load_alpha(F, lds, l, tid);
    if (tid < 128) ((LAS float*)(lds + G_GN))[tid] = F.inp(10)[l * 128 + tid];
    float zr[2]; bf16 qr[16], kr[16]; u32x4 vw[4]; bf16x8 spf[2][4]; u32x2 rw[2][4];
#define GO_LOADS_A(U) do { const int hp_ = (U) & 1, cg_ = (U) >> 1, r0_ = (cg_ >> 7) * SEQ + (cg_ & 127) * 64; \
        _Pragma("unroll") for (int i = 0; i < 2; ++i) zr[i] = ((const float*)(wsl + WS_ZB))[(size_t)r0_ * 16 + tid + 512 * i]; \
        _Pragma("unroll") for (int jj = 0; jj < 16; ++jj) { const bf16* p = Pg + (size_t)(r0_ + 16 * jg + jj) * NPG + (2 * hp_ + hh) * 64 + d; qr[jj] = p[0]; kr[jj] = p[256]; } \
        load_v(Pg, r0_, hp_, tid, vw); } while (0)
#define GO_LOADS_B(U) do { const int hp_ = (U) & 1, cg_ = (U) >> 1, b_ = cg_ >> 7, ch_ = cg_ & 127, h_ = 2 * hp_ + h2; const size_t row_ = (size_t)(b_ * SEQ + ch_ * 64 + 32 * it + c); \
        const bf16* sp = GK + ((size_t)((b_ * 4 + h_) * 128 + ch_)) * 8192;         \
        _Pragma("unroll") for (int v2 = 0; v2 < 2; ++v2) _Pragma("unroll") for (int ks = 0; ks < 4; ++ks) spf[v2][ks] = *(const bf16x8*)(sp + (size_t)(32 * (2 * vh + v2) + c) * 64 + ks * 16 + hi * 8); \
        _Pragma("unroll") for (int v2 = 0; v2 < 2; ++v2) _Pragma("unroll") for (int g = 0; g < 4; g += 2) { const u32x4 w4 = *(const u32x4*)(Pg + row_ * NPG + 1024 + h_ * 128 + 32 * (2 * vh + v2) + 8 * g + 8 * hi);     \
            rw[v2][g] = (u32x2){w4.x, w4.y}; rw[v2][g + 1] = (u32x2){w4.z, w4.w}; } } while (0)
    GO_LOADS_A((int)blockIdx.x); GO_LOADS_B((int)blockIdx.x);
    for (int unit = blockIdx.x; unit < 1024; unit += F.G) {
        const int hp = unit & 1, cg = unit >> 1, b = cg >> 7, ch = cg & 127, r0 = b * SEQ + ch * 64, h = 2 * hp + h2;
        const size_t row = (size_t)(r0 + 32 * it + c);
        __syncthreads();
#pragma unroll
        for (int i = 0; i < 2; ++i) ((LAS float*)(lds + G_ZS))[tid + 512 * i] = zr[i];
        __syncthreads();
        float bc[16];
        (void)gates(lds, hp, tid, bc);
#pragma unroll
        for (int jj = 0; jj < 16; ++jj) { const int j = 16 * jg + jj;
            ((LAS bf16*)(lds + G_QE))[(hh * 64 + j) * (PB / 2) + d] = (bf16)f2bf(bf1(qr[jj]) * 0.125f * __expf(bc[jj]));
            ((LAS bf16*)(lds + G_KE))[(hh * 64 + j) * (PB / 2) + d] = (bf16)f2bf(bf1(kr[jj]) * __expf(-bc[jj])); }
        store_vt(lds, tid, vw);
        __builtin_amdgcn_sched_barrier(0);
        if (unit + F.G < 1024) GO_LOADS_A(unit + F.G);
        __builtin_amdgcn_sched_barrier(0);
        __syncthreads();
        f32x16 X[2];
#pragma unroll
        for (int jt = 0; jt < 2; ++jt) {
#pragma unroll
            for (int r = 0; r < 16; ++r) X[jt][r] = 0.f;
            if (jt <= it) {
#pragma unroll
                for (int ks = 0; ks < 4; ++ks) {
                    const bf16x8 af = *(const LAS bf16x8*)(lds + G_KE + (h2 * 64 + 32 * jt + c) * PB + ks * 32 + hi * 16);
                    const bf16x8 bfv = *(const LAS bf16x8*)(lds + G_QE + (h2 * 64 + 32 * it + c) * PB + ks * 32 + hi * 16);
                    X[jt] = __builtin_amdgcn_mfma_f32_32x32x16_bf16(af, bfv, X[jt], 0, 0, 0); }
                if (jt == it) {
#pragma unroll
                    for (int r = 0; r < 16; ++r) X[jt][r] = (crow(r, hi) > c) ? 0.f : X[jt][r]; }
            }
        }
        f32x16 acc[2];
#pragma unroll
        for (int v2 = 0; v2 < 2; ++v2) {
            const int vbase = h2 * 128 + 32 * (2 * vh + v2);
#pragma unroll
            for (int r = 0; r < 16; ++r) acc[v2][r] = 0.f;
#pragma unroll
            for (int ks = 0; ks < 4; ++ks) {
                const bf16x8 bfv = *(const LAS bf16x8*)(lds + G_QE + (h2 * 64 + 32 * it + c) * PB + ks * 32 + hi * 16);
                acc[v2] = __builtin_amdgcn_mfma_f32_32x32x16_bf16(spf[v2][ks], bfv, acc[v2], 0, 0, 0); }
#pragma unroll
            for (int jt = 0; jt < 2; ++jt) if (jt <= it) {
#pragma unroll
                for (int s2 = 0; s2 < 2; ++s2) {
                    u32x4 xw; xw.x = cvtpk(X[jt][8 * s2 + 0], X[jt][8 * s2 + 1]); xw.y = cvtpk(X[jt][8 * s2 + 2], X[jt][8 * s2 + 3]); xw.z = cvtpk(X[jt][8 * s2 + 4], X[jt][8 * s2 + 5]); xw.w = cvtpk(X[jt][8 * s2 + 6], X[jt][8 * s2 + 7]);
                    const bf16x8 af = v_tr8(lds, 32 * jt + 16 * s2 + 4 * hi, 32 * jt + 16 * s2 + 8 + 4 * hi, vbase, lane);
                    acc[v2] = __builtin_amdgcn_mfma_f32_32x32x16_bf16(af, __builtin_bit_cast(bf16x8, xw), acc[v2], 0, 0, 0); } }
        }
        float ss = 0.f;
#pragma unroll
        for (int v2 = 0; v2 < 2; ++v2)
#pragma unroll
            for (int r = 0; r < 16; ++r) ss += acc[v2][r] * acc[v2][r];
        ss += __shfl_xor(ss, 32);
        LAS float* red = (LAS float*)(lds + G_RED);
        if (hi == 0) red[wave * 32 + c] = ss;
        __syncthreads();
        const float rs = rsqrtf((ss + red[(wave ^ 1) * 32 + c]) * (1.f / 128.f) + RMS_EPS);
#pragma unroll
        for (int v2 = 0; v2 < 2; ++v2)
#pragma unroll
            for (int g = 0; g < 4; g += 2) {
                { auto r0 = __builtin_amdgcn_permlane32_swap(rw[v2][g].x, rw[v2][g + 1].x, false, false); rw[v2][g].x = r0[0]; rw[v2][g + 1].x = r0[1];
                  auto r1 = __builtin_amdgcn_permlane32_swap(rw[v2][g].y, rw[v2][g + 1].y, false, false); rw[v2][g].y = r1[0]; rw[v2][g + 1].y = r1[1]; }
                u32x2 ow[2];
#pragma unroll
                for (int gg = 0; gg < 2; ++gg) { const int g2 = g + gg;
                    const f32x4 gn = *(const LAS f32x4*)(lds + G_GN + (32 * (2 * vh + v2) + 8 * g2 + 4 * hi) * 4);
                    const float r0f = bflo(rw[v2][g2].x), r1f = bfhi(rw[v2][g2].x), r2f = bflo(rw[v2][g2].y), r3f = bfhi(rw[v2][g2].y);
                    ow[gg].x = pk2(acc[v2][4 * g2 + 0] * rs * gn.x * (r0f * sigmoidf_(r0f)), acc[v2][4 * g2 + 1] * rs * gn.y * (r1f * sigmoidf_(r1f)));
                    ow[gg].y = pk2(acc[v2][4 * g2 + 2] * rs * gn.z * (r2f * sigmoidf_(r2f)), acc[v2][4 * g2 + 3] * rs * gn.w * (r3f * sigmoidf_(r3f))); }
                { auto r0 = __builtin_amdgcn_permlane32_swap(ow[0].x, ow[1].x, false, false); ow[0].x = r0[0]; ow[1].x = r0[1];
                  auto r1 = __builtin_amdgcn_permlane32_swap(ow[0].y, ow[1].y, false, false); ow[0].y = r1[0]; ow[1].y = r1[1]; }
                *(u32x4*)(Y + row * NYC + 1024 + h * 128 + 32 * (2 * vh + v2) + 8 * g + 8 * hi) = (u32x4){ow[0].x, ow[0].y, ow[1].x, ow[1].y}; }
        __builtin_amdgcn_sched_barrier(0);
        if (unit + F.G < 1024) GO_LOADS_B(unit + F.G);
    }
#undef GO_LOADS_A
#undef GO_LOADS_B
}
__device__ __forceinline__ void ph_norm_router(Frame& F, int l, bool probe = false) {
    const int tid = tid_now(), lane = tid & 63, wave = __builtin_amdgcn_readfirstlane(tid >> 6); (void)lane; (void)wave;
    unsigned char* const wsl = opaque(F.ws);
    const float* gain = F.inp(14) + (size_t)l * 1024; bf16* H = (bf16*)(wsl + WS_H);
    const float* brg = F.inp(16) + l * 4; const float* bre = F.inp(18) + l * 32;
    const bf16* WRh = (const bf16*)(wsl + WS_WR) + (size_t)(l * 2) * 48 * 1024; const bf16* WRl = WRh + 48 * 1024;
    int* toke = (int*)(wsl + WS_TOKE); float* tokw = (float*)(wsl + WS_TOKW);
    LAS unsigned* hist = (LAS unsigned*)(F.lds + LTAB_OFF);
    if (tid < 32) hist[tid] = 0u;
    LAS float* const gl = (LAS float*)(F.lds + 98304);
    for (int i = tid; i < 1024; i += 512) gl[i] = gain[i];
    if (tid < 32) gl[1024 + tid] = bre[tid]; else if (tid < 36) gl[1024 + tid] = brg[tid - 32];
    __syncthreads();
    const int t = lane & 15, kg = lane >> 4;
    for (int tile = blockIdx.x * 8 + wave; tile < T_ / 16; tile += F.G * 8) {
        const int m = tile * 16 + t;
        const float* xr = F.out + (size_t)m * 1024 + kg * 8;
        float ss = 0.f;
        f32x4 acc[3];
#pragma unroll
        for (int nt = 0; nt < 3; ++nt) acc[nt] = (f32x4){0.f, 0.f, 0.f, 0.f};
        bf16* hr = H + (size_t)m * 1024 + kg * 8;
        LAS unsigned char* const wbuf = F.lds;
#define RT_STAGE_W(BQ) do { _Pragma("unroll") for (int j = 0; j < 6; ++j) { const int f = wave + 8 * j, p = f / 24, r = f % 24; \
            const bf16* src = (p ? WRl : WRh) + (size_t)((r >> 3) * 32 + 8 * (BQ) + (r & 7)) * 512 + lane * 8; \
            __builtin_amdgcn_global_load_lds((const unsigned*)src, (LAS unsigned*)(wbuf + ((BQ) & 1) * 49152 + f * 1024), 16, 0, 0); } } while (0)
#define RT_LOAD_X(BQ, S) do { _Pragma("unroll") for (int q = 0; q < 8; ++q) { xa[S][q] = *(const f32x4*)(xr + 32 * (8 * (BQ) + q)); xb[S][q] = *(const f32x4*)(xr + 32 * (8 * (BQ) + q) + 4); } } while (0)
        f32x4 xa[1][8], xb[1][8];
        RT_STAGE_W(0); RT_LOAD_X(0, 0);
#pragma unroll 1
        for (int bq = 0; bq < 4; ++bq) {
            const int k0 = 8 * bq;
            asm volatile("s_waitcnt vmcnt(0)" ::: "memory");
            __syncthreads();
            if (bq < 3) RT_STAGE_W(bq + 1);
            f32x4 xc[8], xd[8];
#pragma unroll
            for (int q = 0; q < 8; ++q) { xc[q] = xa[0][q]; xd[q] = xb[0][q]; }
            if (bq < 3) RT_LOAD_X(bq + 1, 0);
            __builtin_amdgcn_sched_barrier(0);
            const LAS unsigned char* wb = wbuf + (bq & 1) * 49152 + lane * 16;
            u32x4 hws[8];
#pragma unroll
            for (int q = 0; q < 8; ++q) { const int ks = k0 + q;
                const f32x4 a = xc[q], b = xd[q];
                const f32x4 ga = *(const LAS f32x4*)(gl + 32 * ks + kg * 8), gb = *(const LAS f32x4*)(gl + 32 * ks + kg * 8 + 4);
                ss += (a.x * a.x + a.y * a.y) + (a.z * a.z + a.w * a.w) + (b.x * b.x + b.y * b.y) + (b.z * b.z + b.w * b.w);
                float xn[8] = {a.x * ga.x, a.y * ga.y, a.z * ga.z, a.w * ga.w, b.x * gb.x, b.y * gb.y, b.z * gb.z, b.w * gb.w};
                u32x4 hw, lw;
                hw.x = pk2(xn[0], xn[1]); hw.y = pk2(xn[2], xn[3]); hw.z = pk2(xn[4], xn[5]); hw.w = pk2(xn[6], xn[7]);
                lw.x = pk2(xn[0] - bflo(hw.x), xn[1] - bfhi(hw.x)); lw.y = pk2(xn[2] - bflo(hw.y), xn[3] - bfhi(hw.y)); lw.z = pk2(xn[4] - bflo(hw.z), xn[5] - bfhi(hw.z)); lw.w = pk2(xn[6] - bflo(hw.w), xn[7] - bfhi(hw.w));
                hws[q] = hw;
                const bf16x8 xh = __builtin_bit_cast(bf16x8, hw), xl = __builtin_bit_cast(bf16x8, lw);
#pragma unroll
                for (int nt = 0; nt < 3; ++nt) {
                    const bf16x8 ah = *(const LAS bf16x8*)(wb + (nt * 8 + q) * 1024), al = *(const LAS bf16x8*)(wb + ((3 + nt) * 8 + q) * 1024);
                    acc[nt] = __builtin_amdgcn_mfma_f32_16x16x32_bf16(ah, xh, acc[nt], 0, 0, 0);
                    acc[nt] = __builtin_amdgcn_mfma_f32_16x16x32_bf16(ah, xl, acc[nt], 0, 0, 0);
                    acc[nt] = __builtin_amdgcn_mfma_f32_16x16x32_bf16(al, xh, acc[nt], 0, 0, 0); }
            }
#pragma unroll
            for (int q = 0; q < 8; ++q) *(u32x4*)(hr + 32 * (k0 + q)) = hws[q];
        }
#undef RT_STAGE_W
#undef RT_LOAD_X
        ss += __shfl_xor(ss, 16); ss += __shfl_xor(ss, 32);
        const float rs = rsqrtf(ss * (1.f / 1024.f) + RMS_EPS);
#pragma unroll
        for (int nt = 0; nt < 3; ++nt) acc[nt] = acc[nt] * rs;
        if (kg == 0) ((float*)(wsl + WS_TOKRS))[m] = rs;
        float lg[4];
#pragma unroll
        for (int i = 0; i < 4; ++i) lg[i] = __shfl(acc[2][i], t) + gl[1056 + i];
        int grp = 0; float gm = lg[0];
#pragma unroll
        for (int i = 1; i < 4; ++i) if (lg[i] > gm) { gm = lg[i]; grp = i; }
        float gs = 0.f;
#pragma unroll
        for (int i = 0; i < 4; ++i) gs += __expf(lg[i] - gm);
        const float pgt = 1.f / gs;
        const int src0 = t + 32 * (grp & 1), src1 = src0 + 16;
        float le[8];
#pragma unroll
        for (int i = 0; i < 4; ++i) { const float a0 = __shfl(acc[0][i], src0), a1 = __shfl(acc[0][i], src1), b0 = __shfl(acc[1][i], src0), b1 = __shfl(acc[1][i], src1);
            le[i] = ((grp >> 1) ? b0 : a0) + gl[1024 + grp * 8 + i]; le[4 + i] = ((grp >> 1) ? b1 : a1) + gl[1024 + grp * 8 + 4 + i]; }
        int e0 = 0; float t0 = le[0];
#pragma unroll
        for (int i = 1; i < 8; ++i) if (le[i] > t0) { t0 = le[i]; e0 = i; }
        int e1 = -1; float t1 = -INFINITY;
#pragma unroll
        for (int i = 0; i < 8; ++i) if (i != e0 && le[i] > t1) { t1 = le[i]; e1 = i; }
        const float tt = __expf(t1 - t0), w0 = pgt / (1.f + tt), w1 = pgt * tt / (1.f + tt);
        if (kg == 0) { toke[2 * m] = grp * 8 + e0; toke[2 * m + 1] = grp * 8 + e1; tokw[2 * m] = w0; tokw[2 * m + 1] = w1;
            (void)__hip_atomic_fetch_add(&hist[grp * 8 + e0], 1u, __ATOMIC_RELAXED, __HIP_MEMORY_SCOPE_WORKGROUP); (void)__hip_atomic_fetch_add(&hist[grp * 8 + e1], 1u, __ATOMIC_RELAXED, __HIP_MEMORY_SCOPE_WORKGROUP); }
    }
    __syncthreads();
    if (tid < 32) ((int*)(wsl + WS_HIST))[blockIdx.x * 32 + tid] = (int)hist[tid];
    __syncthreads();
}
__device__ __forceinline__ void ph_dispatch(Frame& F, int l, bool probe = false) {
    const int tid = tid_now(), lane = tid & 63, wave = __builtin_amdgcn_readfirstlane(tid >> 6); (void)lane; (void)wave;
    unsigned char* const wsl = opaque(F.ws);
    LAS int* pstart = (LAS int*)(F.lds + LTAB_OFF); LAS int* cnt = pstart + 32; LAS unsigned* lhist = (LAS unsigned*)(cnt + 32); LAS int* lbase = (LAS int*)(lhist + 32);
    LAS int* rowof = lbase + 32;
        const int* toke = (const int*)(wsl + WS_TOKE); const float* tokw = (const float*)(wsl + WS_TOKW);
    int* toks = (int*)(wsl + WS_TOKS); float* roww = (float*)(wsl + WS_ROWW); int* blke = (int*)(wsl + WS_BLKE);
    const bf16* H = (const bf16*)(wsl + WS_H); bf16* xs = (bf16*)(wsl + WS_XS);
    LAS int* part = rowof + 260;
    LAS int* wcnt = part + 1024;
    { const int e = tid & 31, g = tid >> 5; const int* hs = (const int*)(wsl + WS_HIST); int sa = 0, sb = 0; int hv[16];
#pragma unroll
      for (int q = 0; q < 16; ++q) hv[q] = hs[(g * 16 + q) * 32 + e];
#pragma unroll
      for (int q = 0; q < 16; ++q) { sa += hv[q]; sb += (g * 16 + q < (int)blockIdx.x) ? hv[q] : 0; }
      part[g * 32 + e] = sa; part[512 + g * 32 + e] = sb; }
    __syncthreads();
    if (tid < 32) { int sa = 0, sb = 0;
#pragma unroll
        for (int g = 0; g < 16; ++g) { sa += part[g * 32 + tid]; sb += part[512 + g * 32 + tid]; }
        cnt[tid] = sa; lbase[tid] = sb; lhist[tid] = 0u; }
    __syncthreads();
    if (tid == 0) { int a = 0; for (int e = 0; e < 32; ++e) { pstart[e] = a; a += ((cnt[e] + 255) >> 8) << 8; } pstart[32 + 32 + 32 + 32 + 256] = a; }
    __syncthreads();
    const int total = pstart[32 + 32 + 32 + 32 + 256];
    if (blockIdx.x == 0) {
        for (int rb = tid; rb < 288; rb += 512) { int e = 31; for (int k = 31; k >= 0; --k) if (rb * 256 < pstart[k] + (((cnt[k] + 255) >> 8) << 8)) e = k; blke[rb] = e; }
        if (tid == 0) blke[300] = total >> 8;
    }
    int* rowtok = (int*)(wsl + WS_ROWTOK);
    for (int e = blockIdx.x; e < 32; e += F.G) {
        const int p0 = pstart[e] + cnt[e], p1 = pstart[e] + (((cnt[e] + 255) >> 8) << 8);
        for (int rr = p0 + tid; rr < p1; rr += 512) { roww[rr] = 0.f; rowtok[rr] = 0; }
    }
    const int tpw = T_ / F.G, t0 = blockIdx.x * tpw;
    int myexp = -1, myrank = 0;
    if (tid < 2 * tpw) myexp = toke[2 * t0 + tid];
    if (wave < 4) {
        for (int e = 0; e < 32; ++e) { const unsigned long long bal = __ballot(myexp == e);
            if (myexp == e) myrank = __popcll(bal & ((1ull << lane) - 1ull));
            if (lane == 0) wcnt[wave * 32 + e] = __popcll(bal); } }
    __syncthreads();
    if (tid < 2 * tpw) { for (int w2 = 0; w2 < wave; ++w2) myrank += wcnt[w2 * 32 + myexp]; }
    if (tid < 2 * tpw) { const int row = pstart[myexp] + lbase[myexp] + myrank; rowof[tid] = row; toks[2 * t0 + tid] = row; roww[row] = ((const float*)(wsl + WS_TOKRS))[t0 + (tid >> 1)]; rowtok[row] = t0 + (tid >> 1); }
    __syncthreads();
    __syncthreads();
}

struct Args { const float* in[22]; float* out; unsigned char* ws; int ph_lo, ph_hi; };
constexpr int NPH = 13;

__global__ void __launch_bounds__(512, 2) fwd_kernel(Args args) {
    extern __shared__ __attribute__((aligned(16))) unsigned char lds_raw[];
    Frame F;
    (void)lds_raw;
    F.lds = (LAS unsigned char*)(unsigned)LDS_BASE;
    F.MISC = (volatile LAS unsigned*)(F.lds + MISC_OFF);
    F.tid = threadIdx.x; F.lane = F.tid & 63; F.wave = __builtin_amdgcn_readfirstlane(F.tid >> 6);
    F.out = args.out; F.ws = args.ws; F.ctl = (unsigned*)(args.ws + WS_CTL);
    for (int u = F.tid; u < (LDS_BYTES - LDSCTL_OFF) / 4; u += 512) ((LAS unsigned*)(F.lds + LDSCTL_OFF))[u] = 0u;
    __syncthreads();
    if (F.tid < 22) ((LAS unsigned long long*)(F.lds + PTAB_OFF))[F.tid] = (unsigned long long)args.in[F.tid];
    __syncthreads();
    constexpr int lo = 0, hi = 2 * NPH + 1;
    const bool use_bar = (hi - lo) > 1;
    XcdBarrier bar; bar.bar = F.ctl + CW_BAR; bar.x = 0; bar.st = nullptr;
    if (use_bar) bar = xcd_barrier_post(F.ctl + CW_BAR, F.MISC + 8);
#define IN(k) (lo <= (k) && (k) < hi)
#define SEAM(k) do { if ((PROBE_A >= 0 || PROBE_B >= 0) && tid_now() == 0) { const unsigned long long now_ = __builtin_amdgcn_s_memrealtime(); if (blockIdx.x == PROBE_BLK) ((LAS unsigned long long*)(F.lds + LTAB_OFF + 4096 + 256))[n_stamp] = now_; (void)__hip_atomic_fetch_max((unsigned long long*)(F.ctl + CW_ARR) + n_stamp, now_, __ATOMIC_RELAXED, __HIP_MEMORY_SCOPE_AGENT); } if (IN(k) && IN((k) + 1)) xcd_barrier(bar); if ((PROBE_A >= 0 || PROBE_B >= 0) && blockIdx.x == PROBE_BLK && tid_now() == 0) { ((LAS unsigned long long*)(F.lds + LTAB_OFF + 4096))[n_stamp] = __builtin_amdgcn_s_memrealtime(); } ++n_stamp; } while (0)
    int n_stamp = 1;
    if ((PROBE_A >= 0 || PROBE_B >= 0) && blockIdx.x == PROBE_BLK && tid_now() == 0) ((LAS unsigned long long*)(F.lds + LTAB_OFF + 4096))[0] = __builtin_amdgcn_s_memrealtime();
    for (int l = 0; l < DEPTH; ++l) {
        const int pb = l * NPH;
#define WSL unsigned char* const ws = opaque(F.ws); unsigned char* const wmix = ws + WS_WMIX + (size_t)l * WMIX_LAYER; (void)wmix
        if (IN(pb + 0)) { WSL;
            if (l == 0) { RUN(0, ph_convert_mixer(F)); __syncthreads(); PM(11) ph_norm<false, true>(F, F.inp(0), F.inp(2), (bf16*)(ws + WS_H)); }
            else PM(12) ph_norm<true, true>(F, F.out, F.inp(2) + 1024, (bf16*)(ws + WS_H));
            ph_gla_z(F, l);
        }
        SEAM(pb + 0);
        if (IN(pb + 1)) { WSL;
            LAS float* gtab = (LAS float*)(F.lds + LTAB_OFF);
            if (tid_now() < 128) gtab[tid_now()] = (tid_now() < 64) ? F.inp(6)[l * 64 + tid_now()] * QSCALE : F.inp(7)[l * 64 + tid_now() - 64];
            __syncthreads();
            pg8::SchedPlain S{(const char*)(ws + WS_H), (const char*)(wmix + WO_WIN), 128, 18, F.G, (int)blockIdx.x, (size_t)256 * 1024 * 2, (size_t)256 * 1024 * 2};
            pg8::EpiInProj E{(bf16*)(ws + WS_PC), (bf16*)(ws + WS_PA), (bf16*)(ws + WS_PG), (float*)(ws + WS_KM2), gtab, gtab + 64};
            RUN(16, pg8::gemm_phase(F.lds, 1024, 1024, S, E));
        }
        SEAM(pb + 1);
        if (IN(pb + 2)) { RUN(1, ph_conv(F, l)); RUN(4, ph_moba_gate(F)); __syncthreads(); RUN(3, ph_gla_kv(F, l)); }
        SEAM(pb + 2);
        if (IN(pb + 3)) { PM(5) { if ((REP_MASK >> 5) & 1u) ph_gla_scan(F, true); ph_gla_scan(F); } __syncthreads(); PM(6) ph_moba_routed(F, l); }
        SEAM(pb + 3);
        if (IN(pb + 12)) { RUN(7, ph_gla_out(F, l)); __syncthreads(); RUN(14, ph_moba_own(F, l)); }
        SEAM(pb + 12);
        if (IN(pb + 5)) { WSL;
            pg8::SchedBranch S{(const char*)(ws + WS_Y), (const char*)(wmix + WO_WB), F.G, (int)blockIdx.x};
            pg8::EpiBranch E{(bf16*)(ws + WS_BB)};
            RUN(17, pg8::gemm_phase(F.lds, 512, NYC, S, E));
        }
        ++n_stamp;
        if (IN(pb + 6)) { WSL;
            pg8::SchedGate S{(const char*)(ws + WS_H), (const char*)(wmix + WO_WG), F.G, (int)blockIdx.x};
            pg8::EpiGateMerge E{(const bf16*)(ws + WS_BB), (bf16*)(ws + WS_MRG)};
            RUN(18, pg8::gemm_phase(F.lds, 1024, 1024, S, E));
        }
        SEAM(pb + 6);
        if (IN(pb + 7)) { WSL;
            pg8::SchedPlain S{(const char*)(ws + WS_MRG), (const char*)(wmix + WO_WO), 128, 4, F.G, (int)blockIdx.x, (size_t)256 * 1024 * 2, (size_t)256 * 1024 * 2};
            pg8::EpiOut E{l == 0 ? F.inp(0) : (const float*)F.out, F.out};
            RUN(19, pg8::gemm_phase(F.lds, 1024, 1024, S, E));
        }
        SEAM(pb + 7);
        if (IN(pb + 8)) { const int tid = tid_now(); SP_T0(); PM(8) { if ((REP_MASK >> 8) & 1u) ph_norm_router(F, l, true); ph_norm_router(F, l); } SP_ADD(4); RUN(9, ph_convert_experts(F, l)); SP_ADD(5); }
        SEAM(pb + 8);
        if (IN(pb + 9)) PM(10) { if ((REP_MASK >> 10) & 1u) { ph_dispatch(F, l, true); __syncthreads(); } ph_dispatch(F, l); }
        SEAM(pb + 9);
        if (IN(pb + 10) || IN(pb + 11)) { WSL;
            LAS int* tab = (LAS int*)(F.lds + LTAB_OFF + 2048);
            const int* blke = (const int*)(ws + WS_BLKE);
            for (int i = tid_now(); i < 304; i += 512) tab[i] = blke[i];
            __syncthreads();
            const int nblk = tab[300];
            if (IN(pb + 10)) {
                pg8::SchedMoeG S{(const char*)(ws + WS_H), (const int*)(ws + WS_ROWTOK), (const char*)(ws + WS_W1T), tab, nblk * 4, F.G, (int)blockIdx.x, (size_t)1024 * 1024 * 2, (size_t)256 * 1024 * 2};
                pg8::EpiSwiGLU E{(bf16*)(ws + WS_ACT), (const float*)(ws + WS_ROWW)};
                RUN(20, pg8::gemm_phase_gather(F.lds, 1024, S, E));
            }
            SEAM(pb + 10);
            if (IN(pb + 11)) {
                pg8::SchedMoe S{(const char*)(ws + WS_ACT), (const char*)(ws + WS_WDT), tab, nblk * 4, F.G, (int)blockIdx.x, (size_t)256 * 512 * 2, (size_t)1024 * 512 * 2, (size_t)256 * 512 * 2};
                pg8::EpiMoeDown E{(bf16*)(ws + WS_YS)};
                RUN(21, pg8::gemm_phase(F.lds, 512, 512, S, E));
            }
        }
        SEAM(pb + 11);
    }
    if (IN(2 * NPH)) PM(13) ph_norm<true, false>(F, F.out, nullptr, nullptr);
    if ((PROBE_A >= 0 || PROBE_B >= 0) && blockIdx.x == PROBE_BLK && tid_now() == 0) {
        LAS unsigned long long* ts = (LAS unsigned long long*)(F.lds + LTAB_OFF + 4096);
        LAS unsigned long long* ta = ts + 32;
        constexpr int NSEAM = 12;
        ts[2 * NSEAM + 1] = __builtin_amdgcn_s_memrealtime(); ta[2 * NSEAM + 1] = ts[2 * NSEAM + 1];
        unsigned long long spin = 0ull;
#define PROBE_LAST(i) __hip_atomic_load((unsigned long long*)(F.ctl + CW_ARR) + (i), __ATOMIC_RELAXED, __HIP_MEMORY_SCOPE_AGENT)
#define PROBE_SPAN(P, K, i) ((K) == 0 ? ts[(i) + 1] - ts[(i)] : (K) == 1 ? ta[(i) + 1] - ts[(i)] : (K) == 2 ? ts[(i) + 1] - ta[(i) + 1] : (K) == 3 ? PROBE_LAST((i) + 1) - ts[(i)] : ts[(i) + 1] - PROBE_LAST((i) + 1))
        LAS unsigned long long* spacc = (LAS unsigned long long*)(F.lds + LTAB_OFF + 4096 + 512);
        if (PROBE_A >= 0) { unsigned long long d = (PROBE_A >= 100) ? spacc[PROBE_A >= 100 ? PROBE_A - 100 : 0] : (PROBE_A == NSEAM) ? PROBE_SPAN(PROBE_A, PROBE_KA, 2 * NSEAM) : PROBE_SPAN(PROBE_A, PROBE_KA, PROBE_A) + PROBE_SPAN(PROBE_A, PROBE_KA, PROBE_A + NSEAM);
            unsigned long long q = (d + 50ull * PROBE_QA) / (100ull * PROBE_QA); if (q > 63ull) q = 63ull; spin += q * 10000ull; }
        if (PROBE_B >= 0) { unsigned long long d = (PROBE_B >= 100) ? spacc[PROBE_B >= 100 ? PROBE_B - 100 : 0] : (PROBE_B == NSEAM) ? PROBE_SPAN(PROBE_B, PROBE_KB, 2 * NSEAM) : PROBE_SPAN(PROBE_B, PROBE_KB, PROBE_B) + PROBE_SPAN(PROBE_B, PROBE_KB, PROBE_B + NSEAM);
            unsigned long long q = (d + 50ull * PROBE_QB) / (100ull * PROBE_QB); if (q > 63ull) q = 63ull; spin += q * 640000ull; }
        const unsigned long long t0 = __builtin_amdgcn_s_memrealtime();
        while (__builtin_amdgcn_s_memrealtime() - t0 < spin) __builtin_amdgcn_s_sleep(16);
    }
#undef IN
#undef SEAM
#undef WSL
}

extern "C" void kernel_launch(void* const* d_in, const int* in_sizes, int n_in, void* d_out, int out_size, void* d_ws, size_t ws_size, hipStream_t stream) {
    static int grid = 0;
    if (grid == 0) {
        if (n_in != 22 || out_size != T_ * DM || ws_size < WS_END) { fprintf(stderr, "kernel_launch: unexpected shapes (n_in %d out %d ws %zu)\n", n_in, out_size, ws_size); grid = -1; return; }
        if (hipFuncSetAttribute((const void*)fwd_kernel, hipFuncAttributeMaxDynamicSharedMemorySize, LDS_BASE + LDS_BYTES) != hipSuccess) { fprintf(stderr, "kernel_launch: hipFuncSetAttribute failed\n"); grid = -1; return; }
        int dev = 0, cus = 0, per_cu = 0;
        hipGetDevice(&dev); hipDeviceGetAttribute(&cus, hipDeviceAttributeMultiprocessorCount, dev);
        if (hipOccupancyMaxActiveBlocksPerMultiprocessor(&per_cu, (const void*)fwd_kernel, 512, LDS_BASE + LDS_BYTES) != hipSuccess || per_cu < 1) fprintf(stderr, "kernel_launch: occupancy query reports %d\n", per_cu);
        (void)hipGetLastError();
        grid = 256;
        if (cus < 256) { fprintf(stderr, "kernel_launch: needs a 256-CU device (found %d)\n", cus); grid = -1; return; }
    }
    if (grid < 0) return;
    (void)hipMemsetAsync((char*)d_ws + WS_CTL, 0, CTL_ZERO_BYTES, stream);
    Args a{};
    for (int i = 0; i < 22; ++i) a.in[i] = (const float*)d_in[i];
    a.out = (float*)d_out; a.ws = (unsigned char*)d_ws; a.ph_lo = 0; a.ph_hi = 2 * NPH + 1;
    hipLaunchKernelGGL(fwd_kernel, dim3(grid), dim3(512), LDS_BASE + LDS_BYTES, stream, a);
}
```
